# Optimizing an MI355X kernel written in HIP

```python
import jax, jax.numpy as jnp
from jax import lax
import numpy as np

D_MODEL = 2048
BATCH = 1
SEQ = 16384
DEPTH = 2

MIX_WIDTH = D_MODEL
W_MLA = D_MODEL // 4
W_MOBA = D_MODEL // 4
W_CONV = D_MODEL // 4
W_POOL = MIX_WIDTH - W_MLA - W_MOBA - W_CONV

MLA_NOPE_DIM = 128
MLA_ROPE_DIM = 64
MLA_V_DIM = 128
MLA_QK_DIM = MLA_NOPE_DIM + MLA_ROPE_DIM
MLA_HEADS = W_MLA // MLA_V_DIM
Q_LORA = D_MODEL // 4
KV_LORA = D_MODEL // 8

MOBA_HEAD_DIM = 128
MOBA_HEADS = W_MOBA // MOBA_HEAD_DIM
MOBA_BLOCK = 256
MOBA_TOPK = 3
MOBA_ROT_DIM = MOBA_HEAD_DIM // 4

CONV_WIDTH = 31

POOL_WINDOWS = (2, 4, 8, 16)
POOL_GROUP = W_POOL // len(POOL_WINDOWS)

D_FF = -(-(8 * D_MODEL) // (3 * 256)) * 256

ROPE_THETA = 500000.0
Q_BLOCK = 128
NORM_EPS = 1e-5
NEG_INF = -1e30
DEEPNORM_ALPHA = (2 * DEPTH) ** 0.25
DEEPNORM_BETA = (8 * DEPTH) ** -0.25

IN_SIZES = (Q_LORA, KV_LORA, MLA_ROPE_DIM, W_MOBA, W_MOBA, W_MOBA, 2 * W_CONV, W_POOL)
IN_COLS = Q_LORA + KV_LORA + MLA_ROPE_DIM + 3 * W_MOBA + 2 * W_CONV + W_POOL

kernel_name = 'hybrid_parallel_mla_moba_conv_pool'


def _split_columns(h, sizes):
    outs = []
    start = 0
    for n in sizes:
        outs.append(h[..., start:start + n])
        start += n
    return outs


def _rope_tables(positions, dim):
    inv_freq = 1.0 / (ROPE_THETA ** (jnp.arange(0, dim, 2, dtype=jnp.float32) / dim))
    ang = positions.astype(jnp.float32)[..., None] * inv_freq
    return jnp.cos(ang), jnp.sin(ang)


def _apply_rope(x, cos, sin):
    half = x.shape[-1] // 2
    xf = x.astype(jnp.float32)
    c = cos[:, :, None, :]
    s = sin[:, :, None, :]
    x1, x2 = xf[..., :half], xf[..., half:]
    return jnp.concatenate([x1 * c - x2 * s, x1 * s + x2 * c], axis=-1).astype(x.dtype)


def _partial_rope(x, cos, sin):
    return jnp.concatenate([_apply_rope(x[..., :MOBA_ROT_DIM], cos, sin), x[..., MOBA_ROT_DIM:]], axis=-1)


def _layer_norm(x, g, b):
    xf = x.astype(jnp.float32)
    mu = jnp.mean(xf, axis=-1, keepdims=True)
    xc = xf - mu
    var = jnp.mean(xc * xc, axis=-1, keepdims=True)
    y = xc * lax.rsqrt(var + NORM_EPS) * g.astype(jnp.float32) + b.astype(jnp.float32)
    return y.astype(x.dtype)


def _rms_norm(x, g):
    xf = x.astype(jnp.float32)
    y = xf * lax.rsqrt(jnp.mean(xf * xf, axis=-1, keepdims=True) + NORM_EPS) * g.astype(jnp.float32)
    return y.astype(x.dtype)


def _causal_attention(q, k, v, scale):
    b, s, h, dk = q.shape
    nq = s // Q_BLOCK
    q_blocks = q.reshape(b, nq, Q_BLOCK, h, dk).swapaxes(0, 1)
    k_pos = jnp.arange(s)

    def block(args):
        q_i, i = args
        scores = jnp.einsum('bqhd,bkhd->bhqk', q_i, k, preferred_element_type=jnp.float32) * scale
        q_pos = i * Q_BLOCK + jnp.arange(Q_BLOCK)
        scores = jnp.where(k_pos[None, :] <= q_pos[:, None], scores, NEG_INF)
        p = jax.nn.softmax(scores, axis=-1).astype(v.dtype)
        return jnp.einsum('bhqk,bkhd->bqhd', p, v)

    out = lax.map(block, (q_blocks, jnp.arange(nq)))
    return out.swapaxes(0, 1).reshape(b, s, h, v.shape[-1])


def _moba_attention(q, k, v):
    b, s, h, d = q.shape
    scale = d ** -0.5
    n_blk = max(-(-s // MOBA_BLOCK), MOBA_TOPK)
    pad = n_blk * MOBA_BLOCK - s
    kh = jnp.pad(k, ((0, 0), (0, pad), (0, 0), (0, 0))).swapaxes(1, 2)
    vh = jnp.pad(v, ((0, 0), (0, pad), (0, 0), (0, 0))).swapaxes(1, 2)
    k_mean = jnp.mean(kh.astype(jnp.float32).reshape(b, h, n_blk, MOBA_BLOCK, d), axis=3)
    nq = s // Q_BLOCK
    q_blocks = q.swapaxes(1, 2).reshape(b, h, nq, Q_BLOCK, d).transpose(2, 0, 1, 3, 4)
    b_idx = jnp.arange(b)[:, None, None, None]
    h_idx = jnp.arange(h)[None, :, None, None]
    offs = jnp.arange(MOBA_BLOCK)
    blk_ids = jnp.arange(n_blk)
    n_sel = MOBA_TOPK * MOBA_BLOCK

    def block(args):
        q_i, i = args
        q_start = i * Q_BLOCK
        own = q_start // MOBA_BLOCK
        gate = jnp.einsum('bhqd,bhnd->bhqn', q_i.astype(jnp.float32), k_mean)
        gate = jnp.where((blk_ids < own)[None, None, None, :], gate, NEG_INF)
        _, sel = lax.top_k(gate, MOBA_TOPK)
        sel_ok = jnp.repeat(sel < own, MOBA_BLOCK, axis=-1)
        pos = (sel[..., None] * MOBA_BLOCK + offs).reshape(b, h, Q_BLOCK, n_sel)
        k_sel = kh[b_idx, h_idx, pos]
        v_sel = vh[b_idx, h_idx, pos]
        s_sel = jnp.einsum('bhqd,bhqkd->bhqk', q_i, k_sel, preferred_element_type=jnp.float32) * scale
        s_sel = jnp.where(sel_ok, s_sel, NEG_INF)
        own_start = own * MOBA_BLOCK
        k_own = lax.dynamic_slice_in_dim(kh, own_start, MOBA_BLOCK, axis=2)
        v_own = lax.dynamic_slice_in_dim(vh, own_start, MOBA_BLOCK, axis=2)
        s_own = jnp.einsum('bhqd,bhkd->bhqk', q_i, k_own, preferred_element_type=jnp.float32) * scale
        q_pos = q_start + jnp.arange(Q_BLOCK)
        k_pos = own_start + offs
        s_own = jnp.where(k_pos[None, :] <= q_pos[:, None], s_own, NEG_INF)
        p = jax.nn.softmax(jnp.concatenate([s_sel, s_own], axis=-1), axis=-1).astype(v.dtype)
        return (jnp.einsum('bhqk,bhqkd->bhqd', p[..., :n_sel], v_sel)
                + jnp.einsum('bhqk,bhkd->bhqd', p[..., n_sel:], v_own))

    out = lax.map(block, (q_blocks, jnp.arange(nq)))
    return out.transpose(1, 0, 3, 2, 4).reshape(b, s, h, d)


def _conformer_conv(u, dw_w, dw_b, ln_g, ln_b, pw_w):
    a, g = jnp.split(u, 2, axis=-1)
    hdn = a * jax.nn.sigmoid(g)
    c = hdn.shape[-1]
    hp = jnp.pad(hdn, ((0, 0), (CONV_WIDTH - 1, 0), (0, 0)))
    y = lax.conv_general_dilated(hp, dw_w[:, None, :].astype(hdn.dtype), (1,), 'VALID',
                                 dimension_numbers=('NWC', 'WIO', 'NWC'),
                                 feature_group_count=c) + dw_b
    y = jax.nn.silu(_layer_norm(y, ln_g, ln_b))
    return y @ pw_w


def _multiscale_pool(u, w_pool, scale):
    b, s, c = u.shape
    uf = u.astype(jnp.float32)
    csum = jnp.cumsum(uf, axis=1)
    t = jnp.arange(s)
    groups = []
    for gi, w in enumerate(POOL_WINDOWS):
        sl = slice(gi * POOL_GROUP, (gi + 1) * POOL_GROUP)
        cg = csum[..., sl]
        lower = jnp.pad(cg[:, :s - w], ((0, 0), (w, 0), (0, 0)))
        count = jnp.minimum(t + 1, w).astype(jnp.float32)[None, :, None]
        groups.append((cg - lower) / count - uf[..., sl])
    pooled = jnp.stack(groups, axis=2).astype(u.dtype)
    mixed = jnp.einsum('bsgc,gcd->bsgd', pooled, w_pool).reshape(b, s, c)
    return mixed * scale


def _hybrid_layer(x, cos_mla, sin_mla, cos_moba, sin_moba, w_in, g_q, w_uq, g_kv, w_ukv,
                  conv_dw_w, conv_dw_b, conv_ln_g, conv_ln_b, conv_pw_w, pool_w, pool_scale,
                  w_out, ln1_g, ln1_b, w_gate, w_up, w_down, ln2_g, ln2_b):
    b, s, _ = x.shape
    h = x @ w_in
    c_q, c_kv, k_rope, mq, mk, mv, conv_in, pool_in = _split_columns(h, IN_SIZES)

    q = (_rms_norm(c_q, g_q) @ w_uq).reshape(b, s, MLA_HEADS, MLA_QK_DIM)
    q_pe = _apply_rope(q[..., MLA_NOPE_DIM:], cos_mla, sin_mla)
    q_a = jnp.concatenate([q[..., :MLA_NOPE_DIM], q_pe], axis=-1)
    kv = (_rms_norm(c_kv, g_kv) @ w_ukv).reshape(b, s, MLA_HEADS, MLA_NOPE_DIM + MLA_V_DIM)
    k_pe = _apply_rope(k_rope[:, :, None, :], cos_mla, sin_mla)
    k_a = jnp.concatenate([kv[..., :MLA_NOPE_DIM],
                           jnp.broadcast_to(k_pe, (b, s, MLA_HEADS, MLA_ROPE_DIM))], axis=-1)
    o_mla = _causal_attention(q_a, k_a, kv[..., MLA_NOPE_DIM:], MLA_QK_DIM ** -0.5).reshape(b, s, W_MLA)

    q_b = _partial_rope(mq.reshape(b, s, MOBA_HEADS, MOBA_HEAD_DIM), cos_moba, sin_moba)
    k_b = _partial_rope(mk.reshape(b, s, MOBA_HEADS, MOBA_HEAD_DIM), cos_moba, sin_moba)
    v_b = mv.reshape(b, s, MOBA_HEADS, MOBA_HEAD_DIM)
    o_moba = _moba_attention(q_b, k_b, v_b).reshape(b, s, W_MOBA)

    o_conv = _conformer_conv(conv_in, conv_dw_w, conv_dw_b, conv_ln_g, conv_ln_b, conv_pw_w)

    o_pool = _multiscale_pool(pool_in, pool_w, pool_scale)

    mix = jnp.concatenate([o_mla, o_moba, o_conv, o_pool], axis=-1) @ w_out
    x = _layer_norm(DEEPNORM_ALPHA * x + mix, ln1_g, ln1_b)

    ffn = (jax.nn.silu(x @ w_gate) * (x @ w_up)) @ w_down
    return _layer_norm(DEEPNORM_ALPHA * x + ffn, ln2_g, ln2_b)


def _normal(k, shape, std):
    return jax.random.normal(k, shape, jnp.float32) * std


def setup_inputs(seed: int = 0) -> dict:
    key = jax.random.key(seed)
    ks = jax.random.split(key, 24)
    L = DEPTH
    x = jax.random.normal(ks[0], (BATCH, SEQ, D_MODEL), jnp.float32)
    offset = jax.random.randint(ks[1], (BATCH, 1), 0, 4096, dtype=jnp.int32)
    positions = offset + jnp.arange(SEQ, dtype=jnp.int32)[None, :]
    return {
        'x': x,
        'positions': positions,
        'w_in': _normal(ks[2], (L, D_MODEL, IN_COLS), D_MODEL ** -0.5),
        'g_q': 1.0 + _normal(ks[3], (L, Q_LORA), 0.02),
        'w_uq': _normal(ks[4], (L, Q_LORA, MLA_HEADS * MLA_QK_DIM), Q_LORA ** -0.5),
        'g_kv': 1.0 + _normal(ks[5], (L, KV_LORA), 0.02),
        'w_ukv': _normal(ks[6], (L, KV_LORA, MLA_HEADS * (MLA_NOPE_DIM + MLA_V_DIM)), KV_LORA ** -0.5),
        'conv_dw_w': _normal(ks[7], (L, CONV_WIDTH, W_CONV), CONV_WIDTH ** -0.5),
        'conv_dw_b': _normal(ks[8], (L, W_CONV), 0.02),
        'conv_ln_g': 1.0 + _normal(ks[9], (L, W_CONV), 0.02),
        'conv_ln_b': _normal(ks[10], (L, W_CONV), 0.02),
        'conv_pw_w': _normal(ks[11], (L, W_CONV, W_CONV), W_CONV ** -0.5),
        'pool_w': _normal(ks[12], (L, len(POOL_WINDOWS), POOL_GROUP, POOL_GROUP), POOL_GROUP ** -0.5),
        'pool_scale': 1.0 + _normal(ks[13], (L, W_POOL), 0.1),
        'w_out': _normal(ks[14], (L, MIX_WIDTH, D_MODEL), MIX_WIDTH ** -0.5 * DEEPNORM_BETA),
        'ln1_g': 1.0 + _normal(ks[15], (L, D_MODEL), 0.02),
        'ln1_b': _normal(ks[16], (L, D_MODEL), 0.02),
        'w_gate': _normal(ks[17], (L, D_MODEL, D_FF), D_MODEL ** -0.5),
        'w_up': _normal(ks[18], (L, D_MODEL, D_FF), D_MODEL ** -0.5),
        'w_down': _normal(ks[19], (L, D_FF, D_MODEL), D_FF ** -0.5 * DEEPNORM_BETA),
        'ln2_g': 1.0 + _normal(ks[20], (L, D_MODEL), 0.02),
        'ln2_b': _normal(ks[21], (L, D_MODEL), 0.02),
    }


def reference(x, positions, w_in, g_q, w_uq, g_kv, w_ukv, conv_dw_w, conv_dw_b, conv_ln_g,
              conv_ln_b, conv_pw_w, pool_w, pool_scale, w_out, ln1_g, ln1_b, w_gate, w_up,
              w_down, ln2_g, ln2_b):
    cos_mla, sin_mla = _rope_tables(positions, MLA_ROPE_DIM)
    cos_moba, sin_moba = _rope_tables(positions, MOBA_ROT_DIM)
    h = x
    for l in range(DEPTH):
        h = _hybrid_layer(h, cos_mla, sin_mla, cos_moba, sin_moba, w_in[l], g_q[l], w_uq[l],
                          g_kv[l], w_ukv[l], conv_dw_w[l], conv_dw_b[l], conv_ln_g[l],
                          conv_ln_b[l], conv_pw_w[l], pool_w[l], pool_scale[l], w_out[l],
                          ln1_g[l], ln1_b[l], w_gate[l], w_up[l], w_down[l], ln2_g[l], ln2_b[l])
    return h
```

```cpp
#include <hip/hip_runtime.h>
#include <hip/hip_cooperative_groups.h>
#include <cstdio>
#include <cstdint>
namespace cg = cooperative_groups;
namespace pg8 {
#define PG8_LAS __attribute__((address_space(3)))
typedef unsigned short bf16_t;
typedef short bf16x8 __attribute__((ext_vector_type(8)));
typedef float f32x4 __attribute__((ext_vector_type(4)));
typedef unsigned u32x4 __attribute__((ext_vector_type(4)));
constexpr int BM = 256, BK = 64, HALF = 128, HTB = HALF * BK * 2  , STAGE_BYTES = 8 * HTB, NXCD = 8, WGM = 8;

__host__ __device__ __forceinline__ int lds_byte(int r, int c) { const int st = (r >> 4) * 2 + (c >> 5), rr = r & 15, cc = c & 31, ob = rr * 64 + cc * 2; return st * 1024 + (ob ^ (((ob >> 9) & 1) << 5)); }
__host__ __device__ __forceinline__ void stage_rc(int b, int& R, int& C) { const int st = b / 1024, sb = b % 1024, swz = sb ^ (((sb >> 9) & 1) << 5); R = (st >> 1) * 16 + swz / 64; C = (st & 1) * 32 + (swz % 64) / 2; }
__host__ __device__ __forceinline__ int perm32(int rho) { const int n = rho >> 4, i = rho & 15; return 8 * (i >> 2) + 4 * n + (i & 3); }

struct Unit { int pm, pn; };
struct Gemm { const bf16_t* A; const bf16_t* Bt; int M, N, K; };

struct StaticOrder {
    int nM, nN, nwg, G, c;
    __host__ __device__ void init(int M, int N, int G_, int c_) { nM = M / BM; nN = N / BM; nwg = nM * nN; G = G_; c = c_; }
    __host__ __device__ bool next(int i, Unit& u) const {
        const long L = (long)i * G + c; if (L >= nwg) return false;
        int wgid = (int)L; { const int q = nwg / NXCD, r = nwg % NXCD, xcd = wgid % NXCD, off = wgid / NXCD; wgid = (xcd < r ? xcd * (q + 1) : r * (q + 1) + (xcd - r) * q) + off; }
        const int nig = WGM * nN, gid = wgid / nig, fm = gid * WGM, gsz = (nM - fm) < WGM ? (nM - fm) : WGM;
        u.pm = fm + ((wgid % nig) % gsz); u.pn = (wgid % nig) / gsz; return true;
    }
    __device__ __forceinline__ void a_ready(const Unit&) const {}
    __device__ __forceinline__ void done(const Unit&) const {}
};
__device__ __forceinline__ unsigned cvt_pk_bf16(float lo, float hi) { unsigned r; asm volatile("v_cvt_pk_bf16_f32 %0, %1, %2" : "=v"(r) : "v"(lo), "v"(hi)); return r; }
typedef float f32x2 __attribute__((ext_vector_type(2)));
template <class Epi, class Sched, bool ALIGN_EPI = false, bool SP2 = false>
__device__ __forceinline__ void gemm_phase(PG8_LAS unsigned char* lds, const Gemm g, const Sched& S, const Epi& E) {
    int tid_l = threadIdx.x; asm volatile("" : "+v"(tid_l)); const int tid = tid_l, wid = __builtin_amdgcn_readfirstlane(tid >> 6), lane = tid & 63, wr = wid >> 2, wc = wid & 3, fr = lane & 15, fq = lane >> 4;
    const int K = g.K, nt = K / BK;
    unsigned voffA[2], voffB[2];
#pragma unroll
    for (int i = 0; i < 2; ++i) { int R, C; stage_rc(tid * 16 + i * 8192, R, C); const int Rb = Epi::PERM ? ((R & ~31) + perm32(R & 31)) : R;
        voffA[i] = (unsigned)(R * K + C) * 2u; voffB[i] = (unsigned)(Rb * K + C) * 2u; }
    const size_t kstep = (size_t)(BK * 2);
    const size_t hstep = (size_t)HALF * K * 2;
    const size_t tstep = 2 * hstep;
    const unsigned ldsw = (unsigned)wid * 1024u;
    const int aoff = lds_byte(wr * 64 + fr, fq * 8), boff = lds_byte(wc * 32 + fr, fq * 8);
#define PG8_SA(b, h) (((b) * 2 + (h)) * HTB)
#define PG8_SB(b, h) ((4 + (b) * 2 + (h)) * HTB)
#define PG8_STAGE(bufoff, gbase, voff) do { _Pragma("unroll") for (int _i = 0; _i < 2; ++_i) \
        __builtin_amdgcn_global_load_lds((const unsigned*)((const char*)(gbase) + (voff)[_i]), (PG8_LAS unsigned*)(lds + (bufoff) + ldsw + _i * 8192), 16, 0, 0); } while (0)
#define PG8_LDA(dst, b, h) do { _Pragma("unroll") for (int m = 0; m < 4; ++m) _Pragma("unroll") for (int k = 0; k < 2; ++k) dst[m][k] = *(const PG8_LAS bf16x8*)(lds + PG8_SA(b, h) + aoff + m * 2048 + k * 1024); } while (0)
#define PG8_LDB(dst, b, h) do { _Pragma("unroll") for (int n = 0; n < 2; ++n) _Pragma("unroll") for (int k = 0; k < 2; ++k) dst[n][k] = *(const PG8_LAS bf16x8*)(lds + PG8_SB(b, h) + boff + n * 2048 + k * 1024); } while (0)
#define PG8_MMA(ai, bj, At, Bt) do { __builtin_amdgcn_s_setprio(1); _Pragma("unroll") for (int m = 0; m < 4; ++m) _Pragma("unroll") for (int n = 0; n < 2; ++n) _Pragma("unroll") for (int k = 0; k < 2; ++k) \
        acc[ai][bj][m][n] = __builtin_amdgcn_mfma_f32_16x16x32_bf16(Bt[n][k], At[m][k], acc[ai][bj][m][n], 0, 0, 0); __builtin_amdgcn_s_setprio(0); } while (0)
#define PG8_WAIT_V(n) asm volatile("s_waitcnt vmcnt(" #n ")" ::: "memory")
#define PG8_WAIT_L(n) asm volatile("s_waitcnt lgkmcnt(" #n ")" ::: "memory")
#define PG8_BAR __builtin_amdgcn_s_barrier()
#define PG8_SCHED __builtin_amdgcn_sched_barrier(0)
    Unit cur, nxt; int ui = 0;
    if (!S.next(0, cur)) return;
    f32x4 acc[2][2][4][2];
#pragma unroll
    for (int a = 0; a < 2; ++a)
#pragma unroll
        for (int b = 0; b < 2; ++b)
#pragma unroll
            for (int m = 0; m < 4; ++m)
#pragma unroll
                for (int n = 0; n < 2; ++n) acc[a][b][m][n] = (f32x4){0.f, 0.f, 0.f, 0.f};
    bf16x8 At[4][2], B0[2][2], B1[2][2];
    const char* cA = (const char*)g.A + (size_t)cur.pm * tstep; const char* cB = (const char*)g.Bt + (size_t)cur.pn * tstep;
    S.a_ready(cur);
    if constexpr (SP2) {
        PG8_STAGE(PG8_SB(0, 0), cB, voffB); PG8_STAGE(PG8_SB(0, 1), cB + hstep, voffB); PG8_STAGE(PG8_SA(0, 0), cA, voffA); PG8_STAGE(PG8_SA(0, 1), cA + hstep, voffA);
        if (wr == 1) PG8_BAR;
        PG8_WAIT_V(2); PG8_BAR;
        PG8_STAGE(PG8_SB(1, 0), cB + kstep, voffB); PG8_STAGE(PG8_SA(1, 0), cA + kstep, voffA); PG8_STAGE(PG8_SB(1, 1), cB + hstep + kstep, voffB);
        PG8_WAIT_V(6); PG8_BAR;
    } else {
        PG8_STAGE(PG8_SB(0, 0), cB, voffB); PG8_STAGE(PG8_SA(0, 0), cA, voffA); PG8_STAGE(PG8_SB(0, 1), cB + hstep, voffB); PG8_STAGE(PG8_SA(0, 1), cA + hstep, voffA);
        if (wr == 1) PG8_BAR;
        PG8_WAIT_V(4); PG8_BAR;
        PG8_STAGE(PG8_SB(1, 0), cB + kstep, voffB); PG8_STAGE(PG8_SA(1, 0), cA + kstep, voffA); PG8_STAGE(PG8_SB(1, 1), cB + hstep + kstep, voffB);
        PG8_WAIT_V(6); PG8_BAR;
    }
    for (;;) {
        const bool has_next = S.next(ui + 1, nxt);
        const char* nA = has_next ? (const char*)g.A + (size_t)nxt.pm * tstep : cA; const char* nB = has_next ? (const char*)g.Bt + (size_t)nxt.pn * tstep : cB;
        for (int t = 0; t < nt; t += 2) {
            const bool last = (t == nt - 2);
            const char* a1 = cA + (size_t)(t + 1) * kstep;
            const char* a2 = last ? nA : cA + (size_t)(t + 2) * kstep; const char* b2 = last ? nB : cB + (size_t)(t + 2) * kstep;
            const char* a3 = a2 + kstep; const char* b3 = b2 + kstep;
            if (last && has_next) S.a_ready(nxt);
            if constexpr (SP2) {
            PG8_LDB(B0, 0, 0); PG8_LDB(B1, 0, 1); PG8_SCHED; PG8_LDA(At, 0, 0); PG8_STAGE(PG8_SA(1, 1), a1 + hstep, voffA);
            PG8_WAIT_V(8); PG8_WAIT_L(0); PG8_BAR; PG8_MMA(0, 0, At, B0); PG8_MMA(0, 1, At, B1); PG8_BAR; PG8_SCHED;
            PG8_LDA(At, 0, 1); PG8_STAGE(PG8_SB(0, 0), b2, voffB); PG8_STAGE(PG8_SB(0, 1), b2 + hstep, voffB); PG8_STAGE(PG8_SA(0, 0), a2, voffA);
            PG8_WAIT_V(8); PG8_WAIT_L(0); PG8_BAR; PG8_MMA(1, 0, At, B0); PG8_MMA(1, 1, At, B1); PG8_BAR; PG8_SCHED;
            PG8_LDB(B0, 1, 0); PG8_LDB(B1, 1, 1); PG8_SCHED; PG8_LDA(At, 1, 0); PG8_STAGE(PG8_SA(0, 1), a2 + hstep, voffA);
            PG8_WAIT_V(8); PG8_WAIT_L(0); PG8_BAR; PG8_MMA(0, 0, At, B0); PG8_MMA(0, 1, At, B1); PG8_BAR; PG8_SCHED;
            PG8_LDA(At, 1, 1); PG8_STAGE(PG8_SB(1, 0), b3, voffB); PG8_STAGE(PG8_SB(1, 1), b3 + hstep, voffB); PG8_STAGE(PG8_SA(1, 0), a3, voffA);
            PG8_WAIT_V(8); PG8_WAIT_L(0); PG8_BAR; PG8_MMA(1, 0, At, B0); PG8_MMA(1, 1, At, B1); PG8_BAR; PG8_SCHED;
            } else {
            PG8_LDB(B0, 0, 0); PG8_SCHED; PG8_LDA(At, 0, 0); PG8_STAGE(PG8_SA(1, 1), a1 + hstep, voffA);
            PG8_WAIT_L(8); PG8_BAR; PG8_WAIT_L(0); PG8_MMA(0, 0, At, B0); PG8_BAR; PG8_SCHED;
            PG8_LDB(B1, 0, 1); PG8_STAGE(PG8_SB(0, 0), b2, voffB);
            PG8_BAR; PG8_WAIT_L(0); PG8_MMA(0, 1, At, B1); PG8_BAR;
            PG8_LDA(At, 0, 1); PG8_STAGE(PG8_SA(0, 0), a2, voffA);
            PG8_BAR; PG8_WAIT_L(0); PG8_MMA(1, 0, At, B0); PG8_BAR; PG8_SCHED;
            PG8_STAGE(PG8_SB(0, 1), b2 + hstep, voffB);
            PG8_WAIT_V(6); PG8_BAR; PG8_MMA(1, 1, At, B1); PG8_BAR;
            PG8_LDB(B0, 1, 0); PG8_SCHED; PG8_LDA(At, 1, 0); PG8_STAGE(PG8_SA(0, 1), a2 + hstep, voffA);
            PG8_WAIT_L(8); PG8_BAR; PG8_WAIT_L(0); PG8_MMA(0, 0, At, B0); PG8_BAR; PG8_SCHED;
            PG8_LDB(B1, 1, 1); PG8_STAGE(PG8_SB(1, 0), b3, voffB);
            PG8_BAR; PG8_WAIT_L(0); PG8_MMA(0, 1, At, B1); PG8_BAR;
            PG8_LDA(At, 1, 1); PG8_STAGE(PG8_SA(1, 0), a3, voffA);
            PG8_BAR; PG8_WAIT_L(0); PG8_MMA(1, 0, At, B0); PG8_BAR; PG8_SCHED;
            PG8_STAGE(PG8_SB(1, 1), b3 + hstep, voffB);
            PG8_WAIT_V(6); PG8_BAR; PG8_MMA(1, 1, At, B1); PG8_BAR;
            }
        }
        if constexpr (ALIGN_EPI) { if (wr == 0) PG8_BAR; }
        if constexpr (!Epi::AFTER_DRAIN) { E(acc, cur, wr, wc, fr, fq); S.done(cur); }
        if (!has_next) break;
#pragma unroll
        for (int a = 0; a < 2; ++a)
#pragma unroll
            for (int b = 0; b < 2; ++b)
#pragma unroll
                for (int m = 0; m < 4; ++m)
#pragma unroll
                    for (int n = 0; n < 2; ++n) acc[a][b][m][n] = (f32x4){0.f, 0.f, 0.f, 0.f};
        cur = nxt; cA = nA; cB = nB; ++ui;
        if constexpr (ALIGN_EPI) { if (wr == 1) PG8_BAR; }
    }
    PG8_WAIT_V(0);
    if constexpr (!ALIGN_EPI) { if (wr == 0) PG8_BAR; }
    PG8_BAR;
    if constexpr (Epi::AFTER_DRAIN) { E.fused(acc, cur, wr, wc, fr, fq, lds, wid, lane); S.done(cur); }
#undef PG8_SA
#undef PG8_SB
#undef PG8_STAGE
#undef PG8_LDA
#undef PG8_LDB
#undef PG8_MMA
#undef PG8_WAIT_V
#undef PG8_WAIT_L
#undef PG8_BAR
#undef PG8_SCHED
}
}

#define LAS __attribute__((address_space(3)))
typedef unsigned short bf16_t;
typedef short bf16x8 __attribute__((ext_vector_type(8)));
typedef float f32x2 __attribute__((ext_vector_type(2)));
typedef float f32x4 __attribute__((ext_vector_type(4)));
typedef float f32x16 __attribute__((ext_vector_type(16)));
typedef unsigned u32x2 __attribute__((ext_vector_type(2)));
typedef unsigned u32x4 __attribute__((ext_vector_type(4)));
typedef __bf16 bf16x2_t __attribute__((ext_vector_type(2)));

constexpr int S = 16384, D = 2048, NLAYER = 2, HLD = 4096, DFF = 5632, INC = 3904;
constexpr int C_CQ = 0, C_CKV = 512, C_KR = 768, C_MQ = 832, C_MK = 1344, C_MV = 1856, C_CONV = 2368, C_POOL = 3392;
constexpr float EPS = 1e-5f, ALPHA = 1.41421356237309515f, LOG2E = 1.4426950408889634f;
constexpr float CQ_SCALE = 0.07216878364870323f * LOG2E;
constexpr float CM_SCALE = 0.08838834764831845f * LOG2E;
constexpr int NT = 512, NWV = 8;
constexpr int LDS_BYTES = 147456, LDS_MISC = 131072;

constexpr size_t MiB = (size_t)1 << 20;
constexpr size_t WS_CTL = 0, CTL_BYTES = 1 * MiB;
constexpr size_t WS_WIN = 1 * MiB, WS_WUQ = 17 * MiB, WS_WUKV = 18 * MiB, WS_WPW = 19 * MiB, WS_WPOOL = 20 * MiB, WS_WOUT = 21 * MiB, WS_WGU = 29 * MiB, WS_WDN = 73 * MiB;
constexpr size_t WS_ROPE_MLA = 95 * MiB, WS_ROPE_MOBA = 99 * MiB, WS_STATS = 101 * MiB;
constexpr size_t WS_Y = 102 * MiB, WS_XB = 230 * MiB;
constexpr size_t WS_CQN = 230 * MiB, WS_CKVN = 246 * MiB, WS_KPE = 254 * MiB, WS_CONVA = 256 * MiB, WS_POOLED = 272 * MiB;
constexpr size_t WS_H = 294 * MiB;
constexpr size_t WS_Q = 294 * MiB, WS_K = 318 * MiB, WS_VT = 342 * MiB, WS_CONCAT = 358 * MiB;
constexpr size_t WS_MQ = 422 * MiB, WS_MK = 438 * MiB, WS_MVT = 454 * MiB;
constexpr size_t WS_VR = 470 * MiB;
constexpr size_t WS_ACT = 294 * MiB, WS_END = 486 * MiB;
constexpr int CW_LAYER = 33792, CW_QCTR = 0, CW_KPEMAX = 1, CW_KNPIECE = 4, CW_KMMAX = 20, CW_CNT = 64, CW_KMEAN = 1024;

struct Params { const float* in[22]; float* out; unsigned char* ws; };

__device__ __forceinline__ unsigned f2bf(float f) { unsigned u = __float_as_uint(f); return (u + 0x7fffu + ((u >> 16) & 1u)) >> 16; }
__device__ __forceinline__ float bf2f(unsigned h) { return __uint_as_float(h << 16); }
__device__ __forceinline__ unsigned pk2(float lo, float hi) { f32x2 v = {lo, hi}; bf16x2_t b = __builtin_convertvector(v, bf16x2_t); return __builtin_bit_cast(unsigned, b); }
__device__ __forceinline__ float wave_sum(float v) {
#pragma unroll
    for (int o = 1; o < 64; o <<= 1) v += __shfl_xor(v, o);
    return v;
}
__device__ __forceinline__ float sigmoidf_(float x) { return __builtin_amdgcn_rcpf(1.f + __expf(-x)); }

typedef const pg8::f32x4 (&AccRef)[2][2][4][2];

struct EpiStore {
    static constexpr bool PERM = true, AFTER_DRAIN = false;
    bf16_t* O; int ldc;
    __device__ __forceinline__ void operator()(AccRef acc, const pg8::Unit& u, int wr, int wc, int fr, int fq) const {
        const int row0 = u.pm * 256 + wr * 64 + fr, col0 = u.pn * 256 + wc * 32 + 8 * fq;
#pragma unroll
        for (int ai = 0; ai < 2; ++ai)
#pragma unroll
            for (int m = 0; m < 4; ++m) { bf16_t* rowp = O + (size_t)(row0 + ai * 128 + m * 16) * ldc + col0;
#pragma unroll
                for (int bj = 0; bj < 2; ++bj) { const f32x4 v0 = acc[ai][bj][m][0], v1 = acc[ai][bj][m][1];
                    u32x4 w; w.x = pk2(v0[0], v0[1]); w.y = pk2(v0[2], v0[3]); w.z = pk2(v1[0], v1[1]); w.w = pk2(v1[2], v1[3]);
                    *(u32x4*)(rowp + bj * 128) = w; } }
    }
};

struct EpiQ {
    static constexpr bool PERM = true, AFTER_DRAIN = false;
    bf16_t* O; const float* rope;
    __device__ __forceinline__ void operator()(AccRef acc, const pg8::Unit& u, int wr, int wc, int fr, int fq) const {
        const int row0 = u.pm * 256 + wr * 64 + fr;
#pragma unroll
        for (int bj = 0; bj < 2; ++bj) {
            const int c0 = u.pn * 256 + bj * 128 + wc * 32 + 8 * fq; const int d0 = c0 % 192; const bool rp = d0 >= 128; const int j0 = (d0 - 128) >> 1;
#pragma unroll
            for (int ai = 0; ai < 2; ++ai)
#pragma unroll
                for (int m = 0; m < 4; ++m) { const int row = row0 + ai * 128 + m * 16;
                    f32x4 v0 = acc[ai][bj][m][0] * CQ_SCALE, v1 = acc[ai][bj][m][1] * CQ_SCALE;
                    if (rp) { const f32x4 t0 = *(const f32x4*)(rope + ((size_t)row * 32 + j0) * 2), t1 = *(const f32x4*)(rope + ((size_t)row * 32 + j0 + 2) * 2);
                        f32x4 a, b;
                        a[0] = v0[0] * t0[0] - v0[1] * t0[1]; a[1] = v0[0] * t0[1] + v0[1] * t0[0];
                        a[2] = v0[2] * t0[2] - v0[3] * t0[3]; a[3] = v0[2] * t0[3] + v0[3] * t0[2];
                        b[0] = v1[0] * t1[0] - v1[1] * t1[1]; b[1] = v1[0] * t1[1] + v1[1] * t1[0];
                        b[2] = v1[2] * t1[2] - v1[3] * t1[3]; b[3] = v1[2] * t1[3] + v1[3] * t1[2];
                        v0 = a; v1 = b; }
                    u32x4 w; w.x = pk2(v0[0], v0[1]); w.y = pk2(v0[2], v0[3]); w.z = pk2(v1[0], v1[1]); w.w = pk2(v1[2], v1[3]);
                    *(u32x4*)(O + (size_t)row * 768 + c0) = w; }
        }
    }
};

struct EpiKV {
    static constexpr bool PERM = true, AFTER_DRAIN = false;
    bf16_t* K; bf16_t* VR; const bf16_t* KPE; unsigned* piece;
    __device__ __forceinline__ void operator()(AccRef acc, const pg8::Unit& u, int wr, int wc, int fr, int fq) const {
        const int row0 = u.pm * 256 + wr * 64 + fr, cc = wc * 32 + 8 * fq, hd = u.pn;
        float pmax = 0.f;
#pragma unroll
        for (int ai = 0; ai < 2; ++ai)
#pragma unroll
            for (int m = 0; m < 4; ++m) { const int row = row0 + ai * 128 + m * 16;
                { const f32x4 v0 = acc[ai][0][m][0], v1 = acc[ai][0][m][1];
                  u32x4 w; w.x = pk2(v0[0], v0[1]); w.y = pk2(v0[2], v0[3]); w.z = pk2(v1[0], v1[1]); w.w = pk2(v1[2], v1[3]);
                  *(u32x4*)(K + (size_t)row * 768 + hd * 192 + cc) = w;
                  float ss = (v0[0] * v0[0] + v0[1] * v0[1]) + (v0[2] * v0[2] + v0[3] * v0[3]) + (v1[0] * v1[0] + v1[1] * v1[1]) + (v1[2] * v1[2] + v1[3] * v1[3]);
                  ss += __shfl_xor(ss, 16); ss += __shfl_xor(ss, 32); pmax = fmaxf(pmax, ss); }
                { const f32x4 v0 = acc[ai][1][m][0], v1 = acc[ai][1][m][1];
                  u32x4 w; w.x = pk2(v0[0], v0[1]); w.y = pk2(v0[2], v0[3]); w.z = pk2(v1[0], v1[1]); w.w = pk2(v1[2], v1[3]);
                  *(u32x4*)(VR + (size_t)row * 512 + hd * 128 + cc) = w; }
                if (wc < 2) *(u32x4*)(K + (size_t)row * 768 + hd * 192 + 128 + cc) = *(const u32x4*)(KPE + (size_t)row * 64 + cc); }
#pragma unroll
        for (int o = 1; o < 16; o <<= 1) pmax = fmaxf(pmax, __shfl_xor(pmax, o));
        if ((threadIdx.x & 63) == 0) atomicMax(piece + hd * 4 + wc, __float_as_uint(pmax));
    }
};
__device__ __forceinline__ void vt_tile(const bf16_t* VR, bf16_t* VT, int pm, int pn) {
    int tid = threadIdx.x; asm volatile("" : "+v"(tid));
    const int dv = tid & 127, seg = tid >> 7; const int t0 = 256 * pm + 64 * seg;
    const bf16_t* src = VR + (size_t)t0 * 512 + pn * 128 + dv; unsigned pk[32];
#pragma unroll
    for (int i = 0; i < 32; ++i) pk[i] = (unsigned)src[(size_t)(2 * i) * 512] | ((unsigned)src[(size_t)(2 * i + 1) * 512] << 16);
    u32x4* dst = (u32x4*)(VT + (size_t)(pn * 128 + dv) * S + t0);
#pragma unroll
    for (int i = 0; i < 8; ++i) dst[i] = (u32x4){pk[4 * i], pk[4 * i + 1], pk[4 * i + 2], pk[4 * i + 3]};
}

template <int MODE>
struct EpiRes {
    static constexpr bool PERM = true, AFTER_DRAIN = false;
    const float* xin; float* Y; const float* stats; const float* g; const float* b;
    __device__ __forceinline__ void operator()(AccRef acc, const pg8::Unit& u, int wr, int wc, int fr, int fq) const {
        const int row0 = u.pm * 256 + wr * 64 + fr, col0 = u.pn * 256 + wc * 32 + 8 * fq;
#pragma unroll
        for (int bj = 0; bj < 2; ++bj) { const int col = col0 + bj * 128;
            f32x4 g0, g1, b0, b1;
            if (MODE == 1) { g0 = *(const f32x4*)(g + col); g1 = *(const f32x4*)(g + col + 4); b0 = *(const f32x4*)(b + col); b1 = *(const f32x4*)(b + col + 4); }
#pragma unroll
            for (int ai = 0; ai < 2; ++ai)
#pragma unroll
                for (int m = 0; m < 4; ++m) { const int row = row0 + ai * 128 + m * 16; const size_t off = (size_t)row * D + col;
                    f32x4 r0, r1;
                    if (MODE == 0) { r0 = *(const f32x4*)(xin + off); r1 = *(const f32x4*)(xin + off + 4); }
                    else { const f32x2 st = *(const f32x2*)(stats + (size_t)row * 2); r0 = *(const f32x4*)(Y + off); r1 = *(const f32x4*)(Y + off + 4);
                        r0 = (r0 - st.x) * st.y * g0 + b0; r1 = (r1 - st.x) * st.y * g1 + b1; }
                    *(f32x4*)(Y + off) = r0 * ALPHA + acc[ai][bj][m][0]; *(f32x4*)(Y + off + 4) = r1 * ALPHA + acc[ai][bj][m][1]; }
        }
    }
};

struct EpiFfn {
    static constexpr bool PERM = true, AFTER_DRAIN = false;
    bf16_t* O;
    __device__ __forceinline__ void operator()(AccRef acc, const pg8::Unit& u, int wr, int wc, int fr, int fq) const {
        const int row0 = u.pm * 256 + wr * 64 + fr, col0 = u.pn * 128 + wc * 32 + 8 * fq;
#pragma unroll
        for (int ai = 0; ai < 2; ++ai)
#pragma unroll
            for (int m = 0; m < 4; ++m) { const int row = row0 + ai * 128 + m * 16;
                float r[8];
#pragma unroll
                for (int n = 0; n < 2; ++n)
#pragma unroll
                    for (int e = 0; e < 4; ++e) { const float gt = acc[ai][0][m][n][e], up = acc[ai][1][m][n][e]; r[n * 4 + e] = gt * sigmoidf_(gt) * up; }
                u32x4 w; w.x = pk2(r[0], r[1]); w.y = pk2(r[2], r[3]); w.z = pk2(r[4], r[5]); w.w = pk2(r[6], r[7]);
                *(u32x4*)(O + (size_t)row * DFF + col0) = w; }
    }
};

#define GEMM_CALL(EPIT, E, A_, B_, N_, K_, CID) do { pg8::Gemm g_{(const bf16_t*)(A_), (const bf16_t*)(B_), S, (N_), (K_)}; pg8::StaticOrder so_; so_.init(S, (N_), G, (CID)); \
    pg8::gemm_phase<EPIT, pg8::StaticOrder, true, true>(lds, g_, so_, (E)); } while (0)

struct TrSpec { const float* W; int ldn, K, N; bf16_t* WT; int ldk, mode; const float* sk; const float* sn; };
__device__ __forceinline__ int drow_of(int mode, int n) {
    if (mode == 1) { const int hd = n / 192, d = n - hd * 192; if (d < 128) return n; const int e = d - 128; return hd * 192 + 128 + 2 * (e & 31) + (e >> 5); }
    if (mode == 4) return ((n >> 7) << 8) + (n & 127);
    if (mode == 5) return ((n >> 7) << 8) + 128 + (n & 127);
    return n;
}
__device__ __forceinline__ void transpose_items(const TrSpec& t, LAS float* scr, int gw, int ngw, int lane) {
    const int nblk = t.N / 32, nitems = (t.K / 64) * nblk;
    for (int it = gw; it < nitems; it += ngw) {
        const int kb = it / nblk, nb = it - kb * nblk, k0 = 64 * kb, n0 = 32 * nb;
        const float snv = t.sn ? t.sn[n0 + (lane & 31)] : 1.f;
#pragma unroll 8
        for (int i = 0; i < 32; ++i) { const int kk = 2 * i + (lane >> 5); float v = t.W[(size_t)(k0 + kk) * t.ldn + n0 + (lane & 31)]; if (t.sk) v *= t.sk[k0 + kk]; scr[kk * 33 + (lane & 31)] = v * snv; }
        asm volatile("s_waitcnt lgkmcnt(0)" ::: "memory");
        const int c = lane & 7;
#pragma unroll
        for (int j = 0; j < 4; ++j) { const int n = (lane >> 3) + 8 * j; const LAS float* s = scr + (8 * c) * 33 + n;
            u32x4 o; o.x = pk2(s[0 * 33], s[1 * 33]); o.y = pk2(s[2 * 33], s[3 * 33]); o.z = pk2(s[4 * 33], s[5 * 33]); o.w = pk2(s[6 * 33], s[7 * 33]);
            *(u32x4*)(t.WT + (size_t)drow_of(t.mode, n0 + n) * t.ldk + k0 + 8 * c) = o; }
        asm volatile("s_waitcnt lgkmcnt(0)" ::: "memory");
    }
}
__device__ __forceinline__ void prep_weights(const Params& P, int l, LAS unsigned char* lds, int G) {
    int tid_l = threadIdx.x; asm volatile("" : "+v"(tid_l)); const int tid = tid_l, lane = tid & 63, wave = tid >> 6;
    const int gw = blockIdx.x * NWV + wave, ngw = G * NWV;
    LAS float* scr = (LAS float*)(lds + wave * 16384);
    unsigned char* ws = P.ws;
    TrSpec t;
    t = TrSpec{P.in[2] + (size_t)l * D * INC, INC, D, INC, (bf16_t*)(ws + WS_WIN), D, 0, nullptr, nullptr}; transpose_items(t, scr, gw, ngw, lane);
    t = TrSpec{P.in[4] + (size_t)l * 512 * 768, 768, 512, 768, (bf16_t*)(ws + WS_WUQ), 512, 1, P.in[3] + l * 512, nullptr}; transpose_items(t, scr, gw, ngw, lane);
    t = TrSpec{P.in[6] + (size_t)l * 256 * 1024, 1024, 256, 1024, (bf16_t*)(ws + WS_WUKV), 256, 0, P.in[5] + l * 256, nullptr}; transpose_items(t, scr, gw, ngw, lane);
    t = TrSpec{P.in[11] + (size_t)l * 512 * 512, 512, 512, 512, (bf16_t*)(ws + WS_WPW), 512, 0, nullptr, nullptr}; transpose_items(t, scr, gw, ngw, lane);
#pragma unroll 1
    for (int g = 0; g < 4; ++g) { t = TrSpec{P.in[12] + (size_t)(l * 4 + g) * 128 * 128, 128, 128, 128, (bf16_t*)(ws + WS_WPOOL) + (size_t)(g * 128) * 512 + g * 128, 512, 0, nullptr, P.in[13] + l * 512 + g * 128};
        transpose_items(t, scr, gw, ngw, lane); }
    t = TrSpec{P.in[14] + (size_t)l * D * D, D, D, D, (bf16_t*)(ws + WS_WOUT), D, 0, nullptr, nullptr}; transpose_items(t, scr, gw, ngw, lane);
    t = TrSpec{P.in[17] + (size_t)l * D * DFF, DFF, D, DFF, (bf16_t*)(ws + WS_WGU), D, 4, nullptr, nullptr}; transpose_items(t, scr, gw, ngw, lane);
    t = TrSpec{P.in[18] + (size_t)l * D * DFF, DFF, D, DFF, (bf16_t*)(ws + WS_WGU), D, 5, nullptr, nullptr}; transpose_items(t, scr, gw, ngw, lane);
    t = TrSpec{P.in[19] + (size_t)l * DFF * D, D, DFF, D, (bf16_t*)(ws + WS_WDN), DFF, 0, nullptr, nullptr}; transpose_items(t, scr, gw, ngw, lane);
    const int gt = blockIdx.x * NT + tid, ngt = G * NT; const u32x4 z = {0u, 0u, 0u, 0u};
    { u32x4* p = (u32x4*)((bf16_t*)(ws + WS_WIN) + (size_t)INC * D); for (int i = gt; i < 192 * D / 8; i += ngt) p[i] = z; }
    { u32x4* p = (u32x4*)(ws + WS_WPOOL); for (int i = gt; i < 512 * 512 / 8; i += ngt) { const int row = i >> 6, col = (i & 63) * 8; if ((row >> 7) != (col >> 7)) p[i] = z; } }
}
__device__ __forceinline__ void prep_layer0(const Params& P, int G) {
    int tid_l = threadIdx.x; asm volatile("" : "+v"(tid_l)); const int gt = blockIdx.x * NT + tid_l, ngt = G * NT;
    const f32x4* x4 = (const f32x4*)P.in[0]; u32x4* xb = (u32x4*)(P.ws + WS_XB);
    for (int i = gt; i < S * D / 8; i += ngt) { const f32x4 a = x4[2 * i], b = x4[2 * i + 1]; u32x4 w; w.x = pk2(a[0], a[1]); w.y = pk2(a[2], a[3]); w.z = pk2(b[0], b[1]); w.w = pk2(b[2], b[3]); xb[i] = w; }
    const int* pos = (const int*)P.in[1];
    f32x2* rm = (f32x2*)(P.ws + WS_ROPE_MLA); f32x2* ro = (f32x2*)(P.ws + WS_ROPE_MOBA);
    const double L2T = 18.931568569324174;
    for (int i = gt; i < S * 48; i += ngt) { const int t = i / 48, jj = i - t * 48; const bool mla = jj < 32; const int j = mla ? jj : jj - 32;
        const double invf = exp2(-(mla ? (double)j / 32.0 : (double)j / 16.0) * L2T);
        const double rev = (double)pos[t] * invf * 0.15915494309189535; const float fr = (float)(rev - rint(rev));
        const f32x2 cs = {__builtin_amdgcn_cosf(fr), __builtin_amdgcn_sinf(fr)};
        if (mla) rm[t * 32 + j] = cs; else ro[t * 16 + j] = cs; }
}

template <bool TO_OUT> __device__ __forceinline__ void ln_phase(const float* Y, const float* g, const float* b, float* stats, bf16_t* XB, float* out, int G) {
    int tid_l = threadIdx.x; asm volatile("" : "+v"(tid_l)); const int lane = tid_l & 63, wave = tid_l >> 6;
    for (int row = blockIdx.x * NWV + wave; row < S; row += G * NWV) {
        const f32x4* yr = (const f32x4*)(Y + (size_t)row * D) + lane; f32x4 v[8]; float s = 0.f;
#pragma unroll
        for (int j = 0; j < 8; ++j) { v[j] = yr[64 * j]; s += (v[j][0] + v[j][1]) + (v[j][2] + v[j][3]); }
        const float mean = wave_sum(s) * (1.f / D); float s2 = 0.f;
#pragma unroll
        for (int j = 0; j < 8; ++j) { v[j] = v[j] - mean; s2 += (v[j][0] * v[j][0] + v[j][1] * v[j][1]) + (v[j][2] * v[j][2] + v[j][3] * v[j][3]); }
        const float rstd = rsqrtf(wave_sum(s2) * (1.f / D) + EPS);
        if (!TO_OUT && lane == 0) *(f32x2*)(stats + (size_t)row * 2) = (f32x2){mean, rstd};
#pragma unroll
        for (int j = 0; j < 8; ++j) { const int col = 4 * (lane + 64 * j); const f32x4 o = v[j] * rstd * *(const f32x4*)(g + col) + *(const f32x4*)(b + col);
            if (TO_OUT) *(f32x4*)(out + (size_t)row * D + col) = o;
            else { u32x2 w; w.x = pk2(o[0], o[1]); w.y = pk2(o[2], o[3]); *(u32x2*)(XB + (size_t)row * D + col) = w; } }
    }
}

__device__ __forceinline__ void p2a_phase(const Params& P, int l, LAS unsigned char* lds, int G) {
    int tid_l = threadIdx.x; asm volatile("" : "+v"(tid_l)); const int tid = tid_l, lane = tid & 63, wave = tid >> 6;
    unsigned char* ws = P.ws;
    const bf16_t* H = (const bf16_t*)(ws + WS_H);
    unsigned* ctl = (unsigned*)(ws + WS_CTL) + l * CW_LAYER;
    float* OACC = P.out; float* LACC = P.out + (size_t)S * 1024;
    bf16_t* CQN = (bf16_t*)(ws + WS_CQN); bf16_t* CKVN = (bf16_t*)(ws + WS_CKVN); bf16_t* KPE = (bf16_t*)(ws + WS_KPE);
    bf16_t* CONVA = (bf16_t*)(ws + WS_CONVA); bf16_t* POOLED = (bf16_t*)(ws + WS_POOLED);
    bf16_t* MQ = (bf16_t*)(ws + WS_MQ); bf16_t* MK = (bf16_t*)(ws + WS_MK); bf16_t* MVT = (bf16_t*)(ws + WS_MVT);
    const f32x2* RM = (const f32x2*)(ws + WS_ROPE_MLA); const float* RO = (const float*)(ws + WS_ROPE_MOBA);
    LAS float* ybuf = (LAS float*)lds;
    for (int tile = blockIdx.x; tile < S / 64; tile += G) {
        const int t0 = tile * 64;
        { const f32x4 z = {0.f, 0.f, 0.f, 0.f}; f32x4* o = (f32x4*)(OACC + (size_t)t0 * 1024);
#pragma unroll 4
          for (int i = 0; i < 32; ++i) o[tid + NT * i] = z;
          LACC[t0 * 8 + tid] = 0.f; }
        { float ksum[8]; float kpemax = 0.f, kmmax = 0.f; const int hm = lane & 15;
#pragma unroll
          for (int e = 0; e < 8; ++e) ksum[e] = 0.f;
#pragma unroll 1
          for (int i = 0; i < 8; ++i) {
              const int t = t0 + wave * 8 + i; const bf16_t* hr = H + (size_t)t * HLD;
              { const u32x4 raw = *(const u32x4*)(hr + C_CQ + 8 * lane); float x[8];
                x[0] = bf2f(raw.x & 0xffffu); x[1] = bf2f(raw.x >> 16); x[2] = bf2f(raw.y & 0xffffu); x[3] = bf2f(raw.y >> 16); x[4] = bf2f(raw.z & 0xffffu); x[5] = bf2f(raw.z >> 16); x[6] = bf2f(raw.w & 0xffffu); x[7] = bf2f(raw.w >> 16);
                float ss = 0.f;
#pragma unroll
                for (int e = 0; e < 8; ++e) ss += x[e] * x[e];
                const float rs = rsqrtf(wave_sum(ss) * (1.f / 512.f) + EPS);
                u32x4 w; w.x = pk2(x[0] * rs, x[1] * rs); w.y = pk2(x[2] * rs, x[3] * rs); w.z = pk2(x[4] * rs, x[5] * rs); w.w = pk2(x[6] * rs, x[7] * rs);
                *(u32x4*)(CQN + (size_t)t * 512 + 8 * lane) = w; }
              { const u32x2 raw = *(const u32x2*)(hr + C_CKV + 4 * lane); float x[4];
                x[0] = bf2f(raw.x & 0xffffu); x[1] = bf2f(raw.x >> 16); x[2] = bf2f(raw.y & 0xffffu); x[3] = bf2f(raw.y >> 16);
                const float ss = (x[0] * x[0] + x[1] * x[1]) + (x[2] * x[2] + x[3] * x[3]);
                const float rs = rsqrtf(wave_sum(ss) * (1.f / 256.f) + EPS);
                u32x2 w; w.x = pk2(x[0] * rs, x[1] * rs); w.y = pk2(x[2] * rs, x[3] * rs);
                *(u32x2*)(CKVN + (size_t)t * 256 + 4 * lane) = w; }
              { const int j = lane & 31; const float x1 = bf2f(hr[C_KR + j]), x2 = bf2f(hr[C_KR + 32 + j]); const f32x2 cs = RM[t * 32 + j];
                const float o1 = x1 * cs.x - x2 * cs.y, o2 = x1 * cs.y + x2 * cs.x;
                if (lane < 32) *(unsigned*)(KPE + (size_t)t * 64 + 2 * j) = pk2(o1, o2);
                const float n2 = wave_sum(lane < 32 ? o1 * o1 + o2 * o2 : 0.f); kpemax = fmaxf(kpemax, n2); }
#pragma unroll
              for (int which = 0; which < 2; ++which) {
                  const u32x4 raw = *(const u32x4*)(hr + (which ? C_MK : C_MQ) + 8 * lane); float x[8], px[8];
                  x[0] = bf2f(raw.x & 0xffffu); x[1] = bf2f(raw.x >> 16); x[2] = bf2f(raw.y & 0xffffu); x[3] = bf2f(raw.y >> 16); x[4] = bf2f(raw.z & 0xffffu); x[5] = bf2f(raw.z >> 16); x[6] = bf2f(raw.w & 0xffffu); x[7] = bf2f(raw.w >> 16);
#pragma unroll
                  for (int e = 0; e < 8; ++e) px[e] = __shfl_xor(x[e], 2);
                  if (hm < 4) { const f32x4* tp = (const f32x4*)(RO + ((size_t)t * 16 + 8 * (hm & 1)) * 2);
#pragma unroll
                      for (int e2 = 0; e2 < 4; ++e2) { const f32x4 cs = tp[e2];
                          if (hm < 2) { x[2 * e2] = x[2 * e2] * cs[0] - px[2 * e2] * cs[1]; x[2 * e2 + 1] = x[2 * e2 + 1] * cs[2] - px[2 * e2 + 1] * cs[3]; }
                          else { x[2 * e2] = px[2 * e2] * cs[1] + x[2 * e2] * cs[0]; x[2 * e2 + 1] = px[2 * e2 + 1] * cs[3] + x[2 * e2 + 1] * cs[2]; } } }
                  if (which == 0) { u32x4 w; w.x = pk2(x[0] * CM_SCALE, x[1] * CM_SCALE); w.y = pk2(x[2] * CM_SCALE, x[3] * CM_SCALE); w.z = pk2(x[4] * CM_SCALE, x[5] * CM_SCALE); w.w = pk2(x[6] * CM_SCALE, x[7] * CM_SCALE);
                      *(u32x4*)(MQ + (size_t)t * 512 + 8 * lane) = w; }
                  else { u32x4 w; w.x = pk2(x[0], x[1]); w.y = pk2(x[2], x[3]); w.z = pk2(x[4], x[5]); w.w = pk2(x[6], x[7]);
                      *(u32x4*)(MK + (size_t)t * 512 + 8 * lane) = w;
                      float n2 = 0.f;
#pragma unroll
                      for (int e = 0; e < 8; ++e) { ksum[e] += x[e]; n2 += x[e] * x[e]; }
                      n2 += __shfl_xor(n2, 1); n2 += __shfl_xor(n2, 2); n2 += __shfl_xor(n2, 4); n2 += __shfl_xor(n2, 8); kmmax = fmaxf(kmmax, n2); }
              }
          }
          float* km = (float*)(ctl + CW_KMEAN) + ((size_t)((lane >> 4) * 64 + (t0 >> 8)) * 128 + 8 * hm);
#pragma unroll
          for (int e = 0; e < 8; ++e) unsafeAtomicAdd(km + e, ksum[e]);
          if (lane == 0) atomicMax(ctl + CW_KPEMAX, __float_as_uint(kpemax));
          if (hm == 0) atomicMax(ctl + CW_KMMAX + (lane >> 4), __float_as_uint(kmmax)); }
        { const int c = tid;
          { const bf16_t* src = H + (size_t)t0 * HLD + C_MV + c; unsigned pk[32];
#pragma unroll
            for (int i = 0; i < 32; ++i) pk[i] = (unsigned)src[(size_t)(2 * i) * HLD] | ((unsigned)src[(size_t)(2 * i + 1) * HLD] << 16);
            u32x4* dst = (u32x4*)(MVT + (size_t)c * S + t0);
#pragma unroll
            for (int i = 0; i < 8; ++i) dst[i] = (u32x4){pk[4 * i], pk[4 * i + 1], pk[4 * i + 2], pk[4 * i + 3]}; }
          { const int w = 2 << (c >> 7); const bf16_t* src = H + C_POOL + c; float s = 0.f;
            for (int p = t0 - w; p < t0; ++p) if (p >= 0) s += bf2f(src[(size_t)p * HLD]);
#pragma unroll 4
            for (int i = 0; i < 64; ++i) { const int t = t0 + i; const float ut = bf2f(src[(size_t)t * HLD]); s += ut; if (t - w >= 0) s -= bf2f(src[(size_t)(t - w) * HLD]);
                const float cnt = (float)(t + 1 < w ? t + 1 : w);
                POOLED[(size_t)t * 512 + c] = (bf16_t)f2bf(s / cnt - ut); } }
          { const float* dw = P.in[7] + (size_t)l * 31 * 512 + c; float w[31];
#pragma unroll
            for (int j = 0; j < 31; ++j) w[j] = dw[j * 512];
            const float bias = P.in[8][l * 512 + c]; const bf16_t* src = H + C_CONV + c;
#pragma unroll 1
            for (int ch = 0; ch < 4; ++ch) { float v[46];
#pragma unroll
                for (int i = 0; i < 46; ++i) { const int tt = t0 + 16 * ch - 30 + i; float val = 0.f;
                    if (tt >= 0) { const float a = bf2f(src[(size_t)tt * HLD]), gg = bf2f(src[(size_t)tt * HLD + 512]); val = a * sigmoidf_(gg); }
                    v[i] = val; }
#pragma unroll
                for (int tl = 0; tl < 16; ++tl) { float y = bias;
#pragma unroll
                    for (int j = 0; j < 31; ++j) y = fmaf(w[j], v[tl + j], y);
                    ybuf[(16 * ch + tl) * 512 + c] = y; } } }
        }
        __syncthreads();
        { const float* lg = P.in[9] + l * 512 + 8 * lane; const float* lb = P.in[10] + l * 512 + 8 * lane;
          const f32x4 g0 = *(const f32x4*)lg, g1 = *(const f32x4*)(lg + 4), b0 = *(const f32x4*)lb, b1 = *(const f32x4*)(lb + 4);
#pragma unroll 1
          for (int i = 0; i < 8; ++i) { const int tl = wave * 8 + i; const LAS f32x4* yp = (const LAS f32x4*)(ybuf + tl * 512 + 8 * lane);
              f32x4 y0 = yp[0], y1 = yp[1];
              const float mean = wave_sum((y0[0] + y0[1]) + (y0[2] + y0[3]) + (y1[0] + y1[1]) + (y1[2] + y1[3])) * (1.f / 512.f);
              y0 = y0 - mean; y1 = y1 - mean;
              const float var = wave_sum((y0[0] * y0[0] + y0[1] * y0[1]) + (y0[2] * y0[2] + y0[3] * y0[3]) + (y1[0] * y1[0] + y1[1] * y1[1]) + (y1[2] * y1[2] + y1[3] * y1[3])) * (1.f / 512.f);
              const float rstd = rsqrtf(var + EPS);
              y0 = y0 * rstd * g0 + b0; y1 = y1 * rstd * g1 + b1;
              float r[8];
#pragma unroll
              for (int e = 0; e < 4; ++e) { r[e] = y0[e] * sigmoidf_(y0[e]); r[4 + e] = y1[e] * sigmoidf_(y1[e]); }
              u32x4 wv; wv.x = pk2(r[0], r[1]); wv.y = pk2(r[2], r[3]); wv.z = pk2(r[4], r[5]); wv.w = pk2(r[6], r[7]);
              *(u32x4*)(CONVA + (size_t)(t0 + tl) * 512 + 8 * lane) = wv; } }
        __syncthreads();
    }
}

__device__ __forceinline__ void gate_phase(const Params& P, int l, LAS unsigned char* lds, int G) {
    int tid_l = threadIdx.x; asm volatile("" : "+v"(tid_l)); const int tid = tid_l, lane = tid & 63, wave = tid >> 6;
    unsigned* ctl = (unsigned*)(P.ws + WS_CTL) + l * CW_LAYER;
    const float* kmean = (const float*)(ctl + CW_KMEAN);
    const bf16_t* MQ = (const bf16_t*)(P.ws + WS_MQ);
    int* LIST = (int*)(P.out + (size_t)S * 1024 + (size_t)S * 8);
    LAS float* kmT = (LAS float*)lds;
    __syncthreads();
    for (int idx = tid; idx < 32768; idx += NT) { const int h = idx >> 13, b = (idx >> 7) & 63, d = idx & 127; kmT[(h * 128 + d) * 64 + b] = kmean[idx] * (1.f / 256.f); }
    __syncthreads();
    for (int tile = blockIdx.x; tile < S / 64; tile += G) {
#pragma unroll 1
        for (int i = 0; i < 8; ++i) { const int t = tile * 64 + wave * 8 + i; const int own = t >> 8;
            if (own == 0) continue;
#pragma unroll 1
            for (int h = 0; h < 4; ++h) {
                const unsigned qv = *(const unsigned*)(MQ + (size_t)t * 512 + h * 128 + 2 * lane);
                float ga = 0.f, gb = 0.f; const LAS float* kp = kmT + h * 128 * 64 + lane;
#pragma unroll
                for (int j = 0; j < 64; ++j) { const unsigned wq = (unsigned)__builtin_amdgcn_readlane((int)qv, j);
                    ga = fmaf(bf2f(wq & 0xffffu), kp[(2 * j) * 64], ga); gb = fmaf(bf2f(wq >> 16), kp[(2 * j + 1) * 64], gb); }
                float val = lane < own ? ga + gb : -INFINITY;
                const int npick = own < 3 ? own : 3;
                for (int p = 0; p < npick; ++p) { float bv = val; int bi = lane;
#pragma unroll
                    for (int off = 32; off >= 1; off >>= 1) { const float ov = __shfl_xor(bv, off); const int oi = __shfl_xor(bi, off); if (ov > bv || (ov == bv && oi < bi)) { bv = ov; bi = oi; } }
                    if (lane == 0) { const int slot = (int)atomicAdd(ctl + CW_CNT + h * 64 + bi, 1u); LIST[(size_t)(h * 64 + bi) * S + slot] = t; }
                    if (lane == bi) val = -INFINITY; }
            }
        }
    }
    __syncthreads();
}

template <int DK>
__device__ __forceinline__ void attn_item(const int tid, LAS unsigned char* lds, const bf16_t* Qb, int ldq, int qrow, bool qvalid, int qpos, int wqmin,
                                          const bf16_t* Kp, int ldk, const bf16_t* VT, int key0, int ntiles,
                                          float kmaxA, float kmaxB, float* OACC, float* LACC, int hslot) {
    constexpr int NKS = DK / 16, SPRK = DK / 8 + 1, KSTR = SPRK * 16, NKI = SPRK, KBYTES = NKI * 1024, VSTR = 144, NVI = 18, BUF = KBYTES + NVI * 1024, KW = (DK == 192 ? 5 : 4), NII = 6;
    const int lane = tid & 63, r = lane & 31, hh = lane >> 5, wave = __builtin_amdgcn_readfirstlane(tid >> 6);
    bf16x8 qf[NKS];
    { const bf16_t* qp = Qb + (size_t)qrow * ldq + 8 * hh;
#pragma unroll
      for (int ks = 0; ks < NKS; ++ks) qf[ks] = *(const bf16x8*)(qp + 16 * ks); }
    float na = 0.f, nb = 0.f;
#pragma unroll
    for (int ks = 0; ks < NKS; ++ks)
#pragma unroll
        for (int e = 0; e < 8; ++e) { const float f = bf2f((unsigned)(unsigned short)qf[ks][e]); if (ks < 8) na += f * f; else nb += f * f; }
    na += __shfl_xor(na, 32); nb += __shfl_xor(nb, 32);
    const float negr = -(sqrtf(na) * kmaxA + sqrtf(nb) * kmaxB);
    const bool kwave = wave < KW;
    const int jw = kwave ? wave : wave - KW, jstride = kwave ? KW : 8 - KW, jn = kwave ? NKI : NVI;
    const unsigned char* gbase = kwave ? (const unsigned char*)Kp : (const unsigned char*)VT;
    const unsigned gstep = kwave ? (unsigned)ldk * 128u : 128u, ldst0 = kwave ? 0u : (unsigned)KBYTES;
    unsigned goff[NII];
#pragma unroll
    for (int ii = 0; ii < NII; ++ii) { const int sg = 64 * (jw + jstride * ii) + lane;
        if (kwave) { const int row = sg / SPRK; int part = sg - row * SPRK; if (part == SPRK - 1) part = 0; goff[ii] = (unsigned)(((key0 + row) * ldk + part * 8) * 2); }
        else { const int dv = sg / 9; int part = sg - dv * 9; if (part == 8) part = 0; goff[ii] = (unsigned)((dv * S + key0 + part * 8) * 2); } }
#define AT_DMA(tt, b) do { _Pragma("unroll") for (int ii_ = 0; ii_ < NII; ++ii_) { const int j_ = jw + jstride * ii_; if (j_ < jn) \
        __builtin_amdgcn_global_load_lds((const unsigned*)(gbase + (size_t)(goff[ii_] + (unsigned)(tt) * gstep)), (LAS unsigned*)(lds + (b) * BUF + ldst0 + j_ * 1024), 16, 0, 0); } } while (0)
    AT_DMA(0, 0);
    f32x16 o[4];
#pragma unroll
    for (int d = 0; d < 4; ++d)
#pragma unroll
        for (int i = 0; i < 16; ++i) o[d][i] = 0.f;
    float lsum = 0.f;
    const int pr = (r & 0x13) | ((r & 4) << 1) | ((r & 8) >> 1);
    const unsigned koff = (unsigned)(pr * KSTR + 16 * hh), voff = (unsigned)(KBYTES + r * VSTR + 16 * hh);
    asm volatile("s_waitcnt vmcnt(0)" ::: "memory"); __syncthreads();
#pragma unroll 1
    for (int t = 0; t < ntiles; ++t) {
        const int cur = t & 1;
        if (t + 1 < ntiles) AT_DMA(t + 1, cur ^ 1);
        LAS const unsigned char* bp = lds + cur * BUF;
        bf16x8 pf[2][2];
#pragma unroll
        for (int kb = 0; kb < 2; ++kb) {
            f32x16 acc;
#pragma unroll
            for (int i = 0; i < 16; ++i) acc[i] = negr;
#pragma unroll
            for (int ks = 0; ks < NKS; ++ks) { const bf16x8 kf = *(LAS const bf16x8*)(bp + koff + kb * 32 * KSTR + 32 * ks); acc = __builtin_amdgcn_mfma_f32_32x32x16_bf16(kf, qf[ks], acc, 0, 0, 0); }
            const int kt0 = key0 + 64 * t + 32 * kb + 8 * hh;
            if (key0 + 64 * t + 63 > wqmin) {
#pragma unroll
                for (int i = 0; i < 16; ++i) if (kt0 + 16 * (i >> 3) + (i & 7) > qpos) acc[i] = -INFINITY; }
#pragma unroll
            for (int i = 0; i < 16; ++i) { const float p = __builtin_amdgcn_exp2f(acc[i]); lsum += p; acc[i] = p; }
            u32x4 w0, w1;
            w0.x = pk2(acc[0], acc[1]); w0.y = pk2(acc[2], acc[3]); w0.z = pk2(acc[4], acc[5]); w0.w = pk2(acc[6], acc[7]);
            w1.x = pk2(acc[8], acc[9]); w1.y = pk2(acc[10], acc[11]); w1.z = pk2(acc[12], acc[13]); w1.w = pk2(acc[14], acc[15]);
            pf[kb][0] = __builtin_bit_cast(bf16x8, w0); pf[kb][1] = __builtin_bit_cast(bf16x8, w1);
        }
#pragma unroll
        for (int d = 0; d < 4; ++d)
#pragma unroll
            for (int kb = 0; kb < 2; ++kb)
#pragma unroll
                for (int s = 0; s < 2; ++s) { const bf16x8 vf = *(LAS const bf16x8*)(bp + voff + d * 32 * VSTR + (32 * kb + 16 * s) * 2); o[d] = __builtin_amdgcn_mfma_f32_32x32x16_bf16(vf, pf[kb][s], o[d], 0, 0, 0); }
        asm volatile("s_waitcnt vmcnt(0)" ::: "memory");
        __syncthreads();
    }
#undef AT_DMA
    lsum += __shfl_xor(lsum, 32);
    if (qvalid) { float* orow = OACC + (size_t)qrow * 1024 + hslot * 128 + 4 * hh;
#pragma unroll
        for (int d = 0; d < 4; ++d)
#pragma unroll
            for (int i = 0; i < 16; ++i) unsafeAtomicAdd(orow + 32 * d + (i & 3) + 8 * (i >> 2), o[d][i]);
        if (hh == 0) unsafeAtomicAdd(LACC + (size_t)qrow * 8 + hslot, lsum); }
}

constexpr int N_MLA_ITEMS = 1152, N_OWN_ITEMS = 256, N_FIXED_ITEMS = N_MLA_ITEMS + N_OWN_ITEMS;
__device__ __forceinline__ void attn_phase(const Params& P, int l, LAS unsigned char* lds, int G) {
    const int tid = threadIdx.x, lane = tid & 63, wave = tid >> 6, r = lane & 31;
    unsigned char* ws = P.ws;
    unsigned* ctl = (unsigned*)(ws + WS_CTL) + l * CW_LAYER;
    float* OACC = P.out; float* LACC = P.out + (size_t)S * 1024; const int* LIST = (const int*)(P.out + (size_t)S * 1024 + (size_t)S * 8);
    const bf16_t* Q = (const bf16_t*)(ws + WS_Q); const bf16_t* KK = (const bf16_t*)(ws + WS_K); const bf16_t* VT = (const bf16_t*)(ws + WS_VT);
    const bf16_t* MQ = (const bf16_t*)(ws + WS_MQ); const bf16_t* MK = (const bf16_t*)(ws + WS_MK); const bf16_t* MVT = (const bf16_t*)(ws + WS_MVT);
    LAS int* qidx = (LAS int*)(lds + LDS_MISC); LAS int* pre = (LAS int*)(lds + LDS_MISC + 64);
    __syncthreads();
    if (tid < 256) pre[1 + tid] = (int)((ctl[CW_CNT + tid] + 255u) >> 8);
    __syncthreads();
    if (tid == 0) { pre[0] = 0; int run = 0; for (int i = 0; i < 256; ++i) { run += pre[1 + i]; pre[1 + i] = run; } }
    __syncthreads();
    const int total = N_FIXED_ITEMS + pre[256];
    const float kpemax = sqrtf(__uint_as_float(ctl[CW_KPEMAX]));
    for (;;) {
        if (tid == 0) qidx[0] = (int)atomicAdd(ctl + CW_QCTR, 1u);
        __syncthreads();
        const int idx = qidx[0];
        __syncthreads();
        if (idx >= total) break;
        if (idx < N_MLA_ITEMS) {
            const int h = idx & 3, j = idx >> 2; int qb, t0, nt; bool causal;
            if (j < 224) { int g = 1; while (4 * g * (g + 1) <= j) ++g; const int rem = j - 4 * (g - 1) * g; qb = 8 * g + rem / g; t0 = 32 * (rem % g); nt = 32; causal = false; }
            else { const int jj = j - 224, rr = 7 - (jj >> 3), g = jj & 7; qb = 8 * g + rr; t0 = 32 * g; nt = 4 * (rr + 1); causal = true; }
            const int qrow = 256 * qb + 32 * wave + r;
            const float knmax = sqrtf(__uint_as_float(ctl[CW_KNPIECE + h * 4 + 0]) + __uint_as_float(ctl[CW_KNPIECE + h * 4 + 1]) + __uint_as_float(ctl[CW_KNPIECE + h * 4 + 2]) + __uint_as_float(ctl[CW_KNPIECE + h * 4 + 3]));
            attn_item<192>(tid, lds, Q + h * 192, 768, qrow, true, causal ? qrow : 0x7fffffff, causal ? 256 * qb + 32 * wave : 0x7fffffff,
                           KK + h * 192, 768, VT + (size_t)h * 128 * S, 64 * t0, nt, knmax, kpemax, OACC, LACC, h);
        } else {
            int h, key0, qrow, qpos, wqmin; bool valid = true;
            if (idx < N_FIXED_ITEMS) { const int k = idx - N_MLA_ITEMS; h = k & 3; const int blk = k >> 2; key0 = 256 * blk; qrow = 256 * blk + 32 * wave + r; qpos = qrow; wqmin = 256 * blk + 32 * wave; }
            else { const int g2 = idx - N_FIXED_ITEMS; int lo = 0, hi = 256;
                while (hi - lo > 1) { const int mid = (lo + hi) >> 1; if (pre[mid] <= g2) lo = mid; else hi = mid; }
                const int hb = lo, chunk = g2 - pre[hb]; const int cntv = (int)ctl[CW_CNT + hb]; int nq = cntv - 256 * chunk; nq = nq > 256 ? 256 : nq;
                const int li = 32 * wave + r; valid = li < nq; qrow = LIST[(size_t)hb * S + 256 * chunk + (valid ? li : 0)];
                h = hb >> 6; key0 = 256 * (hb & 63); qpos = 0x7fffffff; wqmin = 0x7fffffff; }
            const float kmmax = sqrtf(__uint_as_float(ctl[CW_KMMAX + h]));
            attn_item<128>(tid, lds, MQ + h * 128, 512, qrow, valid, qpos, wqmin, MK + h * 128, 512, MVT + (size_t)h * 128 * S, key0, 4, kmmax, 0.f, OACC, LACC, 4 + h);
        }
    }
}
__device__ __forceinline__ void attn_norm_phase(const Params& P, int G) {
    int tid_l = threadIdx.x; asm volatile("" : "+v"(tid_l)); const int lane = tid_l & 63, wave = tid_l >> 6;
    const float* OACC = P.out; const float* LACC = P.out + (size_t)S * 1024; bf16_t* CC = (bf16_t*)(P.ws + WS_CONCAT);
    for (int row = blockIdx.x * NWV + wave; row < S; row += G * NWV) {
        const float inv = 1.f / LACC[(size_t)row * 8 + (lane >> 3)]; const f32x4* op = (const f32x4*)(OACC + (size_t)row * 1024 + 16 * lane);
        const f32x4 a = op[0] * inv, b = op[1] * inv, c = op[2] * inv, d = op[3] * inv;
        u32x4 w0, w1; w0.x = pk2(a[0], a[1]); w0.y = pk2(a[2], a[3]); w0.z = pk2(b[0], b[1]); w0.w = pk2(b[2], b[3]); w1.x = pk2(c[0], c[1]); w1.y = pk2(c[2], c[3]); w1.z = pk2(d[0], d[1]); w1.w = pk2(d[2], d[3]);
        u32x4* dst = (u32x4*)(CC + (size_t)row * D + 16 * lane); dst[0] = w0; dst[1] = w1; }
}

#ifdef NO_GSYNC
#define GSYNC() __syncthreads()
#else
#define GSYNC() grid.sync()
#endif
template <int l> __device__ __forceinline__ void layer_fwd(const Params& P, LAS unsigned char* lds, cg::grid_group& grid, const int G) {
    unsigned char* ws = P.ws;

        unsigned* ctl = (unsigned*)(ws + WS_CTL) + l * CW_LAYER;
        float* Y = (float*)(ws + WS_Y); float* stats1 = (float*)(ws + WS_STATS); float* stats2 = stats1 + (size_t)S * 2;
#ifndef SKIP_G1
        { EpiStore E{(bf16_t*)(ws + WS_H), HLD}; GEMM_CALL(EpiStore, E, ws + WS_XB, ws + WS_WIN, HLD, D, (int)blockIdx.x); }
#endif
        GSYNC();

#ifndef SKIP_P2A
        p2a_phase(P, l, lds, G);
#endif

        GSYNC();
#ifndef SKIP_G2
        { EpiQ E{(bf16_t*)(ws + WS_Q), (const float*)(ws + WS_ROPE_MLA)}; GEMM_CALL(EpiQ, E, ws + WS_CQN, ws + WS_WUQ, 768, 512, (int)blockIdx.x); }
#endif
#ifndef SKIP_G3
        { EpiKV E{(bf16_t*)(ws + WS_K), (bf16_t*)(ws + WS_VR), (const bf16_t*)(ws + WS_KPE), ctl + CW_KNPIECE}; int kkv = 256; asm volatile("" : "+s"(kkv)); GEMM_CALL(EpiKV, E, ws + WS_CKVN, ws + WS_WUKV, 1024, kkv, (int)blockIdx.x);
          __threadfence_block(); __syncthreads();
          { pg8::StaticOrder so2; so2.init(S, 1024, G, (int)blockIdx.x); pg8::Unit u2; for (int i2 = 0; so2.next(i2, u2); ++i2) vt_tile((const bf16_t*)(ws + WS_VR), (bf16_t*)(ws + WS_VT), u2.pm, u2.pn); } }
#endif
#ifndef SKIP_G4
        { EpiStore E{(bf16_t*)(ws + WS_CONCAT) + 1024, D}; GEMM_CALL(EpiStore, E, ws + WS_CONVA, ws + WS_WPW, 512, 512, (int)((blockIdx.x + 128) % G)); }
#endif
#ifndef SKIP_G5
        { EpiStore E{(bf16_t*)(ws + WS_CONCAT) + 1536, D}; GEMM_CALL(EpiStore, E, ws + WS_POOLED, ws + WS_WPOOL, 512, 512, (int)((blockIdx.x + 64) % G)); }
#endif

#ifndef SKIP_GATE
        gate_phase(P, l, lds, G);
#endif

        GSYNC();

#ifndef SKIP_ATTN
        attn_phase(P, l, lds, G);
#endif

        GSYNC();

#ifndef SKIP_NORM
        attn_norm_phase(P, G);
#endif

        GSYNC();
#ifndef SKIP_G6
        if (l == 0) { EpiRes<0> E{P.in[0], Y, nullptr, nullptr, nullptr}; GEMM_CALL(EpiRes<0>, E, ws + WS_CONCAT, ws + WS_WOUT, D, D, (int)blockIdx.x); }
        else { EpiRes<1> E{nullptr, Y, stats2, P.in[20] + (size_t)(l - 1) * D, P.in[21] + (size_t)(l - 1) * D}; GEMM_CALL(EpiRes<1>, E, ws + WS_CONCAT, ws + WS_WOUT, D, D, (int)blockIdx.x); }
#endif
        GSYNC();
        ln_phase<false>(Y, P.in[15] + (size_t)l * D, P.in[16] + (size_t)l * D, stats1, (bf16_t*)(ws + WS_XB), nullptr, G);
        GSYNC();
#ifndef SKIP_G8
        { EpiFfn E{(bf16_t*)(ws + WS_ACT)}; GEMM_CALL(EpiFfn, E, ws + WS_XB, ws + WS_WGU, 2 * DFF, D, (int)blockIdx.x); }
#endif
        GSYNC();
#ifndef SKIP_G9
        { EpiRes<1> E{nullptr, Y, stats1, P.in[15] + (size_t)l * D, P.in[16] + (size_t)l * D}; GEMM_CALL(EpiRes<1>, E, ws + WS_ACT, ws + WS_WDN, D, DFF, (int)blockIdx.x); }
#endif
        GSYNC();
        if (l + 1 < NLAYER) { ln_phase<false>(Y, P.in[20] + (size_t)l * D, P.in[21] + (size_t)l * D, stats2, (bf16_t*)(ws + WS_XB), nullptr, G); prep_weights(P, l + 1, lds, G); GSYNC(); }
        else ln_phase<true>(Y, P.in[20] + (size_t)l * D, P.in[21] + (size_t)l * D, nullptr, nullptr, P.out, G);

}

__global__ void __launch_bounds__(NT, 2) hybrid_fwd(Params P) {
    extern __shared__ __attribute__((aligned(16))) unsigned char lds_raw[];
    LAS unsigned char* lds = (LAS unsigned char*)lds_raw;
    cg::grid_group grid = cg::this_grid();
    const int G = gridDim.x;
    unsigned char* ws = P.ws;

#ifndef SKIP_PREP
    prep_weights(P, 0, lds, G);
    prep_layer0(P, G);
#endif

    GSYNC();
    layer_fwd<0>(P, lds, grid, G);
    layer_fwd<1>(P, lds, grid, G);
}

extern "C" void kernel_launch(void* const* d_in, const int* in_sizes, int n_in, void* d_out, int out_size, void* d_ws, size_t ws_size, hipStream_t stream) {
    static int grid = 0;
    if (grid == 0) {
        if (n_in != 22 || out_size != S * D || ws_size < WS_END) { fprintf(stderr, "kernel_launch: unexpected shapes (n_in %d, out %d, ws %zu)\n", n_in, out_size, ws_size); grid = -1; return; }
        int dev = 0, cus = 0, per_cu = 0;
        hipGetDevice(&dev); hipDeviceGetAttribute(&cus, hipDeviceAttributeMultiprocessorCount, dev);
        if (hipFuncSetAttribute((const void*)hybrid_fwd, hipFuncAttributeMaxDynamicSharedMemorySize, LDS_BYTES) != hipSuccess) { fprintf(stderr, "kernel_launch: hipFuncSetAttribute failed\n"); grid = -1; return; }
        if (hipOccupancyMaxActiveBlocksPerMultiprocessor(&per_cu, (const void*)hybrid_fwd, NT, LDS_BYTES) != hipSuccess || per_cu < 1) per_cu = 1;
        (void)hipGetLastError();
        grid = cus * 1;
        fprintf(stderr, "kernel_launch: %d CUs, occupancy %d, grid %d\n", cus, per_cu, grid);
    }
    if (grid < 0) return;
    hipMemsetAsync((char*)d_ws + WS_CTL, 0, CTL_BYTES, stream);
    Params p{};
    for (int i = 0; i < 22; ++i) p.in[i] = (const float*)d_in[i];
    p.out = (float*)d_out; p.ws = (unsigned char*)d_ws;
    void* args[] = {&p};
    hipError_t e = hipLaunchCooperativeKernel((const void*)hybrid_fwd, dim3(grid), dim3(NT), args, LDS_BYTES, stream);
    if (e != hipSuccess) fprintf(stderr, "cooperative launch failed: %s (grid %d)\n", hipGetErrorString(e), grid);
}
```

```cpp
#include <hip/hip_runtime.h>
#include <hip/hip_cooperative_groups.h>
#include <cstdio>
#include <cstdint>
namespace cg = cooperative_groups;
namespace pg8 {
#define PG8_LAS __attribute__((address_space(3)))
typedef unsigned short bf16_t;
typedef short bf16x8 __attribute__((ext_vector_type(8)));
typedef float f32x4 __attribute__((ext_vector_type(4)));
typedef unsigned u32x4 __attribute__((ext_vector_type(4)));
constexpr int BM = 256, BK = 64, HALF = 128, HTB = HALF * BK * 2  , STAGE_BYTES = 8 * HTB, NXCD = 8, WGM = 8;

__host__ __device__ __forceinline__ int lds_byte(int r, int c) { const int st = (r >> 4) * 2 + (c >> 5), rr = r & 15, cc = c & 31, ob = rr * 64 + cc * 2; return st * 1024 + (ob ^ (((ob >> 9) & 1) << 5)); }
__host__ __device__ __forceinline__ void stage_rc(int b, int& R, int& C) { const int st = b / 1024, sb = b % 1024, swz = sb ^ (((sb >> 9) & 1) << 5); R = (st >> 1) * 16 + swz / 64; C = (st & 1) * 32 + (swz % 64) / 2; }
__host__ __device__ __forceinline__ int perm32(int rho) { const int n = rho >> 4, i = rho & 15; return 8 * (i >> 2) + 4 * n + (i & 3); }

struct Unit { int pm, pn; };
struct Gemm { const bf16_t* A; const bf16_t* Bt; int M, N, K; };

struct StaticOrder {
    int nM, nN, nwg, G, c;
    __host__ __device__ void init(int M, int N, int G_, int c_) { nM = M / BM; nN = N / BM; nwg = nM * nN; G = G_; c = c_; }
    __host__ __device__ bool next(int i, Unit& u) const {
        const long L = (long)i * G + c; if (L >= nwg) return false;
        int wgid = (int)L; { const int q = nwg / NXCD, r = nwg % NXCD, xcd = wgid % NXCD, off = wgid / NXCD; wgid = (xcd < r ? xcd * (q + 1) : r * (q + 1) + (xcd - r) * q) + off; }
        const int nig = WGM * nN, gid = wgid / nig, fm = gid * WGM, gsz = (nM - fm) < WGM ? (nM - fm) : WGM;
        u.pm = fm + ((wgid % nig) % gsz); u.pn = (wgid % nig) / gsz; return true;
    }
    __device__ __forceinline__ void a_ready(const Unit&) const {}
    __device__ __forceinline__ void done(const Unit&) const {}
};
__device__ __forceinline__ unsigned cvt_pk_bf16(float lo, float hi) { unsigned r; asm volatile("v_cvt_pk_bf16_f32 %0, %1, %2" : "=v"(r) : "v"(lo), "v"(hi)); return r; }
typedef float f32x2 __attribute__((ext_vector_type(2)));
template <class Epi, class Sched, bool ALIGN_EPI = false, bool SP2 = false>
__device__ __forceinline__ void gemm_phase(PG8_LAS unsigned char* lds, const Gemm g, const Sched& S, const Epi& E) {
    int tid_l = threadIdx.x; asm volatile("" : "+v"(tid_l)); const int tid = tid_l, wid = __builtin_amdgcn_readfirstlane(tid >> 6), lane = tid & 63, wr = wid >> 2, wc = wid & 3, fr = lane & 15, fq = lane >> 4;
    const int K = g.K, nt = K / BK;
    unsigned voffA[2], voffB[2];
#pragma unroll
    for (int i = 0; i < 2; ++i) { int R, C; stage_rc(tid * 16 + i * 8192, R, C); const int Rb = Epi::PERM ? ((R & ~31) + perm32(R & 31)) : R;
        voffA[i] = (unsigned)(R * K + C) * 2u; voffB[i] = (unsigned)(Rb * K + C) * 2u; }
    const size_t kstep = (size_t)(BK * 2);
    const size_t hstep = (size_t)HALF * K * 2;
    const size_t tstep = 2 * hstep;
    const unsigned ldsw = (unsigned)wid * 1024u;
    const int aoff = lds_byte(wr * 64 + fr, fq * 8), boff = lds_byte(wc * 32 + fr, fq * 8);
#define PG8_SA(b, h) (((b) * 2 + (h)) * HTB)
#define PG8_SB(b, h) ((4 + (b) * 2 + (h)) * HTB)
#define PG8_STAGE(bufoff, gbase, voff) do { _Pragma("unroll") for (int _i = 0; _i < 2; ++_i) \
        __builtin_amdgcn_global_load_lds((const unsigned*)((const char*)(gbase) + (voff)[_i]), (PG8_LAS unsigned*)(lds + (bufoff) + ldsw + _i * 8192), 16, 0, 0); } while (0)
#define PG8_LDA(dst, b, h) do { _Pragma("unroll") for (int m = 0; m < 4; ++m) _Pragma("unroll") for (int k = 0; k < 2; ++k) dst[m][k] = *(const PG8_LAS bf16x8*)(lds + PG8_SA(b, h) + aoff + m * 2048 + k * 1024); } while (0)
#define PG8_LDB(dst, b, h) do { _Pragma("unroll") for (int n = 0; n < 2; ++n) _Pragma("unroll") for (int k = 0; k < 2; ++k) dst[n][k] = *(const PG8_LAS bf16x8*)(lds + PG8_SB(b, h) + boff + n * 2048 + k * 1024); } while (0)
#define PG8_MMA(ai, bj, At, Bt) do { __builtin_amdgcn_s_setprio(1); _Pragma("unroll") for (int m = 0; m < 4; ++m) _Pragma("unroll") for (int n = 0; n < 2; ++n) _Pragma("unroll") for (int k = 0; k < 2; ++k) \
        acc[ai][bj][m][n] = __builtin_amdgcn_mfma_f32_16x16x32_bf16(Bt[n][k], At[m][k], acc[ai][bj][m][n], 0, 0, 0); __builtin_amdgcn_s_setprio(0); } while (0)
#define PG8_WAIT_V(n) asm volatile("s_waitcnt vmcnt(" #n ")" ::: "memory")
#define PG8_WAIT_L(n) asm volatile("s_waitcnt lgkmcnt(" #n ")" ::: "memory")
#define PG8_BAR __builtin_amdgcn_s_barrier()
#define PG8_SCHED __builtin_amdgcn_sched_barrier(0)
    Unit cur, nxt; int ui = 0;
    if (!S.next(0, cur)) return;
    f32x4 acc[2][2][4][2];
#pragma unroll
    for (int a = 0; a < 2; ++a)
#pragma unroll
        for (int b = 0; b < 2; ++b)
#pragma unroll
            for (int m = 0; m < 4; ++m)
#pragma unroll
                for (int n = 0; n < 2; ++n) acc[a][b][m][n] = (f32x4){0.f, 0.f, 0.f, 0.f};
    bf16x8 At[4][2], B0[2][2], B1[2][2];
    const char* cA = (const char*)g.A + (size_t)cur.pm * tstep; const char* cB = (const char*)g.Bt + (size_t)cur.pn * tstep;
    S.a_ready(cur);
    if constexpr (SP2) {
        PG8_STAGE(PG8_SB(0, 0), cB, voffB); PG8_STAGE(PG8_SB(0, 1), cB + hstep, voffB); PG8_STAGE(PG8_SA(0, 0), cA, voffA); PG8_STAGE(PG8_SA(0, 1), cA + hstep, voffA);
        if (wr == 1) PG8_BAR;
        PG8_WAIT_V(2); PG8_BAR;
        PG8_STAGE(PG8_SB(1, 0), cB + kstep, voffB); PG8_STAGE(PG8_SA(1, 0), cA + kstep, voffA); PG8_STAGE(PG8_SB(1, 1), cB + hstep + kstep, voffB);
        PG8_WAIT_V(6); PG8_BAR;
    } else {
        PG8_STAGE(PG8_SB(0, 0), cB, voffB); PG8_STAGE(PG8_SA(0, 0), cA, voffA); PG8_STAGE(PG8_SB(0, 1), cB + hstep, voffB); PG8_STAGE(PG8_SA(0, 1), cA + hstep, voffA);
        if (wr == 1) PG8_BAR;
        PG8_WAIT_V(4); PG8_BAR;
        PG8_STAGE(PG8_SB(1, 0), cB + kstep, voffB); PG8_STAGE(PG8_SA(1, 0), cA + kstep, voffA); PG8_STAGE(PG8_SB(1, 1), cB + hstep + kstep, voffB);
        PG8_WAIT_V(6); PG8_BAR;
    }
    for (;;) {
        const bool has_next = S.next(ui + 1, nxt);
        const char* nA = has_next ? (const char*)g.A + (size_t)nxt.pm * tstep : cA; const char* nB = has_next ? (const char*)g.Bt + (size_t)nxt.pn * tstep : cB;
        for (int t = 0; t < nt; t += 2) {
            const bool last = (t == nt - 2);
            const char* a1 = cA + (size_t)(t + 1) * kstep;
            const char* a2 = last ? nA : cA + (size_t)(t + 2) * kstep; const char* b2 = last ? nB : cB + (size_t)(t + 2) * kstep;
            const char* a3 = a2 + kstep; const char* b3 = b2 + kstep;
            if (last && has_next) S.a_ready(nxt);
            if constexpr (SP2) {
            PG8_LDB(B0, 0, 0); PG8_LDB(B1, 0, 1); PG8_SCHED; PG8_LDA(At, 0, 0); PG8_STAGE(PG8_SA(1, 1), a1 + hstep, voffA);
            PG8_WAIT_V(8); PG8_WAIT_L(0); PG8_BAR; PG8_MMA(0, 0, At, B0); PG8_MMA(0, 1, At, B1); PG8_BAR; PG8_SCHED;
            PG8_LDA(At, 0, 1); PG8_STAGE(PG8_SB(0, 0), b2, voffB); PG8_STAGE(PG8_SB(0, 1), b2 + hstep, voffB); PG8_STAGE(PG8_SA(0, 0), a2, voffA);
            PG8_WAIT_V(8); PG8_WAIT_L(0); PG8_BAR; PG8_MMA(1, 0, At, B0); PG8_MMA(1, 1, At, B1); PG8_BAR; PG8_SCHED;
            PG8_LDB(B0, 1, 0); PG8_LDB(B1, 1, 1); PG8_SCHED; PG8_LDA(At, 1, 0); PG8_STAGE(PG8_SA(0, 1), a2 + hstep, voffA);
            PG8_WAIT_V(8); PG8_WAIT_L(0); PG8_BAR; PG8_MMA(0, 0, At, B0); PG8_MMA(0, 1, At, B1); PG8_BAR; PG8_SCHED;
            PG8_LDA(At, 1, 1); PG8_STAGE(PG8_SB(1, 0), b3, voffB); PG8_STAGE(PG8_SB(1, 1), b3 + hstep, voffB); PG8_STAGE(PG8_SA(1, 0), a3, voffA);
            PG8_WAIT_V(8); PG8_WAIT_L(0); PG8_BAR; PG8_MMA(1, 0, At, B0); PG8_MMA(1, 1, At, B1); PG8_BAR; PG8_SCHED;
            } else {
            PG8_LDB(B0, 0, 0); PG8_SCHED; PG8_LDA(At, 0, 0); PG8_STAGE(PG8_SA(1, 1), a1 + hstep, voffA);
            PG8_WAIT_L(8); PG8_BAR; PG8_WAIT_L(0); PG8_MMA(0, 0, At, B0); PG8_BAR; PG8_SCHED;
            PG8_LDB(B1, 0, 1); PG8_STAGE(PG8_SB(0, 0), b2, voffB);
            PG8_BAR; PG8_WAIT_L(0); PG8_MMA(0, 1, At, B1); PG8_BAR;
            PG8_LDA(At, 0, 1); PG8_STAGE(PG8_SA(0, 0), a2, voffA);
            PG8_BAR; PG8_WAIT_L(0); PG8_MMA(1, 0, At, B0); PG8_BAR; PG8_SCHED;
            PG8_STAGE(PG8_SB(0, 1), b2 + hstep, voffB);
            PG8_WAIT_V(6); PG8_BAR; PG8_MMA(1, 1, At, B1); PG8_BAR;
            PG8_LDB(B0, 1, 0); PG8_SCHED; PG8_LDA(At, 1, 0); PG8_STAGE(PG8_SA(0, 1), a2 + hstep, voffA);
            PG8_WAIT_L(8); PG8_BAR; PG8_WAIT_L(0); PG8_MMA(0, 0, At, B0); PG8_BAR; PG8_SCHED;
            PG8_LDB(B1, 1, 1); PG8_STAGE(PG8_SB(1, 0), b3, voffB);
            PG8_BAR; PG8_WAIT_L(0); PG8_MMA(0, 1, At, B1); PG8_BAR;
            PG8_LDA(At, 1, 1); PG8_STAGE(PG8_SA(1, 0), a3, voffA);
            PG8_BAR; PG8_WAIT_L(0); PG8_MMA(1, 0, At, B0); PG8_BAR; PG8_SCHED;
            PG8_STAGE(PG8_SB(1, 1), b3 + hstep, voffB);
            PG8_WAIT_V(6); PG8_BAR; PG8_MMA(1, 1, At, B1); PG8_BAR;
            }
        }
        if constexpr (ALIGN_EPI) { if (wr == 0) PG8_BAR; }
        if constexpr (!Epi::AFTER_DRAIN) { E(acc, cur, wr, wc, fr, fq); S.done(cur); }
        if (!has_next) break;
#pragma unroll
        for (int a = 0; a < 2; ++a)
#pragma unroll
            for (int b = 0; b < 2; ++b)
#pragma unroll
                for (int m = 0; m < 4; ++m)
#pragma unroll
                    for (int n = 0; n < 2; ++n) acc[a][b][m][n] = (f32x4){0.f, 0.f, 0.f, 0.f};
        cur = nxt; cA = nA; cB = nB; ++ui;
        if constexpr (ALIGN_EPI) { if (wr == 1) PG8_BAR; }
    }
    PG8_WAIT_V(0);
    if constexpr (!ALIGN_EPI) { if (wr == 0) PG8_BAR; }
    PG8_BAR;
    if constexpr (Epi::AFTER_DRAIN) { E.fused(acc, cur, wr, wc, fr, fq, lds, wid, lane); S.done(cur); }
#undef PG8_SA
#undef PG8_SB
#undef PG8_STAGE
#undef PG8_LDA
#undef PG8_LDB
#undef PG8_MMA
#undef PG8_WAIT_V
#undef PG8_WAIT_L
#undef PG8_BAR
#undef PG8_SCHED
}
}

#define LAS __attribute__((address_space(3)))
typedef unsigned short bf16_t;
typedef short bf16x8 __attribute__((ext_vector_type(8)));
typedef float f32x2 __attribute__((ext_vector_type(2)));
typedef float f32x4 __attribute__((ext_vector_type(4)));
typedef float f32x16 __attribute__((ext_vector_type(16)));
typedef unsigned u32x2 __attribute__((ext_vector_type(2)));
typedef unsigned u32x4 __attribute__((ext_vector_type(4)));
typedef __bf16 bf16x2_t __attribute__((ext_vector_type(2)));

constexpr int S = 16384, D = 2048, NLAYER = 2, HLD = 4096, DFF = 5632, INC = 3904;
constexpr int C_CQ = 0, C_CKV = 512, C_KR = 768, C_MQ = 832, C_MK = 1344, C_MV = 1856, C_CONV = 2368, C_POOL = 3392;
constexpr float EPS = 1e-5f, ALPHA = 1.41421356237309515f, LOG2E = 1.4426950408889634f;
constexpr float CQ_SCALE = 0.07216878364870323f * LOG2E;
constexpr float CM_SCALE = 0.08838834764831845f * LOG2E;
constexpr int NT = 512, NWV = 8;
constexpr int LDS_BYTES = 147456, LDS_MISC = 131072;

constexpr size_t MiB = (size_t)1 << 20;
constexpr size_t WS_CTL = 0, CTL_BYTES = 1 * MiB;
constexpr size_t WS_WIN = 1 * MiB, WS_WUQ = 17 * MiB, WS_WUKV = 18 * MiB, WS_WPW = 19 * MiB, WS_WPOOL = 20 * MiB, WS_WOUT = 21 * MiB, WS_WGU = 29 * MiB, WS_WDN = 73 * MiB;
constexpr size_t WS_ROPE_MLA = 95 * MiB, WS_ROPE_MOBA = 99 * MiB, WS_STATS = 101 * MiB;
constexpr size_t WS_Y = 102 * MiB, WS_XB = 230 * MiB;
constexpr size_t WS_CQN = 230 * MiB, WS_CKVN = 246 * MiB, WS_KPE = 254 * MiB, WS_CONVA = 256 * MiB, WS_POOLED = 272 * MiB;
constexpr size_t WS_H = 294 * MiB;
constexpr size_t WS_Q = 294 * MiB, WS_K = 318 * MiB, WS_VT = 342 * MiB, WS_CONCAT = 358 * MiB;
constexpr size_t WS_MQ = 422 * MiB, WS_MK = 438 * MiB, WS_MVT = 454 * MiB;
constexpr size_t WS_VR = 470 * MiB;
constexpr size_t WS_ACT = 294 * MiB, WS_END = 486 * MiB;
constexpr int CW_LAYER = 33792, CW_QCTR = 0, CW_KPEMAX = 1, CW_KNPIECE = 4, CW_KMMAX = 20, CW_CNT = 64, CW_KMEAN = 1024;

constexpr size_t DO_PART = 0, DO_PL = 34 * MiB, DO_PARTB = 36 * MiB, DO_LB = 101 * MiB, DO_LIST = 104 * MiB;

struct Params { const float* in[22]; float* out; unsigned char* ws; };

__device__ __forceinline__ unsigned f2bf(float f) { unsigned u = __float_as_uint(f); return (u + 0x7fffu + ((u >> 16) & 1u)) >> 16; }
__device__ __forceinline__ float bf2f(unsigned h) { return __uint_as_float(h << 16); }
__device__ __forceinline__ unsigned pk2(float lo, float hi) { f32x2 v = {lo, hi}; bf16x2_t b = __builtin_convertvector(v, bf16x2_t); return __builtin_bit_cast(unsigned, b); }
__device__ __forceinline__ float wave_sum(float v) {
#pragma unroll
    for (int o = 1; o < 64; o <<= 1) v += __shfl_xor(v, o);
    return v;
}
__device__ __forceinline__ float sigmoidf_(float x) { return __builtin_amdgcn_rcpf(1.f + __expf(-x)); }

typedef const pg8::f32x4 (&AccRef)[2][2][4][2];

struct EpiStore {
    static constexpr bool PERM = true, AFTER_DRAIN = false;
    bf16_t* O; int ldc;
    __device__ __forceinline__ void operator()(AccRef acc, const pg8::Unit& u, int wr, int wc, int fr, int fq) const {
        const int row0 = u.pm * 256 + wr * 64 + fr, col0 = u.pn * 256 + wc * 32 + 8 * fq;
#pragma unroll
        for (int ai = 0; ai < 2; ++ai)
#pragma unroll
            for (int m = 0; m < 4; ++m) { bf16_t* rowp = O + (size_t)(row0 + ai * 128 + m * 16) * ldc + col0;
#pragma unroll
                for (int bj = 0; bj < 2; ++bj) { const f32x4 v0 = acc[ai][bj][m][0], v1 = acc[ai][bj][m][1];
                    u32x4 w; w.x = pk2(v0[0], v0[1]); w.y = pk2(v0[2], v0[3]); w.z = pk2(v1[0], v1[1]); w.w = pk2(v1[2], v1[3]);
                    *(u32x4*)(rowp + bj * 128) = w; } }
    }
};

struct EpiQ {
    static constexpr bool PERM = true, AFTER_DRAIN = false;
    bf16_t* O; const float* rope;
    __device__ __forceinline__ void operator()(AccRef acc, const pg8::Unit& u, int wr, int wc, int fr, int fq) const {
        const int row0 = u.pm * 256 + wr * 64 + fr;
#pragma unroll
        for (int bj = 0; bj < 2; ++bj) {
            const int c0 = u.pn * 256 + bj * 128 + wc * 32 + 8 * fq; const int d0 = c0 % 192; const bool rp = d0 >= 128; const int j0 = (d0 - 128) >> 1;
#pragma unroll
            for (int ai = 0; ai < 2; ++ai)
#pragma unroll
                for (int m = 0; m < 4; ++m) { const int row = row0 + ai * 128 + m * 16;
                    f32x4 v0 = acc[ai][bj][m][0] * CQ_SCALE, v1 = acc[ai][bj][m][1] * CQ_SCALE;
                    if (rp) { const f32x4 t0 = *(const f32x4*)(rope + ((size_t)row * 32 + j0) * 2), t1 = *(const f32x4*)(rope + ((size_t)row * 32 + j0 + 2) * 2);
                        f32x4 a, b;
                        a[0] = v0[0] * t0[0] - v0[1] * t0[1]; a[1] = v0[0] * t0[1] + v0[1] * t0[0];
                        a[2] = v0[2] * t0[2] - v0[3] * t0[3]; a[3] = v0[2] * t0[3] + v0[3] * t0[2];
                        b[0] = v1[0] * t1[0] - v1[1] * t1[1]; b[1] = v1[0] * t1[1] + v1[1] * t1[0];
                        b[2] = v1[2] * t1[2] - v1[3] * t1[3]; b[3] = v1[2] * t1[3] + v1[3] * t1[2];
                        v0 = a; v1 = b; }
                    u32x4 w; w.x = pk2(v0[0], v0[1]); w.y = pk2(v0[2], v0[3]); w.z = pk2(v1[0], v1[1]); w.w = pk2(v1[2], v1[3]);
                    *(u32x4*)(O + (size_t)row * 768 + c0) = w; }
        }
    }
};

struct EpiKV {
    static constexpr bool PERM = true, AFTER_DRAIN = false;
    bf16_t* K; bf16_t* VR; const bf16_t* KPE; unsigned* piece;
    __device__ __forceinline__ void operator()(AccRef acc, const pg8::Unit& u, int wr, int wc, int fr, int fq) const {
        const int row0 = u.pm * 256 + wr * 64 + fr, cc = wc * 32 + 8 * fq, hd = u.pn;
        float pmax = 0.f;
#pragma unroll
        for (int ai = 0; ai < 2; ++ai)
#pragma unroll
            for (int m = 0; m < 4; ++m) { const int row = row0 + ai * 128 + m * 16;
                { const f32x4 v0 = acc[ai][0][m][0], v1 = acc[ai][0][m][1];
                  u32x4 w; w.x = pk2(v0[0], v0[1]); w.y = pk2(v0[2], v0[3]); w.z = pk2(v1[0], v1[1]); w.w = pk2(v1[2], v1[3]);
                  *(u32x4*)(K + (size_t)row * 768 + hd * 192 + cc) = w;
                  float ss = (v0[0] * v0[0] + v0[1] * v0[1]) + (v0[2] * v0[2] + v0[3] * v0[3]) + (v1[0] * v1[0] + v1[1] * v1[1]) + (v1[2] * v1[2] + v1[3] * v1[3]);
                  ss += __shfl_xor(ss, 16); ss += __shfl_xor(ss, 32); pmax = fmaxf(pmax, ss); }
                { const f32x4 v0 = acc[ai][1][m][0], v1 = acc[ai][1][m][1];
                  u32x4 w; w.x = pk2(v0[0], v0[1]); w.y = pk2(v0[2], v0[3]); w.z = pk2(v1[0], v1[1]); w.w = pk2(v1[2], v1[3]);
                  *(u32x4*)(VR + (size_t)row * 512 + hd * 128 + cc) = w; }
                if (wc < 2) *(u32x4*)(K + (size_t)row * 768 + hd * 192 + 128 + cc) = *(const u32x4*)(KPE + (size_t)row * 64 + cc); }
#pragma unroll
        for (int o = 1; o < 16; o <<= 1) pmax = fmaxf(pmax, __shfl_xor(pmax, o));
        if ((threadIdx.x & 63) == 0) atomicMax(piece + hd * 4 + wc, __float_as_uint(pmax));
    }
};
__device__ __forceinline__ void vt_tile(const bf16_t* VR, bf16_t* VT, int pm, int pn) {
    int tid = threadIdx.x; asm volatile("" : "+v"(tid));
    const int dv = tid & 127, seg = tid >> 7; const int t0 = 256 * pm + 64 * seg;
    const bf16_t* src = VR + (size_t)t0 * 512 + pn * 128 + dv; unsigned pk[32];
#pragma unroll
    for (int i = 0; i < 32; ++i) pk[i] = (unsigned)src[(size_t)(2 * i) * 512] | ((unsigned)src[(size_t)(2 * i + 1) * 512] << 16);
    u32x4* dst = (u32x4*)(VT + (size_t)(pn * 128 + dv) * S + t0);
#pragma unroll
    for (int i = 0; i < 8; ++i) dst[i] = (u32x4){pk[4 * i], pk[4 * i + 1], pk[4 * i + 2], pk[4 * i + 3]};
}

template <int MODE>
struct EpiRes {
    static constexpr bool PERM = true, AFTER_DRAIN = false;
    const float* xin; float* Y; const float* stats; const float* g; const float* b;
    __device__ __forceinline__ void operator()(AccRef acc, const pg8::Unit& u, int wr, int wc, int fr, int fq) const {
        const int row0 = u.pm * 256 + wr * 64 + fr, col0 = u.pn * 256 + wc * 32 + 8 * fq;
#pragma unroll
        for (int bj = 0; bj < 2; ++bj) { const int col = col0 + bj * 128;
            f32x4 g0, g1, b0, b1;
            if (MODE == 1) { g0 = *(const f32x4*)(g + col); g1 = *(const f32x4*)(g + col + 4); b0 = *(const f32x4*)(b + col); b1 = *(const f32x4*)(b + col + 4); }
#pragma unroll
            for (int ai = 0; ai < 2; ++ai)
#pragma unroll
                for (int m = 0; m < 4; ++m) { const int row = row0 + ai * 128 + m * 16; const size_t off = (size_t)row * D + col;
                    f32x4 r0, r1;
                    if (MODE == 0) { r0 = *(const f32x4*)(xin + off); r1 = *(const f32x4*)(xin + off + 4); }
                    else { const f32x2 st = *(const f32x2*)(stats + (size_t)row * 2); r0 = *(const f32x4*)(Y + off); r1 = *(const f32x4*)(Y + off + 4);
                        r0 = (r0 - st.x) * st.y * g0 + b0; r1 = (r1 - st.x) * st.y * g1 + b1; }
                    *(f32x4*)(Y + off) = r0 * ALPHA + acc[ai][bj][m][0]; *(f32x4*)(Y + off + 4) = r1 * ALPHA + acc[ai][bj][m][1]; }
        }
    }
};

struct EpiFfn {
    static constexpr bool PERM = true, AFTER_DRAIN = false;
    bf16_t* O;
    __device__ __forceinline__ void operator()(AccRef acc, const pg8::Unit& u, int wr, int wc, int fr, int fq) const {
        const int row0 = u.pm * 256 + wr * 64 + fr, col0 = u.pn * 128 + wc * 32 + 8 * fq;
#pragma unroll
        for (int ai = 0; ai < 2; ++ai)
#pragma unroll
            for (int m = 0; m < 4; ++m) { const int row = row0 + ai * 128 + m * 16;
                float r[8];
#pragma unroll
                for (int n = 0; n < 2; ++n)
#pragma unroll
                    for (int e = 0; e < 4; ++e) { const float gt = acc[ai][0][m][n][e], up = acc[ai][1][m][n][e]; r[n * 4 + e] = gt * sigmoidf_(gt) * up; }
                u32x4 w; w.x = pk2(r[0], r[1]); w.y = pk2(r[2], r[3]); w.z = pk2(r[4], r[5]); w.w = pk2(r[6], r[7]);
                *(u32x4*)(O + (size_t)row * DFF + col0) = w; }
    }
};

#define GEMM_CALL(EPIT, E, A_, B_, N_, K_, CID) do { pg8::Gemm g_{(const bf16_t*)(A_), (const bf16_t*)(B_), S, (N_), (K_)}; pg8::StaticOrder so_; so_.init(S, (N_), G, (CID)); \
    pg8::gemm_phase<EPIT, pg8::StaticOrder, true, true>(lds, g_, so_, (E)); } while (0)

struct TrSpec { const float* W; int ldn, K, N; bf16_t* WT; int ldk, mode; const float* sk; const float* sn; };
__device__ __forceinline__ int drow_of(int mode, int n) {
    if (mode == 1) { const int hd = n / 192, d = n - hd * 192; if (d < 128) return n; const int e = d - 128; return hd * 192 + 128 + 2 * (e & 31) + (e >> 5); }
    if (mode == 4) return ((n >> 7) << 8) + (n & 127);
    if (mode == 5) return ((n >> 7) << 8) + 128 + (n & 127);
    return n;
}
__device__ __forceinline__ void transpose_items(const TrSpec& t, LAS float* scr, int gw, int ngw, int lane) {
    const int nblk = t.N / 32, nitems = (t.K / 64) * nblk;
    for (int it = gw; it < nitems; it += ngw) {
        const int kb = it / nblk, nb = it - kb * nblk, k0 = 64 * kb, n0 = 32 * nb;
        const float snv = t.sn ? t.sn[n0 + (lane & 31)] : 1.f;
#pragma unroll 8
        for (int i = 0; i < 32; ++i) { const int kk = 2 * i + (lane >> 5); float v = t.W[(size_t)(k0 + kk) * t.ldn + n0 + (lane & 31)]; if (t.sk) v *= t.sk[k0 + kk]; scr[kk * 33 + (lane & 31)] = v * snv; }
        asm volatile("s_waitcnt lgkmcnt(0)" ::: "memory");
        const int c = lane & 7;
#pragma unroll
        for (int j = 0; j < 4; ++j) { const int n = (lane >> 3) + 8 * j; const LAS float* s = scr + (8 * c) * 33 + n;
            u32x4 o; o.x = pk2(s[0 * 33], s[1 * 33]); o.y = pk2(s[2 * 33], s[3 * 33]); o.z = pk2(s[4 * 33], s[5 * 33]); o.w = pk2(s[6 * 33], s[7 * 33]);
            *(u32x4*)(t.WT + (size_t)drow_of(t.mode, n0 + n) * t.ldk + k0 + 8 * c) = o; }
        asm volatile("s_waitcnt lgkmcnt(0)" ::: "memory");
    }
}
__device__ __forceinline__ void prep_weights(const Params& P, int l, LAS unsigned char* lds, int G) {
    int tid_l = threadIdx.x; asm volatile("" : "+v"(tid_l)); const int tid = tid_l, lane = tid & 63, wave = tid >> 6;
    const int gw = blockIdx.x * NWV + wave, ngw = G * NWV;
    LAS float* scr = (LAS float*)(lds + wave * 16384);
    unsigned char* ws = P.ws;
    TrSpec t;
    t = TrSpec{P.in[2] + (size_t)l * D * INC, INC, D, INC, (bf16_t*)(ws + WS_WIN), D, 0, nullptr, nullptr}; transpose_items(t, scr, gw, ngw, lane);
    t = TrSpec{P.in[4] + (size_t)l * 512 * 768, 768, 512, 768, (bf16_t*)(ws + WS_WUQ), 512, 1, P.in[3] + l * 512, nullptr}; transpose_items(t, scr, gw, ngw, lane);
    t = TrSpec{P.in[6] + (size_t)l * 256 * 1024, 1024, 256, 1024, (bf16_t*)(ws + WS_WUKV), 256, 0, P.in[5] + l * 256, nullptr}; transpose_items(t, scr, gw, ngw, lane);
    t = TrSpec{P.in[11] + (size_t)l * 512 * 512, 512, 512, 512, (bf16_t*)(ws + WS_WPW), 512, 0, nullptr, nullptr}; transpose_items(t, scr, gw, ngw, lane);
#pragma unroll 1
    for (int g = 0; g < 4; ++g) { t = TrSpec{P.in[12] + (size_t)(l * 4 + g) * 128 * 128, 128, 128, 128, (bf16_t*)(ws + WS_WPOOL) + (size_t)(g * 128) * 512 + g * 128, 512, 0, nullptr, P.in[13] + l * 512 + g * 128};
        transpose_items(t, scr, gw, ngw, lane); }
    t = TrSpec{P.in[14] + (size_t)l * D * D, D, D, D, (bf16_t*)(ws + WS_WOUT), D, 0, nullptr, nullptr}; transpose_items(t, scr, gw, ngw, lane);
    t = TrSpec{P.in[17] + (size_t)l * D * DFF, DFF, D, DFF, (bf16_t*)(ws + WS_WGU), D, 4, nullptr, nullptr}; transpose_items(t, scr, gw, ngw, lane);
    t = TrSpec{P.in[18] + (size_t)l * D * DFF, DFF, D, DFF, (bf16_t*)(ws + WS_WGU), D, 5, nullptr, nullptr}; transpose_items(t, scr, gw, ngw, lane);
    t = TrSpec{P.in[19] + (size_t)l * DFF * D, D, DFF, D, (bf16_t*)(ws + WS_WDN), DFF, 0, nullptr, nullptr}; transpose_items(t, scr, gw, ngw, lane);
    const int gt = blockIdx.x * NT + tid, ngt = G * NT; const u32x4 z = {0u, 0u, 0u, 0u};
    { u32x4* p = (u32x4*)((bf16_t*)(ws + WS_WIN) + (size_t)INC * D); for (int i = gt; i < 192 * D / 8; i += ngt) p[i] = z; }
    { u32x4* p = (u32x4*)(ws + WS_WPOOL); for (int i = gt; i < 512 * 512 / 8; i += ngt) { const int row = i >> 6, col = (i & 63) * 8; if ((row >> 7) != (col >> 7)) p[i] = z; } }
}
__device__ __forceinline__ void prep_layer0(const Params& P, int G) {
    int tid_l = threadIdx.x; asm volatile("" : "+v"(tid_l)); const int gt = blockIdx.x * NT + tid_l, ngt = G * NT;
    const f32x4* x4 = (const f32x4*)P.in[0]; u32x4* xb = (u32x4*)(P.ws + WS_XB);
    for (int i = gt; i < S * D / 8; i += ngt) { const f32x4 a = x4[2 * i], b = x4[2 * i + 1]; u32x4 w; w.x = pk2(a[0], a[1]); w.y = pk2(a[2], a[3]); w.z = pk2(b[0], b[1]); w.w = pk2(b[2], b[3]); xb[i] = w; }
    const int* pos = (const int*)P.in[1];
    f32x2* rm = (f32x2*)(P.ws + WS_ROPE_MLA); f32x2* ro = (f32x2*)(P.ws + WS_ROPE_MOBA);
    const double L2T = 18.931568569324174;
    for (int i = gt; i < S * 48; i += ngt) { const int t = i / 48, jj = i - t * 48; const bool mla = jj < 32; const int j = mla ? jj : jj - 32;
        const double invf = exp2(-(mla ? (double)j / 32.0 : (double)j / 16.0) * L2T);
        const double rev = (double)pos[t] * invf * 0.15915494309189535; const float fr = (float)(rev - rint(rev));
        const f32x2 cs = {__builtin_amdgcn_cosf(fr), __builtin_amdgcn_sinf(fr)};
        if (mla) rm[t * 32 + j] = cs; else ro[t * 16 + j] = cs; }
}

template <bool TO_OUT> __device__ __forceinline__ void ln_phase(const float* Y, const float* g, const float* b, float* stats, bf16_t* XB, float* out, int G, float chkoff = 0.f) {
    int tid_l = threadIdx.x; asm volatile("" : "+v"(tid_l)); const int lane = tid_l & 63, wave = tid_l >> 6;
    for (int row = blockIdx.x * NWV + wave; row < S; row += G * NWV) {
        const f32x4* yr = (const f32x4*)(Y + (size_t)row * D) + lane; f32x4 v[8]; float s = 0.f;
#pragma unroll
        for (int j = 0; j < 8; ++j) { v[j] = yr[64 * j]; s += (v[j][0] + v[j][1]) + (v[j][2] + v[j][3]); }
        const float mean = wave_sum(s) * (1.f / D); float s2 = 0.f;
#pragma unroll
        for (int j = 0; j < 8; ++j) { v[j] = v[j] - mean; s2 += (v[j][0] * v[j][0] + v[j][1] * v[j][1]) + (v[j][2] * v[j][2] + v[j][3] * v[j][3]); }
        const float rstd = rsqrtf(wave_sum(s2) * (1.f / D) + EPS);
        if (!TO_OUT && lane == 0) *(f32x2*)(stats + (size_t)row * 2) = (f32x2){mean, rstd};
#pragma unroll
        for (int j = 0; j < 8; ++j) { const int col = 4 * (lane + 64 * j); const f32x4 o = v[j] * rstd * *(const f32x4*)(g + col) + *(const f32x4*)(b + col);
            if (TO_OUT) *(f32x4*)(out + (size_t)row * D + col) = o + chkoff;
            else { u32x2 w; w.x = pk2(o[0], o[1]); w.y = pk2(o[2], o[3]); *(u32x2*)(XB + (size_t)row * D + col) = w; } }
    }
}

__device__ __forceinline__ void p2a_phase(const Params& P, int l, LAS unsigned char* lds, int G) {
    int tid_l = threadIdx.x; asm volatile("" : "+v"(tid_l)); const int tid = tid_l, lane = tid & 63, wave = tid >> 6;
    unsigned char* ws = P.ws;
    const bf16_t* H = (const bf16_t*)(ws + WS_H);
    unsigned* ctl = (unsigned*)(ws + WS_CTL) + l * CW_LAYER;
    bf16_t* CQN = (bf16_t*)(ws + WS_CQN); bf16_t* CKVN = (bf16_t*)(ws + WS_CKVN); bf16_t* KPE = (bf16_t*)(ws + WS_KPE);
    bf16_t* CONVA = (bf16_t*)(ws + WS_CONVA); bf16_t* POOLED = (bf16_t*)(ws + WS_POOLED);
    bf16_t* MQ = (bf16_t*)(ws + WS_MQ); bf16_t* MK = (bf16_t*)(ws + WS_MK); bf16_t* MVT = (bf16_t*)(ws + WS_MVT);
    const f32x2* RM = (const f32x2*)(ws + WS_ROPE_MLA); const float* RO = (const float*)(ws + WS_ROPE_MOBA);
    LAS float* ybuf = (LAS float*)lds;
    for (int tile = blockIdx.x; tile < S / 64; tile += G) {
        const int t0 = tile * 64;
        { float ksum[8]; float kpemax = 0.f, kmmax = 0.f; const int hm = lane & 15;
#pragma unroll
          for (int e = 0; e < 8; ++e) ksum[e] = 0.f;
#pragma unroll 1
          for (int i = 0; i < 8; ++i) {
              const int t = t0 + wave * 8 + i; const bf16_t* hr = H + (size_t)t * HLD;
              { const u32x4 raw = *(const u32x4*)(hr + C_CQ + 8 * lane); float x[8];
                x[0] = bf2f(raw.x & 0xffffu); x[1] = bf2f(raw.x >> 16); x[2] = bf2f(raw.y & 0xffffu); x[3] = bf2f(raw.y >> 16); x[4] = bf2f(raw.z & 0xffffu); x[5] = bf2f(raw.z >> 16); x[6] = bf2f(raw.w & 0xffffu); x[7] = bf2f(raw.w >> 16);
                float ss = 0.f;
#pragma unroll
                for (int e = 0; e < 8; ++e) ss += x[e] * x[e];
                const float rs = rsqrtf(wave_sum(ss) * (1.f / 512.f) + EPS);
                u32x4 w; w.x = pk2(x[0] * rs, x[1] * rs); w.y = pk2(x[2] * rs, x[3] * rs); w.z = pk2(x[4] * rs, x[5] * rs); w.w = pk2(x[6] * rs, x[7] * rs);
                *(u32x4*)(CQN + (size_t)t * 512 + 8 * lane) = w; }
              { const u32x2 raw = *(const u32x2*)(hr + C_CKV + 4 * lane); float x[4];
                x[0] = bf2f(raw.x & 0xffffu); x[1] = bf2f(raw.x >> 16); x[2] = bf2f(raw.y & 0xffffu); x[3] = bf2f(raw.y >> 16);
                const float ss = (x[0] * x[0] + x[1] * x[1]) + (x[2] * x[2] + x[3] * x[3]);
                const float rs = rsqrtf(wave_sum(ss) * (1.f / 256.f) + EPS);
                u32x2 w; w.x = pk2(x[0] * rs, x[1] * rs); w.y = pk2(x[2] * rs, x[3] * rs);
                *(u32x2*)(CKVN + (size_t)t * 256 + 4 * lane) = w; }
              { const int j = lane & 31; const float x1 = bf2f(hr[C_KR + j]), x2 = bf2f(hr[C_KR + 32 + j]); const f32x2 cs = RM[t * 32 + j];
                const float o1 = x1 * cs.x - x2 * cs.y, o2 = x1 * cs.y + x2 * cs.x;
                if (lane < 32) *(unsigned*)(KPE + (size_t)t * 64 + 2 * j) = pk2(o1, o2);
                const float n2 = wave_sum(lane < 32 ? o1 * o1 + o2 * o2 : 0.f); kpemax = fmaxf(kpemax, n2); }
#pragma unroll
              for (int which = 0; which < 2; ++which) {
                  const u32x4 raw = *(const u32x4*)(hr + (which ? C_MK : C_MQ) + 8 * lane); float x[8], px[8];
                  x[0] = bf2f(raw.x & 0xffffu); x[1] = bf2f(raw.x >> 16); x[2] = bf2f(raw.y & 0xffffu); x[3] = bf2f(raw.y >> 16); x[4] = bf2f(raw.z & 0xffffu); x[5] = bf2f(raw.z >> 16); x[6] = bf2f(raw.w & 0xffffu); x[7] = bf2f(raw.w >> 16);
#pragma unroll
                  for (int e = 0; e < 8; ++e) px[e] = __shfl_xor(x[e], 2);
                  if (hm < 4) { const f32x4* tp = (const f32x4*)(RO + ((size_t)t * 16 + 8 * (hm & 1)) * 2);
#pragma unroll
                      for (int e2 = 0; e2 < 4; ++e2) { const f32x4 cs = tp[e2];
                          if (hm < 2) { x[2 * e2] = x[2 * e2] * cs[0] - px[2 * e2] * cs[1]; x[2 * e2 + 1] = x[2 * e2 + 1] * cs[2] - px[2 * e2 + 1] * cs[3]; }
                          else { x[2 * e2] = px[2 * e2] * cs[1] + x[2 * e2] * cs[0]; x[2 * e2 + 1] = px[2 * e2 + 1] * cs[3] + x[2 * e2 + 1] * cs[2]; } } }
                  if (which == 0) { u32x4 w; w.x = pk2(x[0] * CM_SCALE, x[1] * CM_SCALE); w.y = pk2(x[2] * CM_SCALE, x[3] * CM_SCALE); w.z = pk2(x[4] * CM_SCALE, x[5] * CM_SCALE); w.w = pk2(x[6] * CM_SCALE, x[7] * CM_SCALE);
                      *(u32x4*)(MQ + (size_t)t * 512 + 8 * lane) = w; }
                  else { u32x4 w; w.x = pk2(x[0], x[1]); w.y = pk2(x[2], x[3]); w.z = pk2(x[4], x[5]); w.w = pk2(x[6], x[7]);
                      *(u32x4*)(MK + (size_t)t * 512 + 8 * lane) = w;
                      float n2 = 0.f;
#pragma unroll
                      for (int e = 0; e < 8; ++e) { ksum[e] += x[e]; n2 += x[e] * x[e]; }
                      n2 += __shfl_xor(n2, 1); n2 += __shfl_xor(n2, 2); n2 += __shfl_xor(n2, 4); n2 += __shfl_xor(n2, 8); kmmax = fmaxf(kmmax, n2); }
              }
          }
          float* km = (float*)(ctl + CW_KMEAN) + ((size_t)((lane >> 4) * 64 + (t0 >> 8)) * 128 + 8 * hm);
#pragma unroll
          for (int e = 0; e < 8; ++e) unsafeAtomicAdd(km + e, ksum[e]);
          if (lane == 0) atomicMax(ctl + CW_KPEMAX, __float_as_uint(kpemax));
          if (hm == 0) atomicMax(ctl + CW_KMMAX + (lane >> 4), __float_as_uint(kmmax)); }
        { const int c = tid;
          { const bf16_t* src = H + (size_t)t0 * HLD + C_MV + c; unsigned pk[32];
#pragma unroll
            for (int i = 0; i < 32; ++i) pk[i] = (unsigned)src[(size_t)(2 * i) * HLD] | ((unsigned)src[(size_t)(2 * i + 1) * HLD] << 16);
            u32x4* dst = (u32x4*)(MVT + (size_t)c * S + t0);
#pragma unroll
            for (int i = 0; i < 8; ++i) dst[i] = (u32x4){pk[4 * i], pk[4 * i + 1], pk[4 * i + 2], pk[4 * i + 3]}; }
          { const int w = 2 << (c >> 7); const bf16_t* src = H + C_POOL + c; float s = 0.f;
            for (int p = t0 - w; p < t0; ++p) if (p >= 0) s += bf2f(src[(size_t)p * HLD]);
#pragma unroll 4
            for (int i = 0; i < 64; ++i) { const int t = t0 + i; const float ut = bf2f(src[(size_t)t * HLD]); s += ut; if (t - w >= 0) s -= bf2f(src[(size_t)(t - w) * HLD]);
                const float cnt = (float)(t + 1 < w ? t + 1 : w);
                POOLED[(size_t)t * 512 + c] = (bf16_t)f2bf(s / cnt - ut); } }
          { const float* dw = P.in[7] + (size_t)l * 31 * 512 + c; float w[31];
#pragma unroll
            for (int j = 0; j < 31; ++j) w[j] = dw[j * 512];
            const float bias = P.in[8][l * 512 + c]; const bf16_t* src = H + C_CONV + c;
#pragma unroll 1
            for (int ch = 0; ch < 4; ++ch) { float v[46];
#pragma unroll
                for (int i = 0; i < 46; ++i) { const int tt = t0 + 16 * ch - 30 + i; float val = 0.f;
                    if (tt >= 0) { const float a = bf2f(src[(size_t)tt * HLD]), gg = bf2f(src[(size_t)tt * HLD + 512]); val = a * sigmoidf_(gg); }
                    v[i] = val; }
#pragma unroll
                for (int tl = 0; tl < 16; ++tl) { float y = bias;
#pragma unroll
                    for (int j = 0; j < 31; ++j) y = fmaf(w[j], v[tl + j], y);
                    ybuf[(16 * ch + tl) * 512 + c] = y; } } }
        }
        __syncthreads();
        { const float* lg = P.in[9] + l * 512 + 8 * lane; const float* lb = P.in[10] + l * 512 + 8 * lane;
          const f32x4 g0 = *(const f32x4*)lg, g1 = *(const f32x4*)(lg + 4), b0 = *(const f32x4*)lb, b1 = *(const f32x4*)(lb + 4);
#pragma unroll 1
          for (int i = 0; i < 8; ++i) { const int tl = wave * 8 + i; const LAS f32x4* yp = (const LAS f32x4*)(ybuf + tl * 512 + 8 * lane);
              f32x4 y0 = yp[0], y1 = yp[1];
              const float mean = wave_sum((y0[0] + y0[1]) + (y0[2] + y0[3]) + (y1[0] + y1[1]) + (y1[2] + y1[3])) * (1.f / 512.f);
              y0 = y0 - mean; y1 = y1 - mean;
              const float var = wave_sum((y0[0] * y0[0] + y0[1] * y0[1]) + (y0[2] * y0[2] + y0[3] * y0[3]) + (y1[0] * y1[0] + y1[1] * y1[1]) + (y1[2] * y1[2] + y1[3] * y1[3])) * (1.f / 512.f);
              const float rstd = rsqrtf(var + EPS);
              y0 = y0 * rstd * g0 + b0; y1 = y1 * rstd * g1 + b1;
              float r[8];
#pragma unroll
              for (int e = 0; e < 4; ++e) { r[e] = y0[e] * sigmoidf_(y0[e]); r[4 + e] = y1[e] * sigmoidf_(y1[e]); }
              u32x4 wv; wv.x = pk2(r[0], r[1]); wv.y = pk2(r[2], r[3]); wv.z = pk2(r[4], r[5]); wv.w = pk2(r[6], r[7]);
              *(u32x4*)(CONVA + (size_t)(t0 + tl) * 512 + 8 * lane) = wv; } }
        __syncthreads();
    }
}

__device__ __forceinline__ void gate_phase(const Params& P, int l, LAS unsigned char* lds, int G) {
    int tid_l = threadIdx.x; asm volatile("" : "+v"(tid_l)); const int tid = tid_l, lane = tid & 63, wave = tid >> 6;
    unsigned* ctl = (unsigned*)(P.ws + WS_CTL) + l * CW_LAYER;
    const float* kmean = (const float*)(ctl + CW_KMEAN);
    const bf16_t* MQ = (const bf16_t*)(P.ws + WS_MQ);
    int* LIST = (int*)((unsigned char*)P.out + DO_LIST);
    LAS float* kmT = (LAS float*)lds;
    __syncthreads();
    for (int idx = tid; idx < 32768; idx += NT) { const int h = idx >> 13, b = (idx >> 7) & 63, d = idx & 127; kmT[(h * 128 + d) * 64 + b] = kmean[idx] * (1.f / 256.f); }
    __syncthreads();
    int npend = 0, e_hb = 0, e_val = 0;
    for (int tile = blockIdx.x; tile < S / 64; tile += G) {
#pragma unroll 1
        for (int i = 0; i < 8; ++i) { const int t = tile * 64 + wave * 8 + i; const int own = t >> 8;
            if (own == 0) continue;
#pragma unroll 1
            for (int h = 0; h < 4; ++h) {
                const unsigned qv = *(const unsigned*)(MQ + (size_t)t * 512 + h * 128 + 2 * lane);
                float ga = 0.f, gb = 0.f; const LAS float* kp = kmT + h * 128 * 64 + lane;
#pragma unroll
                for (int j = 0; j < 64; ++j) { const unsigned wq = (unsigned)__builtin_amdgcn_readlane((int)qv, j);
                    ga = fmaf(bf2f(wq & 0xffffu), kp[(2 * j) * 64], ga); gb = fmaf(bf2f(wq >> 16), kp[(2 * j + 1) * 64], gb); }
                float val = lane < own ? ga + gb : -INFINITY;
                const int npick = own < 3 ? own : 3;
                for (int p = 0; p < npick; ++p) { float bv = val; int bi = lane;
#pragma unroll
                    for (int off = 32; off >= 1; off >>= 1) { const float ov = __shfl_xor(bv, off); const int oi = __shfl_xor(bi, off); if (ov > bv || (ov == bv && oi < bi)) { bv = ov; bi = oi; } }
                    if (lane == npend) { e_hb = h * 64 + bi; e_val = t * 4 + p; }
                    ++npend;
                    if (lane == bi) val = -INFINITY; }
                if (npend > 60) { if (lane < npend) { const int slot = (int)atomicAdd(ctl + CW_CNT + e_hb, 1u); LIST[(size_t)e_hb * S + slot] = e_val; } npend = 0; }
            }
        }
        if (npend > 0) { if (lane < npend) { const int slot = (int)atomicAdd(ctl + CW_CNT + e_hb, 1u); LIST[(size_t)e_hb * S + slot] = e_val; } npend = 0; }
    }
    __syncthreads();
}

template <int DK>
__device__ __forceinline__ void attn_item(const int tid, LAS unsigned char* lds, const bf16_t* Qb, int ldq, int qrow, bool qvalid, int qpos, int wqmin,
                                          const bf16_t* Kp, int ldk, const bf16_t* VT, int key0, int ntiles,
                                          float kmaxA, float kmaxB, const int OM, const int oidx, float* o32b, bf16_t* obb, float* lpb) {
    constexpr int NKS = DK / 16, SPRK = DK / 8 + 1, KSTR = SPRK * 16, NKI = SPRK, KBYTES = NKI * 1024, VSTR = 144, NVI = 18, BUF = KBYTES + NVI * 1024, KW = (DK == 192 ? 5 : 4), NII = 6;
    const int lane = tid & 63, r = lane & 31, hh = lane >> 5, wave = __builtin_amdgcn_readfirstlane(tid >> 6);
    bf16x8 qf[NKS];
    { const bf16_t* qp = Qb + (size_t)qrow * ldq + 8 * hh;
#pragma unroll
      for (int ks = 0; ks < NKS; ++ks) qf[ks] = *(const bf16x8*)(qp + 16 * ks); }
    float na = 0.f, nb = 0.f;
#pragma unroll
    for (int ks = 0; ks < NKS; ++ks)
#pragma unroll
        for (int e = 0; e < 8; ++e) { const float f = bf2f((unsigned)(unsigned short)qf[ks][e]); if (ks < 8) na += f * f; else nb += f * f; }
    na += __shfl_xor(na, 32); nb += __shfl_xor(nb, 32);
    const float negr = -(sqrtf(na) * kmaxA + sqrtf(nb) * kmaxB);
    const bool kwave = wave < KW;
    const int jw = kwave ? wave : wave - KW, jstride = kwave ? KW : 8 - KW, jn = kwave ? NKI : NVI;
    const unsigned char* gbase = kwave ? (const unsigned char*)Kp : (const unsigned char*)VT;
    const unsigned gstep = kwave ? (unsigned)ldk * 128u : 128u, ldst0 = kwave ? 0u : (unsigned)KBYTES;
    unsigned goff[NII];
#pragma unroll
    for (int ii = 0; ii < NII; ++ii) { const int sg = 64 * (jw + jstride * ii) + lane;
        if (kwave) { const int row = sg / SPRK; int part = sg - row * SPRK; if (part == SPRK - 1) part = 0; goff[ii] = (unsigned)(((key0 + row) * ldk + part * 8) * 2); }
        else { const int dv = sg / 9; int part = sg - dv * 9; if (part == 8) part = 0; goff[ii] = (unsigned)((dv * S + key0 + part * 8) * 2); } }
#define AT_DMA(tt, b) do { _Pragma("unroll") for (int ii_ = 0; ii_ < NII; ++ii_) { const int j_ = jw + jstride * ii_; if (j_ < jn) \
        __builtin_amdgcn_global_load_lds((const unsigned*)(gbase + (size_t)(goff[ii_] + (unsigned)(tt) * gstep)), (LAS unsigned*)(lds + (b) * BUF + ldst0 + j_ * 1024), 16, 0, 0); } } while (0)
    AT_DMA(0, 0);
    f32x16 o[4];
#pragma unroll
    for (int d = 0; d < 4; ++d)
#pragma unroll
        for (int i = 0; i < 16; ++i) o[d][i] = 0.f;
    float lsum = 0.f;
    const int pr = (r & 0x13) | ((r & 4) << 1) | ((r & 8) >> 1);
    const unsigned koff = (unsigned)(pr * KSTR + 16 * hh), voff = (unsigned)(KBYTES + r * VSTR + 16 * hh);
    asm volatile("s_waitcnt vmcnt(0)" ::: "memory"); __syncthreads();
#pragma unroll 1
    for (int t = 0; t < ntiles; ++t) {
        const int cur = t & 1;
        if (t + 1 < ntiles) AT_DMA(t + 1, cur ^ 1);
        LAS const unsigned char* bp = lds + cur * BUF;
        bf16x8 pf[2][2];
#pragma unroll
        for (int kb = 0; kb < 2; ++kb) {
            f32x16 acc;
#pragma unroll
            for (int i = 0; i < 16; ++i) acc[i] = negr;
#pragma unroll
            for (int ks = 0; ks < NKS; ++ks) { const bf16x8 kf = *(LAS const bf16x8*)(bp + koff + kb * 32 * KSTR + 32 * ks); acc = __builtin_amdgcn_mfma_f32_32x32x16_bf16(kf, qf[ks], acc, 0, 0, 0); }
            const int kt0 = key0 + 64 * t + 32 * kb + 8 * hh;
            if (key0 + 64 * t + 63 > wqmin) {
#pragma unroll
                for (int i = 0; i < 16; ++i) if (kt0 + 16 * (i >> 3) + (i & 7) > qpos) acc[i] = -INFINITY; }
#pragma unroll
            for (int i = 0; i < 16; ++i) { const float p = __builtin_amdgcn_exp2f(acc[i]); lsum += p; acc[i] = p; }
            u32x4 w0, w1;
            w0.x = pk2(acc[0], acc[1]); w0.y = pk2(acc[2], acc[3]); w0.z = pk2(acc[4], acc[5]); w0.w = pk2(acc[6], acc[7]);
            w1.x = pk2(acc[8], acc[9]); w1.y = pk2(acc[10], acc[11]); w1.z = pk2(acc[12], acc[13]); w1.w = pk2(acc[14], acc[15]);
            pf[kb][0] = __builtin_bit_cast(bf16x8, w0); pf[kb][1] = __builtin_bit_cast(bf16x8, w1);
        }
#pragma unroll
        for (int d = 0; d < 4; ++d)
#pragma unroll
            for (int kb = 0; kb < 2; ++kb)
#pragma unroll
                for (int s = 0; s < 2; ++s) { const bf16x8 vf = *(LAS const bf16x8*)(bp + voff + d * 32 * VSTR + (32 * kb + 16 * s) * 2); o[d] = __builtin_amdgcn_mfma_f32_32x32x16_bf16(vf, pf[kb][s], o[d], 0, 0, 0); }
        asm volatile("s_waitcnt vmcnt(0)" ::: "memory");
        __syncthreads();
    }
#undef AT_DMA
    lsum += __shfl_xor(lsum, 32);
    if (qvalid) {
        float* o32 = o32b + (size_t)oidx * 128; bf16_t* ob = obb + (size_t)oidx * (OM == 0 ? D : 128); float* lp = lpb + oidx;
        if (OM == 1) {
#pragma unroll
            for (int d = 0; d < 4; ++d)
#pragma unroll
                for (int i4 = 0; i4 < 4; ++i4) *(f32x4*)(o32 + 32 * d + 8 * i4 + 4 * hh) = (f32x4){o[d][4 * i4], o[d][4 * i4 + 1], o[d][4 * i4 + 2], o[d][4 * i4 + 3]};
            if (hh == 0) *lp = lsum;
        } else {
            const float sc = OM == 0 ? 1.f / lsum : 1.f;
#pragma unroll
            for (int d = 0; d < 4; ++d)
#pragma unroll
                for (int i4 = 0; i4 < 4; ++i4) { u32x2 w; w.x = pk2(o[d][4 * i4] * sc, o[d][4 * i4 + 1] * sc); w.y = pk2(o[d][4 * i4 + 2] * sc, o[d][4 * i4 + 3] * sc); *(u32x2*)(ob + 32 * d + 8 * i4 + 4 * hh) = w; }
            if (OM == 2 && hh == 0) *lp = lsum;
        }
    }
}

constexpr int N_MLA_ITEMS = 384, N_OWN_ITEMS = 256, N_FIXED_ITEMS = N_MLA_ITEMS + N_OWN_ITEMS;
__device__ __forceinline__ void attn_phase(const Params& P, int l, LAS unsigned char* lds, int G, int rep = 0) {
    const int tid = threadIdx.x, lane = tid & 63, wave = tid >> 6, r = lane & 31;
    unsigned char* ws = P.ws; unsigned char* dout = (unsigned char*)P.out;
    unsigned* ctl = (unsigned*)(ws + WS_CTL) + l * CW_LAYER;
    float* PART = (float*)(dout + DO_PART); float* PL = (float*)(dout + DO_PL); bf16_t* PARTB = (bf16_t*)(dout + DO_PARTB); float* LB = (float*)(dout + DO_LB); const int* LIST = (const int*)(dout + DO_LIST);
    const bf16_t* Q = (const bf16_t*)(ws + WS_Q); const bf16_t* KK = (const bf16_t*)(ws + WS_K); const bf16_t* VT = (const bf16_t*)(ws + WS_VT); bf16_t* CC = (bf16_t*)(ws + WS_CONCAT);
    const bf16_t* MQ = (const bf16_t*)(ws + WS_MQ); const bf16_t* MK = (const bf16_t*)(ws + WS_MK); const bf16_t* MVT = (const bf16_t*)(ws + WS_MVT);
    LAS int* qidx = (LAS int*)(lds + LDS_MISC); LAS int* pre = (LAS int*)(lds + LDS_MISC + 64);
    __syncthreads();
    if (tid < 256) pre[1 + tid] = (int)((ctl[CW_CNT + tid] + 255u) >> 8);
    __syncthreads();
    if (tid == 0) { pre[0] = 0; int run = 0; for (int i = 0; i < 256; ++i) { run += pre[1 + i]; pre[1 + i] = run; } }
    __syncthreads();
    const int total = N_FIXED_ITEMS + pre[256];
    const float kpemax = sqrtf(__uint_as_float(ctl[CW_KPEMAX]));
    for (;;) {
        if (tid == 0) qidx[0] = (int)atomicAdd(ctl + CW_QCTR + 2 * rep, 1u);
        __syncthreads();
        const int idx = qidx[0];
        __syncthreads();
        if (idx >= total) break;
        if (idx < N_MLA_ITEMS) {
            const int h = idx & 3, j = idx >> 2; int qb, t0, nt, kind;
            if (j < 32) { qb = 32 + j; t0 = 0; nt = 128; kind = 1; }
            else { const int k = j - 32; if (k & 1) { qb = 31 - (k >> 1); t0 = 0; nt = 4 * (qb + 1); kind = 0; } else { qb = 63 - (k >> 1); t0 = 128; nt = 4 * (qb - 31); kind = 2; } }
            const int qrow = 256 * qb + 32 * wave + r;
            const float knmax = sqrtf(__uint_as_float(ctl[CW_KNPIECE + h * 4 + 0]) + __uint_as_float(ctl[CW_KNPIECE + h * 4 + 1]) + __uint_as_float(ctl[CW_KNPIECE + h * 4 + 2]) + __uint_as_float(ctl[CW_KNPIECE + h * 4 + 3]));
            const int slot = (h * 32 + (qb & 31)) * 2 + (kind == 2 ? 1 : 0); const bool causal = kind != 1;
            attn_item<192>(tid, lds, Q + h * 192, 768, qrow, true, causal ? qrow : 0x7fffffff, causal ? 256 * qb + 32 * wave : 0x7fffffff, KK + h * 192, 768, VT + (size_t)h * 128 * S, 64 * t0, nt, knmax, kpemax,
                           kind == 0 ? 0 : 1, kind == 0 ? qrow : 32 * wave + r, PART + (size_t)slot * 256 * 128, CC + h * 128, PL + (size_t)slot * 256);
        } else {
            int h, key0, qrow, qpos, wqmin, pslot; bool valid = true;
            if (idx < N_FIXED_ITEMS) { const int k = idx - N_MLA_ITEMS; h = k & 3; const int blk = k >> 2; key0 = 256 * blk; qrow = 256 * blk + 32 * wave + r; qpos = qrow; wqmin = 256 * blk + 32 * wave; pslot = 3; }
            else { const int g2 = idx - N_FIXED_ITEMS; int lo = 0, hi = 256;
                while (hi - lo > 1) { const int mid = (lo + hi) >> 1; if (pre[mid] <= g2) lo = mid; else hi = mid; }
                const int hb = lo, chunk = g2 - pre[hb]; const int cntv = (int)ctl[CW_CNT + hb]; int nq = cntv - 256 * chunk; nq = nq > 256 ? 256 : nq;
                const int li = 32 * wave + r; valid = li < nq; const int ent = LIST[(size_t)hb * S + 256 * chunk + (valid ? li : 0)]; qrow = ent >> 2; pslot = ent & 3;
                h = hb >> 6; key0 = 256 * (hb & 63); qpos = 0x7fffffff; wqmin = 0x7fffffff; }
            const float kmmax = sqrtf(__uint_as_float(ctl[CW_KMMAX + h]));
            attn_item<128>(tid, lds, MQ + h * 128, 512, qrow, valid, qpos, wqmin, MK + h * 128, 512, MVT + (size_t)h * 128 * S, key0, 4, kmmax, 0.f, 2, (qrow * 4 + h) * 4 + pslot, nullptr, PARTB, LB);
        }
    }
}
__device__ __forceinline__ void attn_norm_phase(const Params& P, int G) {
    int tid_l = threadIdx.x; asm volatile("" : "+v"(tid_l)); const int lane = tid_l & 63, wave = tid_l >> 6;
    unsigned char* dout = (unsigned char*)P.out;
    const float* PART = (const float*)(dout + DO_PART); const float* PL = (const float*)(dout + DO_PL); const bf16_t* PARTB = (const bf16_t*)(dout + DO_PARTB); const float* LB = (const float*)(dout + DO_LB);
    bf16_t* CC = (bf16_t*)(P.ws + WS_CONCAT);
    for (int row = blockIdx.x * NWV + wave; row < S; row += G * NWV) {
        float acc[16]; float lt = 0.f; bool wr = false;
#pragma unroll
        for (int e = 0; e < 16; ++e) acc[e] = 0.f;
        const int qb = row >> 8;
        if (lane < 32) { if (qb >= 32) { wr = true; const int h = lane >> 3;
#pragma unroll
                for (int c = 0; c < 2; ++c) { const size_t slot = (size_t)((h * 32 + qb - 32) * 2 + c) * 256 + (row & 255); lt += PL[slot]; const f32x4* pp = (const f32x4*)(PART + slot * 128 + 16 * (lane & 7));
#pragma unroll
                    for (int e4 = 0; e4 < 4; ++e4) { const f32x4 v = pp[e4]; acc[4 * e4] += v[0]; acc[4 * e4 + 1] += v[1]; acc[4 * e4 + 2] += v[2]; acc[4 * e4 + 3] += v[3]; } } } }
        else { wr = true; const int h = (lane >> 3) - 4; const int np = qb < 3 ? qb : 3;
#pragma unroll
            for (int sl = 0; sl < 4; ++sl) if (sl == 3 || sl < np) { const size_t ps = ((size_t)row * 4 + h) * 4 + sl; lt += LB[ps]; const u32x4* pp = (const u32x4*)(PARTB + ps * 128 + 16 * (lane & 7));
#pragma unroll
                for (int e8 = 0; e8 < 2; ++e8) { const u32x4 v = pp[e8];
                    acc[8 * e8 + 0] += bf2f(v.x & 0xffffu); acc[8 * e8 + 1] += bf2f(v.x >> 16); acc[8 * e8 + 2] += bf2f(v.y & 0xffffu); acc[8 * e8 + 3] += bf2f(v.y >> 16);
                    acc[8 * e8 + 4] += bf2f(v.z & 0xffffu); acc[8 * e8 + 5] += bf2f(v.z >> 16); acc[8 * e8 + 6] += bf2f(v.w & 0xffffu); acc[8 * e8 + 7] += bf2f(v.w >> 16); } } }
        if (wr) { const float inv = 1.f / lt; u32x4 w0, w1;
            w0.x = pk2(acc[0] * inv, acc[1] * inv); w0.y = pk2(acc[2] * inv, acc[3] * inv); w0.z = pk2(acc[4] * inv, acc[5] * inv); w0.w = pk2(acc[6] * inv, acc[7] * inv);
            w1.x = pk2(acc[8] * inv, acc[9] * inv); w1.y = pk2(acc[10] * inv, acc[11] * inv); w1.z = pk2(acc[12] * inv, acc[13] * inv); w1.w = pk2(acc[14] * inv, acc[15] * inv);
            u32x4* dst = (u32x4*)(CC + (size_t)row * D + 16 * lane); dst[0] = w0; dst[1] = w1; }
    }
}

#ifdef SELFCHECK
constexpr int CW_CHK = 40;
__device__ __forceinline__ float blk_reduce(const int tid, float v, bool domax, LAS float* red) {
#pragma unroll
    for (int o = 1; o < 64; o <<= 1) { const float w = __shfl_xor(v, o); v = domax ? fmaxf(v, w) : v + w; }
    __syncthreads(); if ((tid & 63) == 0) red[tid >> 6] = v; __syncthreads();
    float r = red[0];
#pragma unroll
    for (int i = 1; i < 8; ++i) r = domax ? fmaxf(r, red[i]) : r + red[i];
    __syncthreads();
    return r;
}
__device__ __forceinline__ int chk_token(int i) {
    if (i < 16) { const int base = (i >> 1) == 0 ? 0 : (i >> 1) == 1 ? 32 : (i >> 1) == 2 ? 64 : (i >> 1) == 3 ? 128 : (i >> 1) == 4 ? 256 : (i >> 1) == 5 ? 512 : (i >> 1) == 6 ? 768 : 1024;
        return (i & 1) ? (i == 1 ? 1 : i == 9 ? 257 : base - 1) : base; }
    return (i * 64 + (i * 13) % 64) & (S - 1); }
__device__ __forceinline__ bool chk_softmax_pv(const int tid, LAS float* sbuf, LAS int* kmap, int n, const bf16_t* VTh, const bf16_t* CC, int t, int col0, LAS float* red, LAS float* obuf) {
    float m = -INFINITY; for (int k = tid; k < n; k += NT) m = fmaxf(m, sbuf[k]);
    m = blk_reduce(tid, m, true, red);
    float l = 0.f; for (int k = tid; k < n; k += NT) { const float p = __builtin_amdgcn_exp2f(sbuf[k] - m); sbuf[k] = p; l += p; }
    l = blk_reduce(tid, l, false, red);
    const int dv = tid & 127, part = tid >> 7; float o = 0.f;
    for (int k = part; k < n; k += 4) { const int key = kmap ? kmap[k] : k; o += sbuf[k] * bf2f(VTh[(size_t)dv * S + key]); }
    obuf[tid] = o; __syncthreads();
    float ref = 0.f, err = 0.f;
    if (tid < 128) { ref = (obuf[tid] + obuf[tid + 128] + obuf[tid + 256] + obuf[tid + 384]) / l; err = fabsf(ref - bf2f(CC[(size_t)t * D + col0 + tid])); ref = fabsf(ref); }
    const float mref = blk_reduce(tid, ref, true, red), merr = blk_reduce(tid, err, true, red);
    return !(merr <= 0.02f * mref + 1e-6f);
}
__device__ __forceinline__ void selfcheck_attn(const Params& P, LAS unsigned char* lds, int l, int G) {
    int tid_l = threadIdx.x; asm volatile("" : "+v"(tid_l)); const int tid = tid_l; unsigned char* ws = P.ws;
    unsigned* flag = (unsigned*)(ws + WS_CTL) + CW_CHK; unsigned* ctl = (unsigned*)(ws + WS_CTL) + l * CW_LAYER;
    const bf16_t* Q = (const bf16_t*)(ws + WS_Q); const bf16_t* KK = (const bf16_t*)(ws + WS_K); const bf16_t* VT = (const bf16_t*)(ws + WS_VT); const bf16_t* KPE = (const bf16_t*)(ws + WS_KPE);
    const bf16_t* MQ = (const bf16_t*)(ws + WS_MQ); const bf16_t* MK = (const bf16_t*)(ws + WS_MK); const bf16_t* MVT = (const bf16_t*)(ws + WS_MVT);
    const bf16_t* CC = (const bf16_t*)(ws + WS_CONCAT); const bf16_t* CQN = (const bf16_t*)(ws + WS_CQN); const bf16_t* CKVN = (const bf16_t*)(ws + WS_CKVN);
    const float* kmean = (const float*)(ctl + CW_KMEAN); const float* RM = (const float*)(ws + WS_ROPE_MLA);
    LAS float* sbuf = (LAS float*)lds;
    LAS float* qv = (LAS float*)(lds + 65536);
    LAS float* obuf = (LAS float*)(lds + 65536 + 4096);
    LAS float* red = (LAS float*)(lds + 65536 + 8192);
    LAS int* kmap = (LAS int*)(lds + 65536 + 12288);
    LAS float* gate = (LAS float*)(lds + 65536 + 20480);
    LAS int* sel = (LAS int*)(lds + 65536 + 20480 + 256);
    for (int smp = blockIdx.x; smp < 256; smp += G) {
        const int t = chk_token(smp), h = smp & 3; unsigned bad = 0u;
        __syncthreads();
        if (tid < 192) qv[tid] = bf2f(Q[(size_t)t * 768 + h * 192 + tid]);
        __syncthreads();
        for (int k = tid; k <= t; k += NT) { const bf16_t* kr = KK + (size_t)k * 768 + h * 192; float sc = 0.f; for (int d = 0; d < 192; ++d) sc += qv[d] * bf2f(kr[d]); sbuf[k] = sc; }
        __syncthreads();
        if (chk_softmax_pv(tid, sbuf, nullptr, t + 1, VT + (size_t)h * 128 * S, CC, t, h * 128, red, obuf)) bad |= 1u;
        const int own = t >> 8;
        if (tid < 128) qv[tid] = bf2f(MQ[(size_t)t * 512 + h * 128 + tid]);
        __syncthreads();
        if (tid < 64) { float g = -INFINITY; if (tid < own) { g = 0.f; for (int d = 0; d < 128; ++d) g += qv[d] * kmean[(size_t)(h * 64 + tid) * 128 + d] * (1.f / 256.f); } gate[tid] = g; }
        __syncthreads();
        if (tid == 0) { int ns = own < 3 ? own : 3; float last = 0.f; for (int p = 0; p < 4; ++p) { int bi = -1; float bv = -INFINITY; for (int b = 0; b < own; ++b) if (gate[b] > bv) { bv = gate[b]; bi = b; }
                if (p < 3) { sel[p] = bi; last = bv; if (bi >= 0) gate[bi] = -INFINITY; } else sel[4] = (own > 3 && last - bv < 1e-4f * (fabsf(last) + 1e-3f)) ? 1 : 0; }
            sel[3] = ns; }
        __syncthreads();
        const int ns = sel[3], skip = sel[4]; const int nown = t - 256 * own + 1, n = 256 * ns + nown;
        for (int kk = tid; kk < n; kk += NT) { const int key = kk < 256 * ns ? 256 * sel[kk >> 8] + (kk & 255) : 256 * own + (kk - 256 * ns); kmap[kk] = key;
            const bf16_t* kr = MK + (size_t)key * 512 + h * 128; float sc = 0.f; for (int d = 0; d < 128; ++d) sc += qv[d] * bf2f(kr[d]); sbuf[kk] = sc; }
        __syncthreads();
        if (chk_softmax_pv(tid, sbuf, kmap, n, MVT + (size_t)h * 128 * S, CC, t, 512 + h * 128, red, obuf) && !skip) bad |= 2u;
        { const float* wuq = P.in[4] + (size_t)l * 512 * 768; const float* gq = P.in[3] + l * 512;
          for (int nn = tid; nn < 768; nn += NT) { float a = 0.f; for (int k = 0; k < 512; ++k) a += bf2f(CQN[(size_t)t * 512 + k]) * gq[k] * wuq[(size_t)k * 768 + nn]; qv[nn] = a * CQ_SCALE; }
          __syncthreads();
          float ref = 0.f, err = 0.f;
          for (int nn = tid; nn < 768; nn += NT) { const int hd = nn / 192, d = nn - hd * 192; float v; int pos;
              if (d < 128) { v = qv[nn]; pos = nn; }
              else { const int e = d - 128, j = e & 31; const float x1 = qv[hd * 192 + 128 + j], x2 = qv[hd * 192 + 160 + j], c = RM[((size_t)t * 32 + j) * 2], sn = RM[((size_t)t * 32 + j) * 2 + 1];
                  v = e < 32 ? x1 * c - x2 * sn : x1 * sn + x2 * c; pos = hd * 192 + 128 + 2 * j + (e >> 5); }
              ref = fmaxf(ref, fabsf(v)); err = fmaxf(err, fabsf(v - bf2f(Q[(size_t)t * 768 + pos]))); }
          const float mref = blk_reduce(tid, ref, true, red), merr = blk_reduce(tid, err, true, red);
          if (!(merr <= 0.03f * mref + 1e-6f)) bad |= 4u; }
        { const float* wkv = P.in[6] + (size_t)l * 256 * 1024; const float* gk = P.in[5] + l * 256; float ref = 0.f, err = 0.f;
          for (int nn = tid; nn < 1024; nn += NT) { float a = 0.f; for (int k = 0; k < 256; ++k) a += bf2f(CKVN[(size_t)t * 256 + k]) * gk[k] * wkv[(size_t)k * 1024 + nn];
              const int hd = nn >> 8, d = nn & 255; const float got = d < 128 ? bf2f(KK[(size_t)t * 768 + hd * 192 + d]) : bf2f(VT[(size_t)(hd * 128 + d - 128) * S + t]);
              ref = fmaxf(ref, fabsf(a)); err = fmaxf(err, fabsf(a - got)); }
          if (tid < 256) { const int hd = tid >> 6, e = tid & 63; if (KK[(size_t)t * 768 + hd * 192 + 128 + e] != KPE[(size_t)t * 64 + e]) err = 1e30f; }
          const float mref = blk_reduce(tid, ref, true, red), merr = blk_reduce(tid, err, true, red);
          if (!(merr <= 0.03f * mref + 1e-6f)) bad |= 8u; }
        { const int b = (smp >> 2) & 63; float ref = 0.f, err = 0.f;
          if (tid < 128) { float a = 0.f; for (int i = 0; i < 256; ++i) a += bf2f(MK[(size_t)(256 * b + i) * 512 + h * 128 + tid]); a *= (1.f / 256.f); ref = fabsf(a); err = fabsf(a - kmean[(size_t)(h * 64 + b) * 128 + tid] * (1.f / 256.f)); }
          const float mref = blk_reduce(tid, ref, true, red), merr = blk_reduce(tid, err, true, red);
          if (!(merr <= 0.02f * mref + 1e-6f)) bad |= 16u; }
        if (tid == 0 && bad) atomicOr(flag, bad);
    }
    __syncthreads();
}
__device__ __forceinline__ void selfcheck_p2a(const Params& P, LAS unsigned char* lds, int G) {
    int tid_l = threadIdx.x; asm volatile("" : "+v"(tid_l)); const int tid = tid_l; unsigned char* ws = P.ws; unsigned* flag = (unsigned*)(ws + WS_CTL) + CW_CHK;
    const bf16_t* H = (const bf16_t*)(ws + WS_H); const bf16_t* MQ = (const bf16_t*)(ws + WS_MQ); const bf16_t* MK = (const bf16_t*)(ws + WS_MK); const bf16_t* MVT = (const bf16_t*)(ws + WS_MVT); const bf16_t* KPE = (const bf16_t*)(ws + WS_KPE);
    const float* RM = (const float*)(ws + WS_ROPE_MLA); const float* RO = (const float*)(ws + WS_ROPE_MOBA);
    LAS float* red = (LAS float*)(lds + 65536 + 8192);
    for (int smp = blockIdx.x; smp < 256; smp += G) { const int t = chk_token(smp); float err = 0.f; const bf16_t* hr = H + (size_t)t * HLD;
        { const int c = tid, d = c & 127; float q = bf2f(hr[C_MQ + c]), k = bf2f(hr[C_MK + c]);
          if (d < 32) { const int j = d & 15; const float cs = RO[((size_t)t * 16 + j) * 2], sn = RO[((size_t)t * 16 + j) * 2 + 1];
              const float q1 = bf2f(hr[C_MQ + (c & ~31) + j]), q2 = bf2f(hr[C_MQ + (c & ~31) + 16 + j]), k1 = bf2f(hr[C_MK + (c & ~31) + j]), k2 = bf2f(hr[C_MK + (c & ~31) + 16 + j]);
              q = d < 16 ? q1 * cs - q2 * sn : q1 * sn + q2 * cs; k = d < 16 ? k1 * cs - k2 * sn : k1 * sn + k2 * cs; }
          err = fmaxf(err, fabsf(q * CM_SCALE - bf2f(MQ[(size_t)t * 512 + c])) / (fabsf(q * CM_SCALE) + 0.05f));
          err = fmaxf(err, fabsf(k - bf2f(MK[(size_t)t * 512 + c])) / (fabsf(k) + 0.5f));
          if (MVT[(size_t)c * S + t] != hr[C_MV + c]) err = 1e30f;
          if (c < 64) { const int j = c & 31; const float x1 = bf2f(hr[C_KR + j]), x2 = bf2f(hr[C_KR + 32 + j]), cs = RM[((size_t)t * 32 + j) * 2], sn = RM[((size_t)t * 32 + j) * 2 + 1];
              const float v = c < 32 ? x1 * cs - x2 * sn : x1 * sn + x2 * cs; err = fmaxf(err, fabsf(v - bf2f(KPE[(size_t)t * 64 + 2 * j + (c >> 5)])) / (fabsf(v) + 0.5f)); } }
        const float merr = blk_reduce(tid, err, true, red);
        if (tid == 0 && !(merr <= 0.02f)) atomicOr(flag, 32u); }
    __syncthreads();
}
#endif

#ifdef NO_GSYNC
#define GSYNC() __syncthreads()
#else
#define GSYNC() grid.sync()
#endif
template <int l> __device__ __forceinline__ void layer_fwd(const Params& P, LAS unsigned char* lds, cg::grid_group& grid, const int G) {
    unsigned char* ws = P.ws;

        unsigned* ctl = (unsigned*)(ws + WS_CTL) + l * CW_LAYER;
        float* Y = (float*)(ws + WS_Y); float* stats1 = (float*)(ws + WS_STATS); float* stats2 = stats1 + (size_t)S * 2;
#ifndef SKIP_G1
        { EpiStore E{(bf16_t*)(ws + WS_H), HLD}; GEMM_CALL(EpiStore, E, ws + WS_XB, ws + WS_WIN, HLD, D, (int)blockIdx.x); }
#endif
#ifdef REP_G1
        GSYNC(); { EpiStore E{(bf16_t*)(ws + WS_H), HLD}; GEMM_CALL(EpiStore, E, ws + WS_XB, ws + WS_WIN, HLD, D, (int)blockIdx.x); }
#endif
        GSYNC();

#ifndef SKIP_P2A
        p2a_phase(P, l, lds, G);
#endif
#ifdef SELFCHECK
        GSYNC(); selfcheck_p2a(P, lds, G);
#endif

        GSYNC();
#ifndef SKIP_G2
        { EpiQ E{(bf16_t*)(ws + WS_Q), (const float*)(ws + WS_ROPE_MLA)}; GEMM_CALL(EpiQ, E, ws + WS_CQN, ws + WS_WUQ, 768, 512, (int)blockIdx.x); }
#endif
#ifndef SKIP_G3
        { EpiKV E{(bf16_t*)(ws + WS_K), (bf16_t*)(ws + WS_VR), (const bf16_t*)(ws + WS_KPE), ctl + CW_KNPIECE}; int kkv = 256; asm volatile("" : "+s"(kkv)); GEMM_CALL(EpiKV, E, ws + WS_CKVN, ws + WS_WUKV, 1024, kkv, (int)blockIdx.x);
          __threadfence_block(); __syncthreads();
          { pg8::StaticOrder so2; so2.init(S, 1024, G, (int)blockIdx.x); pg8::Unit u2; for (int i2 = 0; so2.next(i2, u2); ++i2) vt_tile((const bf16_t*)(ws + WS_VR), (bf16_t*)(ws + WS_VT), u2.pm, u2.pn); } }
#endif
#ifndef SKIP_G4
        { EpiStore E{(bf16_t*)(ws + WS_CONCAT) + 1024, D}; GEMM_CALL(EpiStore, E, ws + WS_CONVA, ws + WS_WPW, 512, 512, (int)((blockIdx.x + 128) % G)); }
#endif
#ifndef SKIP_G5
        { EpiStore E{(bf16_t*)(ws + WS_CONCAT) + 1536, D}; GEMM_CALL(EpiStore, E, ws + WS_POOLED, ws + WS_WPOOL, 512, 512, (int)((blockIdx.x + 64) % G)); }
#endif

#ifndef SKIP_GATE
        gate_phase(P, l, lds, G);
#endif

        GSYNC();

#ifndef SKIP_ATTN
        attn_phase(P, l, lds, G);
#endif
#ifdef REP_ATTN
        GSYNC(); attn_phase(P, l, lds, G, 1);
#endif

        GSYNC();

#ifndef SKIP_NORM
        attn_norm_phase(P, G);
#endif
#ifdef SELFCHECK
        GSYNC(); selfcheck_attn(P, lds, l, G);
#endif

        GSYNC();
#ifndef SKIP_G6
        if (l == 0) { EpiRes<0> E{P.in[0], Y, nullptr, nullptr, nullptr}; GEMM_CALL(EpiRes<0>, E, ws + WS_CONCAT, ws + WS_WOUT, D, D, (int)blockIdx.x); }
        else { EpiRes<1> E{nullptr, Y, stats2, P.in[20] + (size_t)(l - 1) * D, P.in[21] + (size_t)(l - 1) * D}; GEMM_CALL(EpiRes<1>, E, ws + WS_CONCAT, ws + WS_WOUT, D, D, (int)blockIdx.x); }
#endif
        GSYNC();
        ln_phase<false>(Y, P.in[15] + (size_t)l * D, P.in[16] + (size_t)l * D, stats1, (bf16_t*)(ws + WS_XB), nullptr, G);
        GSYNC();
#ifndef SKIP_G8
        { EpiFfn E{(bf16_t*)(ws + WS_ACT)}; GEMM_CALL(EpiFfn, E, ws + WS_XB, ws + WS_WGU, 2 * DFF, D, (int)blockIdx.x); }
#endif
#ifdef REP_G8
        GSYNC(); { EpiFfn E{(bf16_t*)(ws + WS_ACT)}; GEMM_CALL(EpiFfn, E, ws + WS_XB, ws + WS_WGU, 2 * DFF, D, (int)blockIdx.x); }
#endif
        GSYNC();
#ifndef SKIP_G9
        { EpiRes<1> E{nullptr, Y, stats1, P.in[15] + (size_t)l * D, P.in[16] + (size_t)l * D}; GEMM_CALL(EpiRes<1>, E, ws + WS_ACT, ws + WS_WDN, D, DFF, (int)blockIdx.x); }
#endif
        GSYNC();
        if (l + 1 < NLAYER) { ln_phase<false>(Y, P.in[20] + (size_t)l * D, P.in[21] + (size_t)l * D, stats2, (bf16_t*)(ws + WS_XB), nullptr, G); prep_weights(P, l + 1, lds, G); GSYNC(); }
#ifdef SELFCHECK
        else ln_phase<true>(Y, P.in[20] + (size_t)l * D, P.in[21] + (size_t)l * D, nullptr, nullptr, P.out, G, (float)(*((const unsigned*)(ws + WS_CTL) + 40)));
#else
        else ln_phase<true>(Y, P.in[20] + (size_t)l * D, P.in[21] + (size_t)l * D, nullptr, nullptr, P.out, G);
#endif

}

__global__ void __launch_bounds__(NT, 2) hybrid_fwd(Params P) {
    extern __shared__ __attribute__((aligned(16))) unsigned char lds_raw[];
    LAS unsigned char* lds = (LAS unsigned char*)lds_raw;
    cg::grid_group grid = cg::this_grid();
    const int G = gridDim.x;
    unsigned char* ws = P.ws;

#ifndef SKIP_PREP
    prep_weights(P, 0, lds, G);
    prep_layer0(P, G);
#endif

    GSYNC();
    layer_fwd<0>(P, lds, grid, G);
    layer_fwd<1>(P, lds, grid, G);
}

extern "C" void kernel_launch(void* const* d_in, const int* in_sizes, int n_in, void* d_out, int out_size, void* d_ws, size_t ws_size, hipStream_t stream) {
    static int grid = 0;
    if (grid == 0) {
        if (n_in != 22 || out_size != S * D || ws_size < WS_END) { fprintf(stderr, "kernel_launch: unexpected shapes (n_in %d, out %d, ws %zu)\n", n_in, out_size, ws_size); grid = -1; return; }
        int dev = 0, cus = 0, per_cu = 0;
        hipGetDevice(&dev); hipDeviceGetAttribute(&cus, hipDeviceAttributeMultiprocessorCount, dev);
        if (hipFuncSetAttribute((const void*)hybrid_fwd, hipFuncAttributeMaxDynamicSharedMemorySize, LDS_BYTES) != hipSuccess) { fprintf(stderr, "kernel_launch: hipFuncSetAttribute failed\n"); grid = -1; return; }
        if (hipOccupancyMaxActiveBlocksPerMultiprocessor(&per_cu, (const void*)hybrid_fwd, NT, LDS_BYTES) != hipSuccess || per_cu < 1) per_cu = 1;
        (void)hipGetLastError();
        grid = cus * 1;
        fprintf(stderr, "kernel_launch: %d CUs, occupancy %d, grid %d\n", cus, per_cu, grid);
    }
    if (grid < 0) return;
    hipMemsetAsync((char*)d_ws + WS_CTL, 0, CTL_BYTES, stream);
    Params p{};
    for (int i = 0; i < 22; ++i) p.in[i] = (const float*)d_in[i];
    p.out = (float*)d_out; p.ws = (unsigned char*)d_ws;
    void* args[] = {&p};
    hipError_t e = hipLaunchCooperativeKernel((const void*)hybrid_fwd, dim3(grid), dim3(NT), args, LDS_BYTES, stream);
    if (e != hipSuccess) fprintf(stderr, "cooperative launch failed: %s (grid %d)\n", hipGetErrorString(e), grid);
}
```

```cpp
#include <hip/hip_runtime.h>
#include <hip/hip_cooperative_groups.h>
#include <cstdio>
#include <cstdint>
namespace cg = cooperative_groups;
namespace pg8 {
#define PG8_LAS __attribute__((address_space(3)))
typedef unsigned short bf16_t;
typedef short bf16x8 __attribute__((ext_vector_type(8)));
typedef float f32x4 __attribute__((ext_vector_type(4)));
typedef unsigned u32x4 __attribute__((ext_vector_type(4)));
constexpr int BM = 256, BK = 64, HALF = 128, HTB = HALF * BK * 2  , STAGE_BYTES = 8 * HTB, NXCD = 8, WGM = 4;

__host__ __device__ __forceinline__ int lds_byte(int r, int c) { const int st = (r >> 4) * 2 + (c >> 5), rr = r & 15, cc = c & 31, ob = rr * 64 + cc * 2; return st * 1024 + (ob ^ (((ob >> 9) & 1) << 5)); }
__host__ __device__ __forceinline__ void stage_rc(int b, int& R, int& C) { const int st = b / 1024, sb = b % 1024, swz = sb ^ (((sb >> 9) & 1) << 5); R = (st >> 1) * 16 + swz / 64; C = (st & 1) * 32 + (swz % 64) / 2; }
__host__ __device__ __forceinline__ int perm32(int rho) { const int n = rho >> 4, i = rho & 15; return 8 * (i >> 2) + 4 * n + (i & 3); }

struct Unit { int pm, pn; };
struct Gemm { const bf16_t* A; const bf16_t* Bt; int M, N, K; };

struct StaticOrder {
    int nM, nN, nwg, G, c;
    __host__ __device__ __forceinline__ void init(int M, int N, int G_, int c_) { nM = M / BM; nN = N / BM; nwg = nM * nN; G = G_; c = c_; }
    __host__ __device__ __forceinline__ bool next(int i, Unit& u) const {
        const long L = (long)i * G + c; if (L >= nwg) return false;
        int wgid = (int)L; { const int q = nwg / NXCD, r = nwg % NXCD, xcd = wgid % NXCD, off = wgid / NXCD; wgid = (xcd < r ? xcd * (q + 1) : r * (q + 1) + (xcd - r) * q) + off; }
        const int nig = WGM * nN, gid = wgid / nig, fm = gid * WGM, gsz = (nM - fm) < WGM ? (nM - fm) : WGM;
        u.pm = fm + ((wgid % nig) % gsz); u.pn = (wgid % nig) / gsz; return true;
    }
    __device__ __forceinline__ void a_ready(const Unit&) const {}
    __device__ __forceinline__ void done(const Unit&) const {}
};
__device__ __forceinline__ unsigned cvt_pk_bf16(float lo, float hi) { unsigned r; asm volatile("v_cvt_pk_bf16_f32 %0, %1, %2" : "=v"(r) : "v"(lo), "v"(hi)); return r; }
typedef float f32x2 __attribute__((ext_vector_type(2)));
template <class Epi, class Sched, bool ALIGN_EPI = false, bool SP2 = false>
__device__ __forceinline__ void gemm_phase(PG8_LAS unsigned char* lds, const Gemm g, const Sched& S, const Epi& E) {
    int tid_l = threadIdx.x; asm volatile("" : "+v"(tid_l)); const int tid = tid_l, wid = __builtin_amdgcn_readfirstlane(tid >> 6), lane = tid & 63, wr = wid >> 2, wc = wid & 3, fr = lane & 15, fq = lane >> 4;
    const int K = g.K, nt = K / BK;
    unsigned voffA[2], voffB[2];
#pragma unroll
    for (int i = 0; i < 2; ++i) { int R, C; stage_rc(tid * 16 + i * 8192, R, C); const int Rb = Epi::PERM ? ((R & ~31) + perm32(R & 31)) : R;
        voffA[i] = (unsigned)(R * K + C) * 2u; voffB[i] = (unsigned)(Rb * K + C) * 2u; }
    const size_t kstep = (size_t)(BK * 2);
    const size_t hstep = (size_t)HALF * K * 2;
    const size_t tstep = 2 * hstep;
    const unsigned ldsw = (unsigned)wid * 1024u;
    const int aoff = lds_byte(wr * 64 + fr, fq * 8), boff = lds_byte(wc * 32 + fr, fq * 8);
#define PG8_SA(b, h) (((b) * 2 + (h)) * HTB)
#define PG8_SB(b, h) ((4 + (b) * 2 + (h)) * HTB)
#define PG8_STAGE(bufoff, gbase, voff) do { _Pragma("unroll") for (int _i = 0; _i < 2; ++_i) \
        __builtin_amdgcn_global_load_lds((const unsigned*)((const char*)(gbase) + (voff)[_i]), (PG8_LAS unsigned*)(lds + (bufoff) + ldsw + _i * 8192), 16, 0, 0); } while (0)
#define PG8_LDA(dst, b, h) do { _Pragma("unroll") for (int m = 0; m < 4; ++m) _Pragma("unroll") for (int k = 0; k < 2; ++k) dst[m][k] = *(const PG8_LAS bf16x8*)(lds + PG8_SA(b, h) + aoff + m * 2048 + k * 1024); } while (0)
#define PG8_LDB(dst, b, h) do { _Pragma("unroll") for (int n = 0; n < 2; ++n) _Pragma("unroll") for (int k = 0; k < 2; ++k) dst[n][k] = *(const PG8_LAS bf16x8*)(lds + PG8_SB(b, h) + boff + n * 2048 + k * 1024); } while (0)
#define PG8_MMA(ai, bj, At, Bt) do { __builtin_amdgcn_s_setprio(1); _Pragma("unroll") for (int m = 0; m < 4; ++m) _Pragma("unroll") for (int n = 0; n < 2; ++n) _Pragma("unroll") for (int k = 0; k < 2; ++k) \
        acc[ai][bj][m][n] = __builtin_amdgcn_mfma_f32_16x16x32_bf16(Bt[n][k], At[m][k], acc[ai][bj][m][n], 0, 0, 0); __builtin_amdgcn_s_setprio(0); } while (0)
#define PG8_WAIT_V(n) asm volatile("s_waitcnt vmcnt(" #n ")" ::: "memory")
#define PG8_WAIT_L(n) asm volatile("s_waitcnt lgkmcnt(" #n ")" ::: "memory")
#define PG8_BAR __builtin_amdgcn_s_barrier()
#define PG8_SCHED __builtin_amdgcn_sched_barrier(0)
    Unit cur, nxt; int ui = 0;
    if (!S.next(0, cur)) return;
    f32x4 acc[2][2][4][2];
#pragma unroll
    for (int a = 0; a < 2; ++a)
#pragma unroll
        for (int b = 0; b < 2; ++b)
#pragma unroll
            for (int m = 0; m < 4; ++m)
#pragma unroll
                for (int n = 0; n < 2; ++n) acc[a][b][m][n] = (f32x4){0.f, 0.f, 0.f, 0.f};
    bf16x8 At[4][2], B0[2][2], B1[2][2];
    const char* cA = (const char*)g.A + (size_t)cur.pm * tstep; const char* cB = (const char*)g.Bt + (size_t)cur.pn * tstep;
    S.a_ready(cur);
    if constexpr (SP2) {
        PG8_STAGE(PG8_SB(0, 0), cB, voffB); PG8_STAGE(PG8_SB(0, 1), cB + hstep, voffB); PG8_STAGE(PG8_SA(0, 0), cA, voffA); PG8_STAGE(PG8_SA(0, 1), cA + hstep, voffA);
        if (wr == 1) PG8_BAR;
        PG8_WAIT_V(2); PG8_BAR;
        PG8_STAGE(PG8_SB(1, 0), cB + kstep, voffB); PG8_STAGE(PG8_SA(1, 0), cA + kstep, voffA); PG8_STAGE(PG8_SB(1, 1), cB + hstep + kstep, voffB);
        PG8_WAIT_V(6); PG8_BAR;
    } else {
        PG8_STAGE(PG8_SB(0, 0), cB, voffB); PG8_STAGE(PG8_SA(0, 0), cA, voffA); PG8_STAGE(PG8_SB(0, 1), cB + hstep, voffB); PG8_STAGE(PG8_SA(0, 1), cA + hstep, voffA);
        if (wr == 1) PG8_BAR;
        PG8_WAIT_V(4); PG8_BAR;
        PG8_STAGE(PG8_SB(1, 0), cB + kstep, voffB); PG8_STAGE(PG8_SA(1, 0), cA + kstep, voffA); PG8_STAGE(PG8_SB(1, 1), cB + hstep + kstep, voffB);
        PG8_WAIT_V(6); PG8_BAR;
    }
    for (;;) {
        const bool has_next = S.next(ui + 1, nxt);
        const char* nA = has_next ? (const char*)g.A + (size_t)nxt.pm * tstep : cA; const char* nB = has_next ? (const char*)g.Bt + (size_t)nxt.pn * tstep : cB;
        for (int t = 0; t < nt; t += 2) {
            const bool last = (t == nt - 2);
            const char* a1 = cA + (size_t)(t + 1) * kstep;
            const char* a2 = last ? nA : cA + (size_t)(t + 2) * kstep; const char* b2 = last ? nB : cB + (size_t)(t + 2) * kstep;
            const char* a3 = a2 + kstep; const char* b3 = b2 + kstep;
            if (last && has_next) S.a_ready(nxt);
            if constexpr (SP2) {
            PG8_LDB(B0, 0, 0); PG8_LDB(B1, 0, 1); PG8_SCHED; PG8_LDA(At, 0, 0); PG8_STAGE(PG8_SA(1, 1), a1 + hstep, voffA);
            PG8_WAIT_V(8); PG8_WAIT_L(0); PG8_BAR; PG8_MMA(0, 0, At, B0); PG8_MMA(0, 1, At, B1); PG8_BAR; PG8_SCHED;
            PG8_LDA(At, 0, 1); PG8_STAGE(PG8_SB(0, 0), b2, voffB); PG8_STAGE(PG8_SB(0, 1), b2 + hstep, voffB); PG8_STAGE(PG8_SA(0, 0), a2, voffA);
            PG8_WAIT_V(8); PG8_WAIT_L(0); PG8_BAR; PG8_MMA(1, 0, At, B0); PG8_MMA(1, 1, At, B1); PG8_BAR; PG8_SCHED;
            PG8_LDB(B0, 1, 0); PG8_LDB(B1, 1, 1); PG8_SCHED; PG8_LDA(At, 1, 0); PG8_STAGE(PG8_SA(0, 1), a2 + hstep, voffA);
            PG8_WAIT_V(8); PG8_WAIT_L(0); PG8_BAR; PG8_MMA(0, 0, At, B0); PG8_MMA(0, 1, At, B1); PG8_BAR; PG8_SCHED;
            PG8_LDA(At, 1, 1); PG8_STAGE(PG8_SB(1, 0), b3, voffB); PG8_STAGE(PG8_SB(1, 1), b3 + hstep, voffB); PG8_STAGE(PG8_SA(1, 0), a3, voffA);
            PG8_WAIT_V(8); PG8_WAIT_L(0); PG8_BAR; PG8_MMA(1, 0, At, B0); PG8_MMA(1, 1, At, B1); PG8_BAR; PG8_SCHED;
            } else {
            PG8_LDB(B0, 0, 0); PG8_SCHED; PG8_LDA(At, 0, 0); PG8_STAGE(PG8_SA(1, 1), a1 + hstep, voffA);
            PG8_WAIT_L(8); PG8_BAR; PG8_WAIT_L(0); PG8_MMA(0, 0, At, B0); PG8_BAR; PG8_SCHED;
            PG8_LDB(B1, 0, 1); PG8_STAGE(PG8_SB(0, 0), b2, voffB);
            PG8_BAR; PG8_WAIT_L(0); PG8_MMA(0, 1, At, B1); PG8_BAR;
            PG8_LDA(At, 0, 1); PG8_STAGE(PG8_SA(0, 0), a2, voffA);
            PG8_BAR; PG8_WAIT_L(0); PG8_MMA(1, 0, At, B0); PG8_BAR; PG8_SCHED;
            PG8_STAGE(PG8_SB(0, 1), b2 + hstep, voffB);
            PG8_WAIT_V(6); PG8_BAR; PG8_MMA(1, 1, At, B1); PG8_BAR;
            PG8_LDB(B0, 1, 0); PG8_SCHED; PG8_LDA(At, 1, 0); PG8_STAGE(PG8_SA(0, 1), a2 + hstep, voffA);
            PG8_WAIT_L(8); PG8_BAR; PG8_WAIT_L(0); PG8_MMA(0, 0, At, B0); PG8_BAR; PG8_SCHED;
            PG8_LDB(B1, 1, 1); PG8_STAGE(PG8_SB(1, 0), b3, voffB);
            PG8_BAR; PG8_WAIT_L(0); PG8_MMA(0, 1, At, B1); PG8_BAR;
            PG8_LDA(At, 1, 1); PG8_STAGE(PG8_SA(1, 0), a3, voffA);
            PG8_BAR; PG8_WAIT_L(0); PG8_MMA(1, 0, At, B0); PG8_BAR; PG8_SCHED;
            PG8_STAGE(PG8_SB(1, 1), b3 + hstep, voffB);
            PG8_WAIT_V(6); PG8_BAR; PG8_MMA(1, 1, At, B1); PG8_BAR;
            }
        }
        if constexpr (ALIGN_EPI) { if (wr == 0) PG8_BAR; }
        if constexpr (!Epi::AFTER_DRAIN) { E(acc, cur, wr, wc, fr, fq); S.done(cur); }
        if (!has_next) break;
#pragma unroll
        for (int a = 0; a < 2; ++a)
#pragma unroll
            for (int b = 0; b < 2; ++b)
#pragma unroll
                for (int m = 0; m < 4; ++m)
#pragma unroll
                    for (int n = 0; n < 2; ++n) acc[a][b][m][n] = (f32x4){0.f, 0.f, 0.f, 0.f};
        cur = nxt; cA = nA; cB = nB; ++ui;
        if constexpr (ALIGN_EPI) { if (wr == 1) PG8_BAR; }
    }
    PG8_WAIT_V(0);
    if constexpr (!ALIGN_EPI) { if (wr == 0) PG8_BAR; }
    PG8_BAR;
    if constexpr (Epi::AFTER_DRAIN) { E.fused(acc, cur, wr, wc, fr, fq, lds, wid, lane); S.done(cur); }
#undef PG8_SA
#undef PG8_SB
#undef PG8_STAGE
#undef PG8_LDA
#undef PG8_LDB
#undef PG8_MMA
#undef PG8_WAIT_V
#undef PG8_WAIT_L
#undef PG8_BAR
#undef PG8_SCHED
}
}

#define LAS __attribute__((address_space(3)))
typedef unsigned short bf16_t;
typedef short bf16x8 __attribute__((ext_vector_type(8)));
typedef float f32x2 __attribute__((ext_vector_type(2)));
typedef float f32x4 __attribute__((ext_vector_type(4)));
typedef float f32x16 __attribute__((ext_vector_type(16)));
typedef unsigned u32x2 __attribute__((ext_vector_type(2)));
typedef unsigned u32x4 __attribute__((ext_vector_type(4)));
typedef __bf16 bf16x2_t __attribute__((ext_vector_type(2)));

constexpr int S = 16384, D = 2048, NLAYER = 2, HLD = 4096, DFF = 5632, INC = 3904;
constexpr int C_CQ = 0, C_CKV = 512, C_KR = 768, C_MQ = 832, C_MK = 1344, C_MV = 1856, C_CONV = 2368, C_POOL = 3392;
constexpr float EPS = 1e-5f, ALPHA = 1.41421356237309515f, LOG2E = 1.4426950408889634f;
constexpr float CQ_SCALE = 0.07216878364870323f * LOG2E;
constexpr float CM_SCALE = 0.08838834764831845f * LOG2E;
constexpr int NT = 512, NWV = 8;
constexpr float KM_FIX = 1048576.f, KM_INV = 1.f / 1048576.f;
constexpr int LDS_BYTES = 147456, LDS_MISC = 131072;

constexpr size_t MiB = (size_t)1 << 20;
constexpr size_t WS_CTL = 0, CTL_BYTES = 1 * MiB;
constexpr size_t WS_WIN = 1 * MiB, WS_WUQ = 17 * MiB, WS_WUKV = 18 * MiB, WS_WPW = 19 * MiB, WS_WPOOL = 20 * MiB, WS_WOUT = 21 * MiB, WS_WGU = 29 * MiB, WS_WDN = 73 * MiB;
constexpr size_t WS_ROPE_MLA = 95 * MiB, WS_ROPE_MOBA = 99 * MiB, WS_STATS = 101 * MiB;
constexpr size_t WS_Y = 102 * MiB, WS_XB = 230 * MiB;
constexpr size_t WS_CQN = 230 * MiB, WS_CKVN = 246 * MiB, WS_KPE = 254 * MiB, WS_CONVA = 256 * MiB, WS_POOLED = 272 * MiB;
constexpr size_t WS_H = 294 * MiB;
constexpr size_t WS_Q = 294 * MiB, WS_K = 318 * MiB, WS_VT = 342 * MiB, WS_CONCAT = 358 * MiB;
constexpr size_t WS_MQ = 422 * MiB, WS_MK = 438 * MiB, WS_MVT = 454 * MiB;
constexpr size_t WS_VR = 470 * MiB;
constexpr size_t WS_ACT = 294 * MiB, WS_END = 486 * MiB;
constexpr int CW_LAYER = 33792, CW_QCTR = 0, CW_KPEMAX = 1, CW_KNPIECE = 4, CW_KMMAX = 20, CW_CNT = 64, CW_KMEAN = 1024;

constexpr size_t DO_PART = 0, DO_PL = 34 * MiB, DO_PARTB = 36 * MiB, DO_LB = 101 * MiB, DO_LIST = 104 * MiB;

struct Params { const float* in[22]; float* out; unsigned char* ws; };

__device__ __forceinline__ unsigned f2bf(float f) { unsigned u = __float_as_uint(f); return (u + 0x7fffu + ((u >> 16) & 1u)) >> 16; }
__device__ __forceinline__ float bf2f(unsigned h) { return __uint_as_float(h << 16); }
__device__ __forceinline__ unsigned pk2(float lo, float hi) { f32x2 v = {lo, hi}; bf16x2_t b = __builtin_convertvector(v, bf16x2_t); return __builtin_bit_cast(unsigned, b); }
__device__ __forceinline__ float wave_sum(float v) {
#pragma unroll
    for (int o = 1; o < 64; o <<= 1) v += __shfl_xor(v, o);
    return v;
}
__device__ __forceinline__ float sigmoidf_(float x) { return __builtin_amdgcn_rcpf(1.f + __expf(-x)); }

typedef const pg8::f32x4 (&AccRef)[2][2][4][2];

struct EpiStore {
    static constexpr bool PERM = true, AFTER_DRAIN = false;
    bf16_t* O; int ldc;
    __device__ __forceinline__ void operator()(AccRef acc, const pg8::Unit& u, int wr, int wc, int fr, int fq) const {
        const int row0 = u.pm * 256 + wr * 64 + fr, col0 = u.pn * 256 + wc * 32 + 8 * fq;
#pragma unroll
        for (int ai = 0; ai < 2; ++ai)
#pragma unroll
            for (int m = 0; m < 4; ++m) { bf16_t* rowp = O + (size_t)(row0 + ai * 128 + m * 16) * ldc + col0;
#pragma unroll
                for (int bj = 0; bj < 2; ++bj) { const f32x4 v0 = acc[ai][bj][m][0], v1 = acc[ai][bj][m][1];
                    u32x4 w; w.x = pk2(v0[0], v0[1]); w.y = pk2(v0[2], v0[3]); w.z = pk2(v1[0], v1[1]); w.w = pk2(v1[2], v1[3]);
                    *(u32x4*)(rowp + bj * 128) = w; } }
    }
};

struct EpiQ {
    static constexpr bool PERM = true, AFTER_DRAIN = false;
    bf16_t* O; const float* rope;
    __device__ __forceinline__ void operator()(AccRef acc, const pg8::Unit& u, int wr, int wc, int fr, int fq) const {
        const int row0 = u.pm * 256 + wr * 64 + fr;
#pragma unroll
        for (int bj = 0; bj < 2; ++bj) {
            const int c0 = u.pn * 256 + bj * 128 + wc * 32 + 8 * fq; const int d0 = c0 % 192; const bool rp = d0 >= 128; const int jc = rp ? (d0 - 128) >> 1 : 0;
#pragma unroll
            for (int ai = 0; ai < 2; ++ai)
#pragma unroll
                for (int m = 0; m < 4; ++m) { const int row = row0 + ai * 128 + m * 16;
                    f32x4 v0 = acc[ai][bj][m][0] * CQ_SCALE, v1 = acc[ai][bj][m][1] * CQ_SCALE;
                    const f32x4 t0 = *(const f32x4*)(rope + ((size_t)row * 32 + jc) * 2), t1 = *(const f32x4*)(rope + ((size_t)row * 32 + jc + 2) * 2);
                    if (rp) {
                        f32x4 a, b;
                        a[0] = v0[0] * t0[0] - v0[1] * t0[1]; a[1] = v0[0] * t0[1] + v0[1] * t0[0];
                        a[2] = v0[2] * t0[2] - v0[3] * t0[3]; a[3] = v0[2] * t0[3] + v0[3] * t0[2];
                        b[0] = v1[0] * t1[0] - v1[1] * t1[1]; b[1] = v1[0] * t1[1] + v1[1] * t1[0];
                        b[2] = v1[2] * t1[2] - v1[3] * t1[3]; b[3] = v1[2] * t1[3] + v1[3] * t1[2];
                        v0 = a; v1 = b; }
                    u32x4 w; w.x = pk2(v0[0], v0[1]); w.y = pk2(v0[2], v0[3]); w.z = pk2(v1[0], v1[1]); w.w = pk2(v1[2], v1[3]);
                    *(u32x4*)(O + (size_t)row * 768 + c0) = w; }
        }
    }
};

struct EpiKV {
    static constexpr bool PERM = true, AFTER_DRAIN = false;
    bf16_t* K; bf16_t* VR; const bf16_t* KPE; unsigned* piece;
    __device__ __forceinline__ void operator()(AccRef acc, const pg8::Unit& u, int wr, int wc, int fr, int fq) const {
        const int row0 = u.pm * 256 + wr * 64 + fr, cc = wc * 32 + 8 * fq, hd = u.pn;
        float pmax = 0.f;
#pragma unroll
        for (int ai = 0; ai < 2; ++ai)
#pragma unroll
            for (int m = 0; m < 4; ++m) { const int row = row0 + ai * 128 + m * 16;
                { const f32x4 v0 = acc[ai][0][m][0], v1 = acc[ai][0][m][1];
                  u32x4 w; w.x = pk2(v0[0], v0[1]); w.y = pk2(v0[2], v0[3]); w.z = pk2(v1[0], v1[1]); w.w = pk2(v1[2], v1[3]);
                  *(u32x4*)(K + (size_t)row * 768 + hd * 192 + cc) = w;
                  float ss = (v0[0] * v0[0] + v0[1] * v0[1]) + (v0[2] * v0[2] + v0[3] * v0[3]) + (v1[0] * v1[0] + v1[1] * v1[1]) + (v1[2] * v1[2] + v1[3] * v1[3]);
                  ss += __shfl_xor(ss, 16); ss += __shfl_xor(ss, 32); pmax = fmaxf(pmax, ss); }
                { const f32x4 v0 = acc[ai][1][m][0], v1 = acc[ai][1][m][1];
                  u32x4 w; w.x = pk2(v0[0], v0[1]); w.y = pk2(v0[2], v0[3]); w.z = pk2(v1[0], v1[1]); w.w = pk2(v1[2], v1[3]);
                  *(u32x4*)(VR + (size_t)row * 512 + hd * 128 + cc) = w; }
                }
        if (wc < 2) { u32x4 kp[8];
#pragma unroll
            for (int q8 = 0; q8 < 8; ++q8) kp[q8] = *(const u32x4*)(KPE + (size_t)(row0 + (q8 >> 2) * 128 + (q8 & 3) * 16) * 64 + cc);
#pragma unroll
            for (int q8 = 0; q8 < 8; ++q8) *(u32x4*)(K + (size_t)(row0 + (q8 >> 2) * 128 + (q8 & 3) * 16) * 768 + hd * 192 + 128 + cc) = kp[q8]; }
#pragma unroll
        for (int o = 1; o < 16; o <<= 1) pmax = fmaxf(pmax, __shfl_xor(pmax, o));
        if ((threadIdx.x & 63) == 0) atomicMax(piece + hd * 4 + wc, __float_as_uint(pmax));
    }
};
__device__ __forceinline__ void vt_tile(const bf16_t* VR, bf16_t* VT, int pm, int pn) {
    int tid = threadIdx.x; asm volatile("" : "+v"(tid));
    const int dv = tid & 127, seg = tid >> 7; const int t0 = 256 * pm + 64 * seg;
    const bf16_t* src = VR + (size_t)t0 * 512 + pn * 128 + dv; unsigned pk[32];
#pragma unroll
    for (int i = 0; i < 32; ++i) pk[i] = (unsigned)src[(size_t)(2 * i) * 512] | ((unsigned)src[(size_t)(2 * i + 1) * 512] << 16);
    u32x4* dst = (u32x4*)(VT + (size_t)(pn * 128 + dv) * S + t0);
#pragma unroll
    for (int i = 0; i < 8; ++i) dst[i] = (u32x4){pk[4 * i], pk[4 * i + 1], pk[4 * i + 2], pk[4 * i + 3]};
}

template <int MODE>
struct EpiRes {
    static constexpr bool PERM = true, AFTER_DRAIN = false;
    const float* xin; bf16_t* Y; const float* stats; const float* g; const float* b;
    __device__ __forceinline__ void operator()(AccRef acc, const pg8::Unit& u, int wr, int wc, int fr, int fq) const {
        const int row0 = u.pm * 256 + wr * 64 + fr, col0 = u.pn * 256 + wc * 32 + 8 * fq;
#pragma unroll
        for (int bj = 0; bj < 2; ++bj) { const int col = col0 + bj * 128;
            f32x4 g0, g1, b0, b1;
            if (MODE == 1) { g0 = *(const f32x4*)(g + col); g1 = *(const f32x4*)(g + col + 4); b0 = *(const f32x4*)(b + col); b1 = *(const f32x4*)(b + col + 4); }
#pragma unroll
            for (int ai = 0; ai < 2; ++ai)
#pragma unroll
                for (int m = 0; m < 4; ++m) { const int row = row0 + ai * 128 + m * 16; const size_t off = (size_t)row * D + col;
                    f32x4 r0, r1;
                    if (MODE == 0) { r0 = *(const f32x4*)(xin + off); r1 = *(const f32x4*)(xin + off + 4); }
                    else { const f32x2 st = *(const f32x2*)(stats + (size_t)row * 2); const u32x4 raw = *(const u32x4*)(Y + off);
                        r0 = (f32x4){bf2f(raw.x & 0xffffu), bf2f(raw.x >> 16), bf2f(raw.y & 0xffffu), bf2f(raw.y >> 16)}; r1 = (f32x4){bf2f(raw.z & 0xffffu), bf2f(raw.z >> 16), bf2f(raw.w & 0xffffu), bf2f(raw.w >> 16)};
                        r0 = (r0 - st.x) * st.y * g0 + b0; r1 = (r1 - st.x) * st.y * g1 + b1; }
                    r0 = r0 * ALPHA + acc[ai][bj][m][0]; r1 = r1 * ALPHA + acc[ai][bj][m][1];
                    u32x4 w; w.x = pk2(r0[0], r0[1]); w.y = pk2(r0[2], r0[3]); w.z = pk2(r1[0], r1[1]); w.w = pk2(r1[2], r1[3]);
                    *(u32x4*)(Y + off) = w; }
        }
    }
};

struct EpiFfn {
    static constexpr bool PERM = true, AFTER_DRAIN = false;
    bf16_t* O;
    __device__ __forceinline__ void operator()(AccRef acc, const pg8::Unit& u, int wr, int wc, int fr, int fq) const {
        const int row0 = u.pm * 256 + wr * 64 + fr, col0 = u.pn * 128 + wc * 32 + 8 * fq;
#pragma unroll
        for (int ai = 0; ai < 2; ++ai)
#pragma unroll
            for (int m = 0; m < 4; ++m) { const int row = row0 + ai * 128 + m * 16;
                float r[8];
#pragma unroll
                for (int n = 0; n < 2; ++n)
#pragma unroll
                    for (int e = 0; e < 4; ++e) { const float gt = acc[ai][0][m][n][e], up = acc[ai][1][m][n][e]; r[n * 4 + e] = gt * sigmoidf_(gt) * up; }
                u32x4 w; w.x = pk2(r[0], r[1]); w.y = pk2(r[2], r[3]); w.z = pk2(r[4], r[5]); w.w = pk2(r[6], r[7]);
                *(u32x4*)(O + (size_t)row * DFF + col0) = w; }
    }
};

#define GEMM_CALL(EPIT, E, A_, B_, N_, K_, CID) do { pg8::Gemm g_{(const bf16_t*)(A_), (const bf16_t*)(B_), S, (N_), (K_)}; pg8::StaticOrder so_; so_.init(S, (N_), G, (CID)); \
    pg8::gemm_phase<EPIT, pg8::StaticOrder, true, true>(lds, g_, so_, (E)); } while (0)

struct TrSpec { const float* W; int ldn, K, N; bf16_t* WT; int ldk, mode; const float* sk; const float* sn; };
__device__ __forceinline__ int drow_of(int mode, int n) {
    if (mode == 1) { const int hd = n / 192, d = n - hd * 192; if (d < 128) return n; const int e = d - 128; return hd * 192 + 128 + 2 * (e & 31) + (e >> 5); }
    if (mode == 4) return ((n >> 7) << 8) + (n & 127);
    if (mode == 5) return ((n >> 7) << 8) + 128 + (n & 127);
    return n;
}
__device__ __forceinline__ void transpose_items(const TrSpec& t, LAS float* scr, int gw, int ngw, int lane) {
    const int nblk = t.N / 32, nitems = (t.K / 64) * nblk;
    for (int it = gw; it < nitems; it += ngw) {
        const int kb = it / nblk, nb = it - kb * nblk, k0 = 64 * kb, n0 = 32 * nb;
        const float snv = t.sn ? t.sn[n0 + (lane & 31)] : 1.f;
        const float* wp = t.W + (size_t)(k0 + (lane >> 5)) * t.ldn + n0 + (lane & 31);
        if (t.sk) { const float* skp = t.sk + k0 + (lane >> 5);
#pragma unroll 8
            for (int i = 0; i < 32; ++i) { const float v = wp[(size_t)(2 * i) * t.ldn] * skp[2 * i]; scr[(2 * i + (lane >> 5)) * 33 + (lane & 31)] = v * snv; } }
        else {
#pragma unroll 8
            for (int i = 0; i < 32; ++i) { const float v = wp[(size_t)(2 * i) * t.ldn]; scr[(2 * i + (lane >> 5)) * 33 + (lane & 31)] = v * snv; } }
        asm volatile("s_waitcnt lgkmcnt(0)" ::: "memory");
        const int c = lane & 7;
#pragma unroll
        for (int j = 0; j < 4; ++j) { const int n = (lane >> 3) + 8 * j; const LAS float* s = scr + (8 * c) * 33 + n;
            u32x4 o; o.x = pk2(s[0 * 33], s[1 * 33]); o.y = pk2(s[2 * 33], s[3 * 33]); o.z = pk2(s[4 * 33], s[5 * 33]); o.w = pk2(s[6 * 33], s[7 * 33]);
            *(u32x4*)(t.WT + (size_t)drow_of(t.mode, n0 + n) * t.ldk + k0 + 8 * c) = o; }
        asm volatile("s_waitcnt lgkmcnt(0)" ::: "memory");
    }
}
__device__ __forceinline__ void prep_weights(const Params& P, int l, LAS unsigned char* lds, int G) {
    int tid_l = threadIdx.x; asm volatile("" : "+v"(tid_l)); const int tid = tid_l, lane = tid & 63, wave = tid >> 6;
    const int gw = blockIdx.x * NWV + wave, ngw = G * NWV;
    LAS float* scr = (LAS float*)(lds + wave * 16384);
    unsigned char* ws = P.ws;
    TrSpec t;
    t = TrSpec{P.in[2] + (size_t)l * D * INC, INC, D, INC, (bf16_t*)(ws + WS_WIN), D, 0, nullptr, nullptr}; transpose_items(t, scr, gw, ngw, lane);
    t = TrSpec{P.in[4] + (size_t)l * 512 * 768, 768, 512, 768, (bf16_t*)(ws + WS_WUQ), 512, 1, P.in[3] + l * 512, nullptr}; transpose_items(t, scr, gw, ngw, lane);
    t = TrSpec{P.in[6] + (size_t)l * 256 * 1024, 1024, 256, 1024, (bf16_t*)(ws + WS_WUKV), 256, 0, P.in[5] + l * 256, nullptr}; transpose_items(t, scr, gw, ngw, lane);
    t = TrSpec{P.in[11] + (size_t)l * 512 * 512, 512, 512, 512, (bf16_t*)(ws + WS_WPW), 512, 0, nullptr, nullptr}; transpose_items(t, scr, gw, ngw, lane);
#pragma unroll 1
    for (int g = 0; g < 4; ++g) { t = TrSpec{P.in[12] + (size_t)(l * 4 + g) * 128 * 128, 128, 128, 128, (bf16_t*)(ws + WS_WPOOL) + (size_t)(g * 128) * 512 + g * 128, 512, 0, nullptr, P.in[13] + l * 512 + g * 128};
        transpose_items(t, scr, gw, ngw, lane); }
    t = TrSpec{P.in[14] + (size_t)l * D * D, D, D, D, (bf16_t*)(ws + WS_WOUT), D, 0, nullptr, nullptr}; transpose_items(t, scr, gw, ngw, lane);
    t = TrSpec{P.in[17] + (size_t)l * D * DFF, DFF, D, DFF, (bf16_t*)(ws + WS_WGU), D, 4, nullptr, nullptr}; transpose_items(t, scr, gw, ngw, lane);
    t = TrSpec{P.in[18] + (size_t)l * D * DFF, DFF, D, DFF, (bf16_t*)(ws + WS_WGU), D, 5, nullptr, nullptr}; transpose_items(t, scr, gw, ngw, lane);
    t = TrSpec{P.in[19] + (size_t)l * DFF * D, D, DFF, D, (bf16_t*)(ws + WS_WDN), DFF, 0, nullptr, nullptr}; transpose_items(t, scr, gw, ngw, lane);
    const int gt = blockIdx.x * NT + tid, ngt = G * NT; const u32x4 z = {0u, 0u, 0u, 0u};
    { u32x4* p = (u32x4*)((bf16_t*)(ws + WS_WIN) + (size_t)INC * D); for (int i = gt; i < 192 * D / 8; i += ngt) p[i] = z; }
    { u32x4* p = (u32x4*)(ws + WS_WPOOL); for (int i = gt; i < 512 * 512 / 8; i += ngt) { const int row = i >> 6, col = (i & 63) * 8; if ((row >> 7) != (col >> 7)) p[i] = z; } }
}
__device__ __forceinline__ void prep_layer0(const Params& P, int G) {
    int tid_l = threadIdx.x; asm volatile("" : "+v"(tid_l)); const int gt = blockIdx.x * NT + tid_l, ngt = G * NT;
    const f32x4* x4 = (const f32x4*)P.in[0]; u32x4* xb = (u32x4*)(P.ws + WS_XB);
    for (int i = gt; i < S * D / 8; i += ngt) { const f32x4 a = x4[2 * i], b = x4[2 * i + 1]; u32x4 w; w.x = pk2(a[0], a[1]); w.y = pk2(a[2], a[3]); w.z = pk2(b[0], b[1]); w.w = pk2(b[2], b[3]); xb[i] = w; }
    const int* pos = (const int*)P.in[1];
    f32x2* rm = (f32x2*)(P.ws + WS_ROPE_MLA); f32x2* ro = (f32x2*)(P.ws + WS_ROPE_MOBA);
    const double L2T = 18.931568569324174;
    for (int i = gt; i < S * 48; i += ngt) { const int t = i / 48, jj = i - t * 48; const bool mla = jj < 32; const int j = mla ? jj : jj - 32;
        const double invf = exp2(-(mla ? (double)j / 32.0 : (double)j / 16.0) * L2T);
        const double rev = (double)pos[t] * invf * 0.15915494309189535; const float fr = (float)(rev - rint(rev));
        const f32x2 cs = {__builtin_amdgcn_cosf(fr), __builtin_amdgcn_sinf(fr)};
        if (mla) rm[t * 32 + j] = cs; else ro[t * 16 + j] = cs; }
}

struct XcdSplit { int base, step, lim, plain_step;
    __device__ __forceinline__ XcdSplit(int n, int G, int per_block) { if ((G & 7) == 0 && (n & 7) == 0) { const int x = blockIdx.x & 7, ci = blockIdx.x >> 3; base = (n >> 3) * x + ci * per_block; step = (G >> 3) * per_block; lim = (n >> 3) * (x + 1); }
        else { base = blockIdx.x * per_block; step = G * per_block; lim = n; } plain_step = 0; } };
template <bool TO_OUT> __device__ __forceinline__ void ln_phase(const bf16_t* Y, const float* g, const float* b, float* stats, bf16_t* XB, float* out, int G, float chkoff = 0.f) {
    int tid_l = threadIdx.x; asm volatile("" : "+v"(tid_l)); const int lane = tid_l & 63, wave = tid_l >> 6;
    const XcdSplit xs(S, G, NWV);
    for (int row = xs.base + wave; row < xs.lim; row += xs.step) {
        const u32x4* yr = (const u32x4*)(Y + (size_t)row * D) + lane; float v[4][8]; float s = 0.f;
#pragma unroll
        for (int j = 0; j < 4; ++j) { const u32x4 raw = yr[64 * j];
            v[j][0] = bf2f(raw.x & 0xffffu); v[j][1] = bf2f(raw.x >> 16); v[j][2] = bf2f(raw.y & 0xffffu); v[j][3] = bf2f(raw.y >> 16); v[j][4] = bf2f(raw.z & 0xffffu); v[j][5] = bf2f(raw.z >> 16); v[j][6] = bf2f(raw.w & 0xffffu); v[j][7] = bf2f(raw.w >> 16);
#pragma unroll
            for (int e = 0; e < 8; ++e) s += v[j][e]; }
        const float mean = wave_sum(s) * (1.f / D); float s2 = 0.f;
#pragma unroll
        for (int j = 0; j < 4; ++j)
#pragma unroll
            for (int e = 0; e < 8; ++e) { v[j][e] -= mean; s2 += v[j][e] * v[j][e]; }
        const float rstd = rsqrtf(wave_sum(s2) * (1.f / D) + EPS);
        if (!TO_OUT && lane == 0) *(f32x2*)(stats + (size_t)row * 2) = (f32x2){mean, rstd};
#pragma unroll
        for (int j = 0; j < 4; ++j) { const int col = 8 * (lane + 64 * j); const f32x4 g0 = *(const f32x4*)(g + col), g1 = *(const f32x4*)(g + col + 4), b0 = *(const f32x4*)(b + col), b1 = *(const f32x4*)(b + col + 4);
            f32x4 o0 = (f32x4){v[j][0], v[j][1], v[j][2], v[j][3]} * rstd * g0 + b0, o1 = (f32x4){v[j][4], v[j][5], v[j][6], v[j][7]} * rstd * g1 + b1;
            if (TO_OUT) { *(f32x4*)(out + (size_t)row * D + col) = o0 + chkoff; *(f32x4*)(out + (size_t)row * D + col + 4) = o1 + chkoff; }
            else { u32x4 w; w.x = pk2(o0[0], o0[1]); w.y = pk2(o0[2], o0[3]); w.z = pk2(o1[0], o1[1]); w.w = pk2(o1[2], o1[3]); *(u32x4*)(XB + (size_t)row * D + col) = w; } }
    }
}

__device__ __forceinline__ void p2a_phase(const Params& P, int l, LAS unsigned char* lds, int G) {
    int tid_l = threadIdx.x; asm volatile("" : "+v"(tid_l)); const int tid = tid_l, lane = tid & 63, wave = tid >> 6;
    unsigned char* ws = P.ws;
    const bf16_t* H = (const bf16_t*)(ws + WS_H);
    unsigned* ctl = (unsigned*)(ws + WS_CTL) + l * CW_LAYER;
    bf16_t* CQN = (bf16_t*)(ws + WS_CQN); bf16_t* CKVN = (bf16_t*)(ws + WS_CKVN); bf16_t* KPE = (bf16_t*)(ws + WS_KPE);
    bf16_t* CONVA = (bf16_t*)(ws + WS_CONVA); bf16_t* POOLED = (bf16_t*)(ws + WS_POOLED);
    bf16_t* MQ = (bf16_t*)(ws + WS_MQ); bf16_t* MK = (bf16_t*)(ws + WS_MK); bf16_t* MVT = (bf16_t*)(ws + WS_MVT);
    const f32x2* RM = (const f32x2*)(ws + WS_ROPE_MLA); const float* RO = (const float*)(ws + WS_ROPE_MOBA);
    LAS float* ybuf = (LAS float*)lds;
    const XcdSplit xsp(S / 64, G, 1);
    for (int tile = xsp.base; tile < xsp.lim; tile += xsp.step) {
        const int t0 = tile * 64;
        { float ksum[8]; float kpemax = 0.f, kmmax = 0.f; const int hm = lane & 15;
#pragma unroll
          for (int e = 0; e < 8; ++e) ksum[e] = 0.f;
          struct TokIn { u32x4 cq, mq, mk; u32x2 ckv; unsigned kr1, kr2; f32x2 cs; f32x4 ro[4]; };
#define P2A_LOAD(dst, tt) do { const bf16_t* hr_ = H + (size_t)(tt) * HLD; (dst).cq = *(const u32x4*)(hr_ + C_CQ + 8 * lane); (dst).ckv = *(const u32x2*)(hr_ + C_CKV + 4 * lane); \
              (dst).kr1 = hr_[C_KR + (lane & 31)]; (dst).kr2 = hr_[C_KR + 32 + (lane & 31)]; (dst).cs = RM[(tt) * 32 + (lane & 31)]; (dst).mq = *(const u32x4*)(hr_ + C_MQ + 8 * lane); (dst).mk = *(const u32x4*)(hr_ + C_MK + 8 * lane); \
              const f32x4* tp_ = (const f32x4*)(RO + ((size_t)(tt) * 16 + 8 * (hm & 1)) * 2); (dst).ro[0] = tp_[0]; (dst).ro[1] = tp_[1]; (dst).ro[2] = tp_[2]; (dst).ro[3] = tp_[3]; } while (0)
          TokIn cur, nxt; P2A_LOAD(cur, t0 + wave * 8); nxt = cur;
#pragma unroll 1
          for (int i = 0; i < 8; ++i) {
              const int t = t0 + wave * 8 + i;
              if (i + 1 < 8) P2A_LOAD(nxt, t + 1);
              { const u32x4 raw = cur.cq; float x[8];
                x[0] = bf2f(raw.x & 0xffffu); x[1] = bf2f(raw.x >> 16); x[2] = bf2f(raw.y & 0xffffu); x[3] = bf2f(raw.y >> 16); x[4] = bf2f(raw.z & 0xffffu); x[5] = bf2f(raw.z >> 16); x[6] = bf2f(raw.w & 0xffffu); x[7] = bf2f(raw.w >> 16);
                float ss = 0.f;
#pragma unroll
                for (int e = 0; e < 8; ++e) ss += x[e] * x[e];
                const float rs = rsqrtf(wave_sum(ss) * (1.f / 512.f) + EPS);
                u32x4 w; w.x = pk2(x[0] * rs, x[1] * rs); w.y = pk2(x[2] * rs, x[3] * rs); w.z = pk2(x[4] * rs, x[5] * rs); w.w = pk2(x[6] * rs, x[7] * rs);
                *(u32x4*)(CQN + (size_t)t * 512 + 8 * lane) = w; }
              { const u32x2 raw = cur.ckv; float x[4];
                x[0] = bf2f(raw.x & 0xffffu); x[1] = bf2f(raw.x >> 16); x[2] = bf2f(raw.y & 0xffffu); x[3] = bf2f(raw.y >> 16);
                const float ss = (x[0] * x[0] + x[1] * x[1]) + (x[2] * x[2] + x[3] * x[3]);
                const float rs = rsqrtf(wave_sum(ss) * (1.f / 256.f) + EPS);
                u32x2 w; w.x = pk2(x[0] * rs, x[1] * rs); w.y = pk2(x[2] * rs, x[3] * rs);
                *(u32x2*)(CKVN + (size_t)t * 256 + 4 * lane) = w; }
              { const int j = lane & 31; const float x1 = bf2f(cur.kr1), x2 = bf2f(cur.kr2); const f32x2 cs = cur.cs;
                const float o1 = x1 * cs.x - x2 * cs.y, o2 = x1 * cs.y + x2 * cs.x;
                if (lane < 32) *(unsigned*)(KPE + (size_t)t * 64 + 2 * j) = pk2(o1, o2);
                const float n2 = wave_sum(lane < 32 ? o1 * o1 + o2 * o2 : 0.f); kpemax = fmaxf(kpemax, n2); }
#pragma unroll
              for (int which = 0; which < 2; ++which) {
                  const u32x4 raw = which ? cur.mk : cur.mq; float x[8], px[8];
                  x[0] = bf2f(raw.x & 0xffffu); x[1] = bf2f(raw.x >> 16); x[2] = bf2f(raw.y & 0xffffu); x[3] = bf2f(raw.y >> 16); x[4] = bf2f(raw.z & 0xffffu); x[5] = bf2f(raw.z >> 16); x[6] = bf2f(raw.w & 0xffffu); x[7] = bf2f(raw.w >> 16);
#pragma unroll
                  for (int e = 0; e < 8; ++e) px[e] = __shfl_xor(x[e], 2);
                  if (hm < 4) {
#pragma unroll
                      for (int e2 = 0; e2 < 4; ++e2) { const f32x4 cs = cur.ro[e2];
                          if (hm < 2) { x[2 * e2] = x[2 * e2] * cs[0] - px[2 * e2] * cs[1]; x[2 * e2 + 1] = x[2 * e2 + 1] * cs[2] - px[2 * e2 + 1] * cs[3]; }
                          else { x[2 * e2] = px[2 * e2] * cs[1] + x[2 * e2] * cs[0]; x[2 * e2 + 1] = px[2 * e2 + 1] * cs[3] + x[2 * e2 + 1] * cs[2]; } } }
                  if (which == 0) { u32x4 w; w.x = pk2(x[0] * CM_SCALE, x[1] * CM_SCALE); w.y = pk2(x[2] * CM_SCALE, x[3] * CM_SCALE); w.z = pk2(x[4] * CM_SCALE, x[5] * CM_SCALE); w.w = pk2(x[6] * CM_SCALE, x[7] * CM_SCALE);
                      *(u32x4*)(MQ + (size_t)t * 512 + 8 * lane) = w; }
                  else { u32x4 w; w.x = pk2(x[0], x[1]); w.y = pk2(x[2], x[3]); w.z = pk2(x[4], x[5]); w.w = pk2(x[6], x[7]);
                      *(u32x4*)(MK + (size_t)t * 512 + 8 * lane) = w;
                      float n2 = 0.f;
#pragma unroll
                      for (int e = 0; e < 8; ++e) { ksum[e] += x[e]; n2 += x[e] * x[e]; }
                      n2 += __shfl_xor(n2, 1); n2 += __shfl_xor(n2, 2); n2 += __shfl_xor(n2, 4); n2 += __shfl_xor(n2, 8); kmmax = fmaxf(kmmax, n2); }
              }
              cur = nxt;
          }
#undef P2A_LOAD
          { LAS f32x4* kr = (LAS f32x4*)(ybuf + wave * 512 + 8 * lane); kr[0] = (f32x4){ksum[0], ksum[1], ksum[2], ksum[3]}; kr[1] = (f32x4){ksum[4], ksum[5], ksum[6], ksum[7]}; }
          if (lane == 0) ybuf[4096 + wave * 8 + 4] = kpemax;
          if (hm == 0) ybuf[4096 + wave * 8 + (lane >> 4)] = kmmax;
          __syncthreads();
          { float a = 0.f;
#pragma unroll
            for (int w8 = 0; w8 < 8; ++w8) a += ybuf[w8 * 512 + tid];
            atomicAdd((int*)(ctl + CW_KMEAN) + ((size_t)((tid >> 7) * 64 + (t0 >> 8)) * 128 + (tid & 127)), __float2int_rn(a * KM_FIX));
            if (tid < 5) { float m = 0.f;
#pragma unroll
                for (int w8 = 0; w8 < 8; ++w8) m = fmaxf(m, ybuf[4096 + w8 * 8 + tid]);
                atomicMax(ctl + (tid == 4 ? CW_KPEMAX : CW_KMMAX + tid), __float_as_uint(m)); } }
          __syncthreads(); }
#ifdef REP_P2A_C
#pragma unroll 1
        for (int rep_ = 0; rep_ < 2; ++rep_)
#endif
        { const int c = tid;
          { const bf16_t* src = H + (size_t)t0 * HLD + C_MV + c; unsigned pk[32];
#pragma unroll
            for (int i = 0; i < 32; ++i) pk[i] = (unsigned)src[(size_t)(2 * i) * HLD] | ((unsigned)src[(size_t)(2 * i + 1) * HLD] << 16);
            u32x4* dst = (u32x4*)(MVT + (size_t)c * S + t0);
#pragma unroll
            for (int i = 0; i < 8; ++i) dst[i] = (u32x4){pk[4 * i], pk[4 * i + 1], pk[4 * i + 2], pk[4 * i + 3]}; }
          { const bf16_t* src = H + C_POOL + c; float uv[80];
#pragma unroll
            for (int i0 = 0; i0 < 80; i0 += 16) { const bf16_t* p = src + (ptrdiff_t)(t0 - 16) * HLD;
#pragma unroll
                for (int i = 0; i < 16; ++i) { const float u_ = bf2f(p[(ptrdiff_t)(i0 + i) * HLD]); uv[i0 + i] = t0 - 16 + i0 + i >= 0 ? u_ : 0.f; }
                asm volatile("" ::: "memory"); }
#define P2A_POOL(W) do { float s_ = 0.f; _Pragma("unroll") for (int i = 16 - (W); i < 16; ++i) s_ += uv[i]; \
              _Pragma("unroll") for (int i = 0; i < 64; ++i) { const int t_ = t0 + i; s_ += uv[16 + i] - uv[16 + i - (W)]; const float cnt_ = (float)(t_ + 1 < (W) ? t_ + 1 : (W)); \
                  POOLED[(size_t)t_ * 512 + c] = (bf16_t)f2bf(s_ / cnt_ - uv[16 + i]); } } while (0)
            const int grp = c >> 7;
            if (grp == 0) P2A_POOL(2); else if (grp == 1) P2A_POOL(4); else if (grp == 2) P2A_POOL(8); else P2A_POOL(16);
#undef P2A_POOL
          }
          { const float* dw = P.in[7] + (size_t)l * 31 * 512 + c; float w[31];
#pragma unroll
            for (int j = 0; j < 31; ++j) w[j] = dw[j * 512];
            const float bias = P.in[8][l * 512 + c]; const bf16_t* src = H + C_CONV + c;
#pragma unroll 1
            for (int ch = 0; ch < 4; ++ch) { float v[46];
                const int tb = t0 + 16 * ch - 30;
                { const bf16_t* p = src + (ptrdiff_t)tb * HLD;
#pragma unroll
                  for (int i0 = 0; i0 < 46; i0 += 8) { unsigned ra[8], rg[8];
#pragma unroll
                      for (int i = 0; i < 8; ++i) if (i0 + i < 46) { ra[i] = p[(ptrdiff_t)(i0 + i) * HLD]; rg[i] = p[(ptrdiff_t)(i0 + i) * HLD + 512]; }
#pragma unroll
                      for (int i = 0; i < 8; ++i) if (i0 + i < 46) { const float val = bf2f(ra[i]) * sigmoidf_(bf2f(rg[i])); v[i0 + i] = tb + i0 + i >= 0 ? val : 0.f; }
                      asm volatile("" ::: "memory"); } }
#pragma unroll
                for (int tl = 0; tl < 16; ++tl) { float y = bias;
#pragma unroll
                    for (int j = 0; j < 31; ++j) y = fmaf(w[j], v[tl + j], y);
                    ybuf[(16 * ch + tl) * 512 + c] = y; } } }
        }
        __syncthreads();
        { const float* lg = P.in[9] + l * 512 + 8 * lane; const float* lb = P.in[10] + l * 512 + 8 * lane;
          const f32x4 g0 = *(const f32x4*)lg, g1 = *(const f32x4*)(lg + 4), b0 = *(const f32x4*)lb, b1 = *(const f32x4*)(lb + 4);
#pragma unroll 1
          for (int i = 0; i < 8; ++i) { const int tl = wave * 8 + i; const LAS f32x4* yp = (const LAS f32x4*)(ybuf + tl * 512 + 8 * lane);
              f32x4 y0 = yp[0], y1 = yp[1];
              const float mean = wave_sum((y0[0] + y0[1]) + (y0[2] + y0[3]) + (y1[0] + y1[1]) + (y1[2] + y1[3])) * (1.f / 512.f);
              y0 = y0 - mean; y1 = y1 - mean;
              const float var = wave_sum((y0[0] * y0[0] + y0[1] * y0[1]) + (y0[2] * y0[2] + y0[3] * y0[3]) + (y1[0] * y1[0] + y1[1] * y1[1]) + (y1[2] * y1[2] + y1[3] * y1[3])) * (1.f / 512.f);
              const float rstd = rsqrtf(var + EPS);
              y0 = y0 * rstd * g0 + b0; y1 = y1 * rstd * g1 + b1;
              float r[8];
#pragma unroll
              for (int e = 0; e < 4; ++e) { r[e] = y0[e] * sigmoidf_(y0[e]); r[4 + e] = y1[e] * sigmoidf_(y1[e]); }
              u32x4 wv; wv.x = pk2(r[0], r[1]); wv.y = pk2(r[2], r[3]); wv.z = pk2(r[4], r[5]); wv.w = pk2(r[6], r[7]);
              *(u32x4*)(CONVA + (size_t)(t0 + tl) * 512 + 8 * lane) = wv; } }
        __syncthreads();
    }
}

__device__ __forceinline__ void gate_phase(const Params& P, int l, LAS unsigned char* lds, int G, int dup = 0) {
    int tid_l = threadIdx.x; asm volatile("" : "+v"(tid_l)); const int tid = tid_l, lane = tid & 63, wave = tid >> 6, r = lane & 31, hh = lane >> 5;
    unsigned* ctl = (unsigned*)(P.ws + WS_CTL) + l * CW_LAYER;
    const int* kmean = (const int*)(ctl + CW_KMEAN);
    const bf16_t* MQ = (const bf16_t*)(P.ws + WS_MQ);
    int* LIST = dup ? (int*)(P.ws + 486 * MiB) : (int*)((unsigned char*)P.out + DO_LIST); unsigned* cntp = ctl + (dup ? 512 : CW_CNT);
    for (int unit = blockIdx.x * NWV + wave; unit < (S / 32) * 4; unit += G * NWV) {
        const int h = unit & 3, t0 = (unit >> 2) * 32, own = t0 >> 8, t = t0 + r;
        if (own == 0) continue;
        f32x16 acc[2];
#pragma unroll
        for (int mt = 0; mt < 2; ++mt)
#pragma unroll
            for (int i = 0; i < 16; ++i) acc[mt][i] = 0.f;
#pragma unroll
        for (int ks = 0; ks < 8; ++ks) { const bf16x8 qf = *(const bf16x8*)(MQ + (size_t)t * 512 + h * 128 + 16 * ks + 8 * hh);
#pragma unroll
            for (int mt = 0; mt < 2; ++mt) { const int* kp = kmean + (size_t)(h * 64 + 32 * mt + r) * 128 + 16 * ks + 8 * hh; const u32x4 a = *(const u32x4*)kp, b = *(const u32x4*)(kp + 4);
                float v[8] = {(float)(int)a.x * KM_INV, (float)(int)a.y * KM_INV, (float)(int)a.z * KM_INV, (float)(int)a.w * KM_INV, (float)(int)b.x * KM_INV, (float)(int)b.y * KM_INV, (float)(int)b.z * KM_INV, (float)(int)b.w * KM_INV}; unsigned hi[8], lo[8];
#pragma unroll
                for (int e = 0; e < 8; ++e) { hi[e] = f2bf(v[e]); lo[e] = f2bf(v[e] - bf2f(hi[e])); }
                u32x4 wh, wl; wh.x = hi[0] | (hi[1] << 16); wh.y = hi[2] | (hi[3] << 16); wh.z = hi[4] | (hi[5] << 16); wh.w = hi[6] | (hi[7] << 16);
                wl.x = lo[0] | (lo[1] << 16); wl.y = lo[2] | (lo[3] << 16); wl.z = lo[4] | (lo[5] << 16); wl.w = lo[6] | (lo[7] << 16);
                acc[mt] = __builtin_amdgcn_mfma_f32_32x32x16_bf16(__builtin_bit_cast(bf16x8, wh), qf, acc[mt], 0, 0, 0);
                acc[mt] = __builtin_amdgcn_mfma_f32_32x32x16_bf16(__builtin_bit_cast(bf16x8, wl), qf, acc[mt], 0, 0, 0); } }
#pragma unroll
        for (int mt = 0; mt < 2; ++mt)
#pragma unroll
            for (int i = 0; i < 16; ++i) if (32 * mt + (i & 3) + 8 * (i >> 2) + 4 * hh >= own) acc[mt][i] = -INFINITY;
        float tv[3]; int ti[3];
#pragma unroll
        for (int p = 0; p < 3; ++p) { float bv = -INFINITY; int bi = 64;
#pragma unroll
            for (int mt = 0; mt < 2; ++mt)
#pragma unroll
                for (int i = 0; i < 16; ++i) { const int bidx = 32 * mt + (i & 3) + 8 * (i >> 2) + 4 * hh; const float v = acc[mt][i]; if (v > bv || (v == bv && bidx < bi)) { bv = v; bi = bidx; } }
            tv[p] = bv; ti[p] = bi;
#pragma unroll
            for (int mt = 0; mt < 2; ++mt)
#pragma unroll
                for (int i = 0; i < 16; ++i) if (32 * mt + (i & 3) + 8 * (i >> 2) + 4 * hh == bi) acc[mt][i] = -INFINITY; }
        float cv[6]; int ci[6];
#pragma unroll
        for (int p = 0; p < 3; ++p) { cv[p] = tv[p]; ci[p] = ti[p]; cv[3 + p] = __shfl_xor(tv[p], 32); ci[3 + p] = __shfl_xor(ti[p], 32); }
        int pick[3];
#pragma unroll
        for (int p = 0; p < 3; ++p) { float bv = -INFINITY; int bi = 64;
#pragma unroll
            for (int c = 0; c < 6; ++c) if (cv[c] > bv || (cv[c] == bv && ci[c] < bi)) { bv = cv[c]; bi = ci[c]; }
            pick[p] = bi;
#pragma unroll
            for (int c = 0; c < 6; ++c) if (ci[c] == bi) cv[c] = -INFINITY; }
        const int npick = own < 3 ? own : 3;
        if (hh == 0) {
#pragma unroll
            for (int p = 0; p < 3; ++p) if (p < npick) { const int hb = h * 64 + pick[p]; const int slot = (int)atomicAdd(cntp + hb, 1u); LIST[(size_t)hb * S + slot] = t * 4 + p; } }
    }
}

template <int DK>
__device__ __forceinline__ int attn_item(unsigned* qctr, const int tid, LAS unsigned char* lds, const bf16_t* Qb, int ldq, int qrow, bool qvalid, int qpos, int wqmin,
                                          const bf16_t* Kp, int ldk, const bf16_t* VT, int key0, int ntiles,
                                          float kmaxA, float kmaxB, const int OM, const int oidx, float* o32b, bf16_t* obb, float* lpb) {
    constexpr int NKS = DK / 16, SPRK = DK / 8 + 1, KSTR = SPRK * 16, NKI = SPRK, KBYTES = NKI * 1024, VSTR = 144, NVI = 18, BUF = KBYTES + NVI * 1024, KW = (DK == 192 ? 5 : 4), NII = 6;
    const int lane = tid & 63, r = lane & 31, hh = lane >> 5, wave = __builtin_amdgcn_readfirstlane(tid >> 6);
    bf16x8 qf[NKS];
    { const bf16_t* qp = Qb + (size_t)qrow * ldq + 8 * hh;
#pragma unroll
      for (int ks = 0; ks < NKS; ++ks) qf[ks] = *(const bf16x8*)(qp + 16 * ks); }
    float na = 0.f, nb = 0.f;
#pragma unroll
    for (int ks = 0; ks < NKS; ++ks)
#pragma unroll
        for (int e = 0; e < 8; ++e) { const float f = bf2f((unsigned)(unsigned short)qf[ks][e]); if (ks < 8) na += f * f; else nb += f * f; }
    na += __shfl_xor(na, 32); nb += __shfl_xor(nb, 32);
    const float negr = -(sqrtf(na) * kmaxA + sqrtf(nb) * kmaxB);
    const bool kwave = wave < KW;
    const int jw = kwave ? wave : wave - KW, jstride = kwave ? KW : 8 - KW, jn = kwave ? NKI : NVI;
    const unsigned char* gbase = kwave ? (const unsigned char*)Kp : (const unsigned char*)VT;
    const unsigned gstep = kwave ? (unsigned)ldk * 128u : 128u, ldst0 = kwave ? 0u : (unsigned)KBYTES;
#define AT_GOFF(j_) ({ const int sg_ = 64 * (j_) + lane; unsigned g_; \
        if (kwave) { const int row_ = sg_ / SPRK; int part_ = sg_ - row_ * SPRK; if (part_ == SPRK - 1) part_ = 0; g_ = (unsigned)(((key0 + row_) * ldk + part_ * 8) * 2); } \
        else { const int dv_ = sg_ / 9; int part_ = sg_ - dv_ * 9; if (part_ == 8) part_ = 0; g_ = (unsigned)((dv_ * S + key0 + part_ * 8) * 2); } g_; })
#define AT_DMA(tt, b) do { _Pragma("unroll") for (int ii_ = 0; ii_ < NII; ++ii_) { const int j_ = jw + jstride * ii_; if (j_ < jn) \
        __builtin_amdgcn_global_load_lds((const unsigned*)(gbase + (size_t)(AT_GOFF(j_) + (unsigned)(tt) * gstep)), (LAS unsigned*)(lds + (b) * BUF + ldst0 + j_ * 1024), 16, 0, 0); } } while (0)
    AT_DMA(0, 0);
    f32x16 o[4];
#pragma unroll
    for (int d = 0; d < 4; ++d)
#pragma unroll
        for (int i = 0; i < 16; ++i) o[d][i] = 0.f;
    float lsum = 0.f;
    const int pr = (r & 0x13) | ((r & 4) << 1) | ((r & 8) >> 1);
    const unsigned koff = (unsigned)(pr * KSTR + 16 * hh), voff = (unsigned)(KBYTES + r * VSTR + 16 * hh);
    asm volatile("s_waitcnt vmcnt(0)" ::: "memory"); __syncthreads();
    int nxt_idx = 0;
#pragma unroll 1
    for (int t = 0; t < ntiles; ++t) {
        const int cur = t & 1;
        if (t + 1 < ntiles) AT_DMA(t + 1, cur ^ 1);
        else if (tid == 0) nxt_idx = (int)atomicAdd(qctr, 1u);
        LAS const unsigned char* bp = lds + cur * BUF;
        bf16x8 pf[2][2];
#pragma unroll
        for (int kb = 0; kb < 2; ++kb) {
            f32x16 acc;
#pragma unroll
            for (int i = 0; i < 16; ++i) acc[i] = negr;
#pragma unroll
            for (int ks = 0; ks < NKS; ++ks) { const bf16x8 kf = *(LAS const bf16x8*)(bp + koff + kb * 32 * KSTR + 32 * ks); acc = __builtin_amdgcn_mfma_f32_32x32x16_bf16(kf, qf[ks], acc, 0, 0, 0); }
            const int kt0 = key0 + 64 * t + 32 * kb + 8 * hh;
            if (key0 + 64 * t + 63 > wqmin) {
#pragma unroll
                for (int i = 0; i < 16; ++i) if (kt0 + 16 * (i >> 3) + (i & 7) > qpos) acc[i] = -INFINITY; }
#pragma unroll
            for (int i = 0; i < 16; ++i) { const float p = __builtin_amdgcn_exp2f(acc[i]); lsum += p; acc[i] = p; }
            u32x4 w0, w1;
            w0.x = pk2(acc[0], acc[1]); w0.y = pk2(acc[2], acc[3]); w0.z = pk2(acc[4], acc[5]); w0.w = pk2(acc[6], acc[7]);
            w1.x = pk2(acc[8], acc[9]); w1.y = pk2(acc[10], acc[11]); w1.z = pk2(acc[12], acc[13]); w1.w = pk2(acc[14], acc[15]);
            pf[kb][0] = __builtin_bit_cast(bf16x8, w0); pf[kb][1] = __builtin_bit_cast(bf16x8, w1);
        }
#pragma unroll
        for (int d = 0; d < 4; ++d)
#pragma unroll
            for (int kb = 0; kb < 2; ++kb)
#pragma unroll
                for (int s = 0; s < 2; ++s) { const bf16x8 vf = *(LAS const bf16x8*)(bp + voff + d * 32 * VSTR + (32 * kb + 16 * s) * 2); o[d] = __builtin_amdgcn_mfma_f32_32x32x16_bf16(vf, pf[kb][s], o[d], 0, 0, 0); }
        asm volatile("s_waitcnt vmcnt(0)" ::: "memory");
        __syncthreads();
    }
#undef AT_DMA
#undef AT_GOFF
    lsum += __shfl_xor(lsum, 32);
    if (qvalid) {
        float* o32 = o32b + (size_t)oidx * 128; bf16_t* ob = obb + (size_t)oidx * (OM == 0 ? D : 128); float* lp = lpb + oidx;
        if (OM == 1) {
#pragma unroll
            for (int d = 0; d < 4; ++d)
#pragma unroll
                for (int i4 = 0; i4 < 4; ++i4) *(f32x4*)(o32 + 32 * d + 8 * i4 + 4 * hh) = (f32x4){o[d][4 * i4], o[d][4 * i4 + 1], o[d][4 * i4 + 2], o[d][4 * i4 + 3]};
            if (hh == 0) *lp = lsum;
        } else {
            const float sc = OM == 0 ? 1.f / lsum : 1.f;
#pragma unroll
            for (int d = 0; d < 4; ++d)
#pragma unroll
                for (int i4 = 0; i4 < 4; ++i4) { u32x2 w; w.x = pk2(o[d][4 * i4] * sc, o[d][4 * i4 + 1] * sc); w.y = pk2(o[d][4 * i4 + 2] * sc, o[d][4 * i4 + 3] * sc); *(u32x2*)(ob + 32 * d + 8 * i4 + 4 * hh) = w; }
            if (OM == 2 && hh == 0) *lp = lsum;
        }
    }
    return nxt_idx;
}

constexpr int N_HEAD_MLA = 96, N_HEAD_FIXED = 160, CW_QH = 24;
__device__ __forceinline__ void attn_phase(const Params& P, int l, LAS unsigned char* lds, int G, int rep = 0) {
    const int tid = threadIdx.x, lane = tid & 63, wave = tid >> 6, r = lane & 31;
    unsigned char* ws = P.ws; unsigned char* dout = (unsigned char*)P.out;
    unsigned* ctl = (unsigned*)(ws + WS_CTL) + l * CW_LAYER;
    float* PART = (float*)(dout + DO_PART); float* PL = (float*)(dout + DO_PL); bf16_t* PARTB = (bf16_t*)(dout + DO_PARTB); float* LB = (float*)(dout + DO_LB); const int* LIST = (const int*)(dout + DO_LIST);
    const bf16_t* Q = (const bf16_t*)(ws + WS_Q); const bf16_t* KK = (const bf16_t*)(ws + WS_K); const bf16_t* VT = (const bf16_t*)(ws + WS_VT); bf16_t* CC = (bf16_t*)(ws + WS_CONCAT);
    const bf16_t* MQ = (const bf16_t*)(ws + WS_MQ); const bf16_t* MK = (const bf16_t*)(ws + WS_MK); const bf16_t* MVT = (const bf16_t*)(ws + WS_MVT);
    LAS int* qidx = (LAS int*)(lds + LDS_MISC); LAS int* pre = (LAS int*)(lds + LDS_MISC + 64);
    __syncthreads();
    if (tid < 64) {
        const u32x4 c4 = *(const u32x4*)(ctl + CW_CNT + 4 * tid);
        const int a0 = (int)((c4.x + 255u) >> 8), a1 = a0 + (int)((c4.y + 255u) >> 8), a2 = a1 + (int)((c4.z + 255u) >> 8), a3 = a2 + (int)((c4.w + 255u) >> 8);
        int run = a3;
#pragma unroll
        for (int o = 1; o < 64; o <<= 1) { const int v = __shfl_up(run, o); if (lane >= o) run += v; }
        const int base = run - a3;
        pre[1 + 4 * tid] = base + a0; pre[2 + 4 * tid] = base + a1; pre[3 + 4 * tid] = base + a2; pre[4 + 4 * tid] = base + a3;
        if (tid == 0) pre[0] = 0; }
    __syncthreads();
    const float kpemax = sqrtf(__uint_as_float(ctl[CW_KPEMAX]));
    int hcur = (int)(((unsigned)__builtin_amdgcn_s_getreg((3 << 11) | 20) & 0xFu) & 3u), tried = 0;
    unsigned* qctr = ctl + CW_QH + 4 * rep + hcur;
    if (tid == 0) qidx[0] = (int)atomicAdd(qctr, 1u);
    __syncthreads();
    int idx = qidx[0];
    __syncthreads();
    for (;;) {
        bool done = false;
        while (idx >= N_HEAD_FIXED + pre[64 * hcur + 64] - pre[64 * hcur]) {
            if (++tried == 4) { done = true; break; }
            hcur = (hcur + 1) & 3; qctr = ctl + CW_QH + 4 * rep + hcur;
            if (tid == 0) qidx[0] = (int)atomicAdd(qctr, 1u);
            __syncthreads();
            idx = qidx[0];
            __syncthreads();
        }
        if (done) break;
        const int h = hcur; int nxt_idx;
        if (idx < N_HEAD_MLA) {
            const int j = idx; int qb, t0, nt, kind;
            if (j < 32) { qb = 32 + j; t0 = 0; nt = 128; kind = 1; }
            else { const int k = j - 32; if (k & 1) { qb = 31 - (k >> 1); t0 = 0; nt = 4 * (qb + 1); kind = 0; } else { qb = 63 - (k >> 1); t0 = 128; nt = 4 * (qb - 31); kind = 2; } }
            const int qrow = 256 * qb + 32 * wave + r;
            const float knmax = sqrtf(__uint_as_float(ctl[CW_KNPIECE + h * 4 + 0]) + __uint_as_float(ctl[CW_KNPIECE + h * 4 + 1]) + __uint_as_float(ctl[CW_KNPIECE + h * 4 + 2]) + __uint_as_float(ctl[CW_KNPIECE + h * 4 + 3]));
            const int slot = (h * 32 + (qb & 31)) * 2 + (kind == 2 ? 1 : 0); const bool causal = kind != 1;
            nxt_idx = attn_item<192>(qctr, tid, lds, Q + h * 192, 768, qrow, true, causal ? qrow : 0x7fffffff, causal ? 256 * qb + 32 * wave : 0x7fffffff, KK + h * 192, 768, VT + (size_t)h * 128 * S, 64 * t0, nt, knmax, kpemax,
                           kind == 0 ? 0 : 1, kind == 0 ? qrow : 32 * wave + r, PART + (size_t)slot * 256 * 128, CC + h * 128, PL + (size_t)slot * 256);
        } else {
            int key0, qrow, qpos, wqmin, pslot; bool valid = true;
            if (idx < N_HEAD_FIXED) { const int blk = idx - N_HEAD_MLA; key0 = 256 * blk; qrow = 256 * blk + 32 * wave + r; qpos = qrow; wqmin = 256 * blk + 32 * wave; pslot = 3; }
            else { const int g2 = pre[64 * h] + idx - N_HEAD_FIXED; int lo = 64 * h, hi = 64 * h + 64;
                while (hi - lo > 1) { const int mid = (lo + hi) >> 1; if (pre[mid] <= g2) lo = mid; else hi = mid; }
                const int hb = lo, chunk = g2 - pre[hb]; const int cntv = (int)ctl[CW_CNT + hb]; int nq = cntv - 256 * chunk; nq = nq > 256 ? 256 : nq;
                const int li = 32 * wave + r; valid = li < nq; const int ent = LIST[(size_t)hb * S + 256 * chunk + (valid ? li : 0)]; qrow = ent >> 2; pslot = ent & 3;
                key0 = 256 * (hb & 63); qpos = 0x7fffffff; wqmin = 0x7fffffff; }
            const float kmmax = sqrtf(__uint_as_float(ctl[CW_KMMAX + h]));
            nxt_idx = attn_item<128>(qctr, tid, lds, MQ + h * 128, 512, qrow, valid, qpos, wqmin, MK + h * 128, 512, MVT + (size_t)h * 128 * S, key0, 4, kmmax, 0.f, 2, (qrow * 4 + h) * 4 + pslot, nullptr, PARTB, LB);
        }
        if (tid == 0) qidx[0] = nxt_idx;
        __syncthreads();
        idx = qidx[0];
        __syncthreads();
    }
}
__device__ __forceinline__ void attn_norm_phase(const Params& P, int G) {
    int tid_l = threadIdx.x; asm volatile("" : "+v"(tid_l)); const int lane = tid_l & 63, wave = tid_l >> 6;
    unsigned char* dout = (unsigned char*)P.out;
    const float* PART = (const float*)(dout + DO_PART); const float* PL = (const float*)(dout + DO_PL); const bf16_t* PARTB = (const bf16_t*)(dout + DO_PARTB); const float* LB = (const float*)(dout + DO_LB);
    bf16_t* CC = (bf16_t*)(P.ws + WS_CONCAT);
    const XcdSplit xs(S, G, NWV);
    for (int row = xs.base + wave; row < xs.lim; row += xs.step) {
        float acc[16]; float lt = 0.f; bool wr = false;
#pragma unroll
        for (int e = 0; e < 16; ++e) acc[e] = 0.f;
        const int qb = row >> 8;
        if (lane < 32) { if (qb >= 32) { wr = true; const int h = lane >> 3;
#pragma unroll
                for (int c = 0; c < 2; ++c) { const size_t slot = (size_t)((h * 32 + qb - 32) * 2 + c) * 256 + (row & 255); lt += PL[slot]; const f32x4* pp = (const f32x4*)(PART + slot * 128 + 16 * (lane & 7));
#pragma unroll
                    for (int e4 = 0; e4 < 4; ++e4) { const f32x4 v = pp[e4]; acc[4 * e4] += v[0]; acc[4 * e4 + 1] += v[1]; acc[4 * e4 + 2] += v[2]; acc[4 * e4 + 3] += v[3]; } } } }
        else { wr = true; const int h = (lane >> 3) - 4; const int np = qb < 3 ? qb : 3;
            const size_t ps0 = ((size_t)row * 4 + h) * 4; const f32x4 l4 = *(const f32x4*)(LB + ps0); u32x4 raw[4][2];
#pragma unroll
            for (int sl = 0; sl < 4; ++sl) { const u32x4* pp = (const u32x4*)(PARTB + (ps0 + sl) * 128 + 16 * (lane & 7)); raw[sl][0] = pp[0]; raw[sl][1] = pp[1]; }
#pragma unroll
            for (int sl = 0; sl < 4; ++sl) { const bool use = sl == 3 || sl < np; lt += use ? l4[sl] : 0.f;
#pragma unroll
                for (int e8 = 0; e8 < 2; ++e8) { const u32x4 v = raw[sl][e8]; float f[8] = {bf2f(v.x & 0xffffu), bf2f(v.x >> 16), bf2f(v.y & 0xffffu), bf2f(v.y >> 16), bf2f(v.z & 0xffffu), bf2f(v.z >> 16), bf2f(v.w & 0xffffu), bf2f(v.w >> 16)};
#pragma unroll
                    for (int e = 0; e < 8; ++e) acc[8 * e8 + e] += use ? f[e] : 0.f; } } }
        if (wr) { const float inv = 1.f / lt; u32x4 w0, w1;
            w0.x = pk2(acc[0] * inv, acc[1] * inv); w0.y = pk2(acc[2] * inv, acc[3] * inv); w0.z = pk2(acc[4] * inv, acc[5] * inv); w0.w = pk2(acc[6] * inv, acc[7] * inv);
            w1.x = pk2(acc[8] * inv, acc[9] * inv); w1.y = pk2(acc[10] * inv, acc[11] * inv); w1.z = pk2(acc[12] * inv, acc[13] * inv); w1.w = pk2(acc[14] * inv, acc[15] * inv);
            u32x4* dst = (u32x4*)(CC + (size_t)row * D + 16 * lane); dst[0] = w0; dst[1] = w1; }
    }
}

#define GAS __attribute__((address_space(1)))

typedef GAS unsigned gu32;
typedef GAS unsigned long long gu64;
#define RLX_AGENT __ATOMIC_RELAXED, __HIP_MEMORY_SCOPE_AGENT
#define LDS_WAIT() asm volatile("s_waitcnt lgkmcnt(0)" ::: "memory")
#define VM_WAIT() asm volatile("s_waitcnt vmcnt(0)" ::: "memory")
__device__ __forceinline__ unsigned long long rt() { return __builtin_amdgcn_s_memrealtime(); }
#define XB_TMO      128
#define XB_XCNT(j)  (256  + 64 * (j))
#define XB_XSUB(j)  (1280 + 64 * (j))
#define XB_XGEN(j)  (2304 + 64 * (j))
#define XB_TOP      3328
#define XB_TOPGEN   3392
#define XCD_BAR_WORDS 3456
#define XB_SPIN_CAP (1u << 18)

__device__ __forceinline__ unsigned xb_ld(unsigned* p)              { return __hip_atomic_load(p, __ATOMIC_RELAXED, __HIP_MEMORY_SCOPE_AGENT); }
__device__ __forceinline__ unsigned xb_add(unsigned* p, unsigned v) { return __hip_atomic_fetch_add(p, v, __ATOMIC_RELAXED, __HIP_MEMORY_SCOPE_AGENT); }
__device__ __forceinline__ unsigned xb_xcc_id() { return (unsigned)__builtin_amdgcn_s_getreg((3 << 11) | 20) & 0xFu; }
#define XB_SPIN(cond, bar) do { unsigned _sp = 0; while (cond) { __builtin_amdgcn_s_sleep(1); \
    if ((++_sp & 255u) == 0u) { if (xb_ld(&(bar)[XB_TMO])) break; if (_sp > XB_SPIN_CAP) { atomicAdd(&(bar)[XB_TMO], 1u); break; } } } } while (0)

struct XcdBarrier {
    unsigned* bar; unsigned x;
    volatile LAS unsigned* st;
};

__device__ __forceinline__ XcdBarrier xcd_barrier_post(unsigned* bar, volatile LAS unsigned* st) {
    XcdBarrier b; b.bar = bar; b.x = xb_xcc_id(); b.st = st;
    if (threadIdx.x == 0) (void)xb_add(&bar[XB_XCNT(b.x)], 1u);
    return b;
}
__device__ __forceinline__ void xcd_barrier_complete(unsigned* bar, unsigned x, unsigned& nloc, unsigned& nx) {
    const unsigned G = gridDim.x * gridDim.y * gridDim.z;
    unsigned sum, cnt, mine, sp = 0u;
    for (;;) {
        sum = 0u; cnt = 0u; mine = 0u;
#pragma unroll
        for (unsigned j = 0; j < 16; ++j) { const unsigned c = xb_ld(&bar[XB_XCNT(j)]); sum += c; cnt += (c > 0u) ? 1u : 0u; mine = (j == x) ? c : mine; }
        if (sum == G) break;
        __builtin_amdgcn_s_sleep(1);
        if ((++sp & 255u) == 0u) { if (xb_ld(&bar[XB_TMO])) break; if (sp > XB_SPIN_CAP) { atomicAdd(&bar[XB_TMO], 1u); break; } }
    }
    nloc = mine > 0u ? mine : 1u; nx = cnt > 0u ? cnt : 1u;
}

__device__ __forceinline__ void xcd_barrier(const XcdBarrier& b) {
    asm volatile("s_waitcnt vmcnt(0)" ::: "memory");
    __syncthreads();
    if (threadIdx.x == 0) {
        unsigned* bar = b.bar;
        __builtin_amdgcn_s_waitcnt(0);
        unsigned nloc = b.st[0], nx = b.st[1];
        if (nloc == 0u) { xcd_barrier_complete(bar, b.x, nloc, nx); b.st[0] = nloc; b.st[1] = nx; }
        const unsigned old = xb_add(&bar[XB_XSUB(b.x)], 1u);
        const unsigned gen = old / nloc;
        if (old + 1u == (gen + 1u) * nloc) {
            __builtin_amdgcn_fence(__ATOMIC_RELEASE, "agent");
            asm volatile("s_waitcnt vmcnt(0)" ::: "memory");
            const unsigned og = xb_add(&bar[XB_TOP], 1u);
            const unsigned tg = og / nx;
            if (og + 1u == (tg + 1u) * nx) xb_add(&bar[XB_TOPGEN], 1u);
            else XB_SPIN(xb_ld(&bar[XB_TOPGEN]) == tg, bar);
            __builtin_amdgcn_fence(__ATOMIC_ACQUIRE, "agent");
            xb_add(&bar[XB_XGEN(b.x)], 1u);
            asm volatile("s_waitcnt vmcnt(0)" ::: "memory");
        } else {
            XB_SPIN(xb_ld(&bar[XB_XGEN(b.x)]) == gen, bar);
            __builtin_amdgcn_fence(__ATOMIC_ACQUIRE, "agent");
            asm volatile("s_waitcnt vmcnt(0)" ::: "memory");
        }
    }
    __syncthreads();
}

constexpr int CW_BAR = 131072;

#ifdef SELFCHECK
constexpr int CW_CHK = 40;
__device__ __forceinline__ float blk_reduce(const int tid, float v, bool domax, LAS float* red) {
#pragma unroll
    for (int o = 1; o < 64; o <<= 1) { const float w = __shfl_xor(v, o); v = domax ? fmaxf(v, w) : v + w; }
    __syncthreads(); if ((tid & 63) == 0) red[tid >> 6] = v; __syncthreads();
    float r = red[0];
#pragma unroll
    for (int i = 1; i < 8; ++i) r = domax ? fmaxf(r, red[i]) : r + red[i];
    __syncthreads();
    return r;
}
__device__ __forceinline__ int chk_token(int i) {
    if (i < 16) { const int base = (i >> 1) == 0 ? 0 : (i >> 1) == 1 ? 32 : (i >> 1) == 2 ? 64 : (i >> 1) == 3 ? 128 : (i >> 1) == 4 ? 256 : (i >> 1) == 5 ? 512 : (i >> 1) == 6 ? 768 : 1024;
        return (i & 1) ? (i == 1 ? 1 : i == 9 ? 257 : base - 1) : base; }
    return (i * 64 + (i * 13) % 64) & (S - 1); }
__device__ __forceinline__ bool chk_softmax_pv(const int tid, LAS float* sbuf, LAS int* kmap, int n, const bf16_t* VTh, const bf16_t* CC, int t, int col0, LAS float* red, LAS float* obuf) {
    float m = -INFINITY; for (int k = tid; k < n; k += NT) m = fmaxf(m, sbuf[k]);
    m = blk_reduce(tid, m, true, red);
    float l = 0.f; for (int k = tid; k < n; k += NT) { const float p = __builtin_amdgcn_exp2f(sbuf[k] - m); sbuf[k] = p; l += p; }
    l = blk_reduce(tid, l, false, red);
    const int dv = tid & 127, part = tid >> 7; float o = 0.f;
    for (int k = part; k < n; k += 4) { const int key = kmap ? kmap[k] : k; o += sbuf[k] * bf2f(VTh[(size_t)dv * S + key]); }
    obuf[tid] = o; __syncthreads();
    float ref = 0.f, err = 0.f;
    if (tid < 128) { ref = (obuf[tid] + obuf[tid + 128] + obuf[tid + 256] + obuf[tid + 384]) / l; err = fabsf(ref - bf2f(CC[(size_t)t * D + col0 + tid])); ref = fabsf(ref); }
    const float mref = blk_reduce(tid, ref, true, red), merr = blk_reduce(tid, err, true, red);
    return !(merr <= 0.02f * mref + 1e-6f);
}
__device__ __forceinline__ void selfcheck_attn(const Params& P, LAS unsigned char* lds, int l, int G) {
    int tid_l = threadIdx.x; asm volatile("" : "+v"(tid_l)); const int tid = tid_l; unsigned char* ws = P.ws;
    unsigned* flag = (unsigned*)(ws + WS_CTL) + CW_CHK; unsigned* ctl = (unsigned*)(ws + WS_CTL) + l * CW_LAYER;
    const bf16_t* Q = (const bf16_t*)(ws + WS_Q); const bf16_t* KK = (const bf16_t*)(ws + WS_K); const bf16_t* VT = (const bf16_t*)(ws + WS_VT); const bf16_t* KPE = (const bf16_t*)(ws + WS_KPE);
    const bf16_t* MQ = (const bf16_t*)(ws + WS_MQ); const bf16_t* MK = (const bf16_t*)(ws + WS_MK); const bf16_t* MVT = (const bf16_t*)(ws + WS_MVT);
    const bf16_t* CC = (const bf16_t*)(ws + WS_CONCAT); const bf16_t* CQN = (const bf16_t*)(ws + WS_CQN); const bf16_t* CKVN = (const bf16_t*)(ws + WS_CKVN);
    const int* kmean = (const int*)(ctl + CW_KMEAN); const float* RM = (const float*)(ws + WS_ROPE_MLA);
    LAS float* sbuf = (LAS float*)lds;
    LAS float* qv = (LAS float*)(lds + 65536);
    LAS float* obuf = (LAS float*)(lds + 65536 + 4096);
    LAS float* red = (LAS float*)(lds + 65536 + 8192);
    LAS int* kmap = (LAS int*)(lds + 65536 + 12288);
    LAS float* gate = (LAS float*)(lds + 65536 + 20480);
    LAS int* sel = (LAS int*)(lds + 65536 + 20480 + 256);
    for (int smp = blockIdx.x; smp < 256; smp += G) {
        const int t = chk_token(smp), h = smp & 3; unsigned bad = 0u;
        __syncthreads();
        if (tid < 192) qv[tid] = bf2f(Q[(size_t)t * 768 + h * 192 + tid]);
        __syncthreads();
        for (int k = tid; k <= t; k += NT) { const bf16_t* kr = KK + (size_t)k * 768 + h * 192; float sc = 0.f; for (int d = 0; d < 192; ++d) sc += qv[d] * bf2f(kr[d]); sbuf[k] = sc; }
        __syncthreads();
        if (chk_softmax_pv(tid, sbuf, nullptr, t + 1, VT + (size_t)h * 128 * S, CC, t, h * 128, red, obuf)) bad |= 1u;
        const int own = t >> 8;
        if (tid < 128) qv[tid] = bf2f(MQ[(size_t)t * 512 + h * 128 + tid]);
        __syncthreads();
        if (tid < 64) { float g = -INFINITY; if (tid < own) { g = 0.f; for (int d = 0; d < 128; ++d) g += qv[d] * ((float)kmean[(size_t)(h * 64 + tid) * 128 + d] * KM_INV) * (1.f / 256.f); } gate[tid] = g; }
        __syncthreads();
        if (tid == 0) { int ns = own < 3 ? own : 3; float last = 0.f; for (int p = 0; p < 4; ++p) { int bi = -1; float bv = -INFINITY; for (int b = 0; b < own; ++b) if (gate[b] > bv) { bv = gate[b]; bi = b; }
                if (p < 3) { sel[p] = bi; last = bv; if (bi >= 0) gate[bi] = -INFINITY; } else sel[4] = (own > 3 && last - bv < 1e-4f * (fabsf(last) + 1e-3f)) ? 1 : 0; }
            sel[3] = ns; }
        __syncthreads();
        const int ns = sel[3], skip = sel[4]; const int nown = t - 256 * own + 1, n = 256 * ns + nown;
        for (int kk = tid; kk < n; kk += NT) { const int key = kk < 256 * ns ? 256 * sel[kk >> 8] + (kk & 255) : 256 * own + (kk - 256 * ns); kmap[kk] = key;
            const bf16_t* kr = MK + (size_t)key * 512 + h * 128; float sc = 0.f; for (int d = 0; d < 128; ++d) sc += qv[d] * bf2f(kr[d]); sbuf[kk] = sc; }
        __syncthreads();
        if (chk_softmax_pv(tid, sbuf, kmap, n, MVT + (size_t)h * 128 * S, CC, t, 512 + h * 128, red, obuf) && !skip) bad |= 2u;
        { const float* wuq = P.in[4] + (size_t)l * 512 * 768; const float* gq = P.in[3] + l * 512;
          for (int nn = tid; nn < 768; nn += NT) { float a = 0.f; for (int k = 0; k < 512; ++k) a += bf2f(CQN[(size_t)t * 512 + k]) * gq[k] * wuq[(size_t)k * 768 + nn]; qv[nn] = a * CQ_SCALE; }
          __syncthreads();
          float ref = 0.f, err = 0.f;
          for (int nn = tid; nn < 768; nn += NT) { const int hd = nn / 192, d = nn - hd * 192; float v; int pos;
              if (d < 128) { v = qv[nn]; pos = nn; }
              else { const int e = d - 128, j = e & 31; const float x1 = qv[hd * 192 + 128 + j], x2 = qv[hd * 192 + 160 + j], c = RM[((size_t)t * 32 + j) * 2], sn = RM[((size_t)t * 32 + j) * 2 + 1];
                  v = e < 32 ? x1 * c - x2 * sn : x1 * sn + x2 * c; pos = hd * 192 + 128 + 2 * j + (e >> 5); }
              ref = fmaxf(ref, fabsf(v)); err = fmaxf(err, fabsf(v - bf2f(Q[(size_t)t * 768 + pos]))); }
          const float mref = blk_reduce(tid, ref, true, red), merr = blk_reduce(tid, err, true, red);
          if (!(merr <= 0.03f * mref + 1e-6f)) bad |= 4u; }
        { const float* wkv = P.in[6] + (size_t)l * 256 * 1024; const float* gk = P.in[5] + l * 256; float ref = 0.f, err = 0.f;
          for (int nn = tid; nn < 1024; nn += NT) { float a = 0.f; for (int k = 0; k < 256; ++k) a += bf2f(CKVN[(size_t)t * 256 + k]) * gk[k] * wkv[(size_t)k * 1024 + nn];
              const int hd = nn >> 8, d = nn & 255; const float got = d < 128 ? bf2f(KK[(size_t)t * 768 + hd * 192 + d]) : bf2f(VT[(size_t)(hd * 128 + d - 128) * S + t]);
              ref = fmaxf(ref, fabsf(a)); err = fmaxf(err, fabsf(a - got)); }
          if (tid < 256) { const int hd = tid >> 6, e = tid & 63; if (KK[(size_t)t * 768 + hd * 192 + 128 + e] != KPE[(size_t)t * 64 + e]) err = 1e30f; }
          const float mref = blk_reduce(tid, ref, true, red), merr = blk_reduce(tid, err, true, red);
          if (!(merr <= 0.03f * mref + 1e-6f)) bad |= 8u; }
        { const int b = (smp >> 2) & 63; float ref = 0.f, err = 0.f;
          if (tid < 128) { float a = 0.f; for (int i = 0; i < 256; ++i) a += bf2f(MK[(size_t)(256 * b + i) * 512 + h * 128 + tid]); a *= (1.f / 256.f); ref = fabsf(a); err = fabsf(a - (float)kmean[(size_t)(h * 64 + b) * 128 + tid] * KM_INV * (1.f / 256.f)); }
          const float mref = blk_reduce(tid, ref, true, red), merr = blk_reduce(tid, err, true, red);
          if (!(merr <= 0.02f * mref + 1e-6f)) bad |= 16u; }
        if (tid == 0 && bad) atomicOr(flag, bad);
    }
    __syncthreads();
}
__device__ __forceinline__ void selfcheck_p2a(const Params& P, LAS unsigned char* lds, int G) {
    int tid_l = threadIdx.x; asm volatile("" : "+v"(tid_l)); const int tid = tid_l; unsigned char* ws = P.ws; unsigned* flag = (unsigned*)(ws + WS_CTL) + CW_CHK;
    const bf16_t* H = (const bf16_t*)(ws + WS_H); const bf16_t* MQ = (const bf16_t*)(ws + WS_MQ); const bf16_t* MK = (const bf16_t*)(ws + WS_MK); const bf16_t* MVT = (const bf16_t*)(ws + WS_MVT); const bf16_t* KPE = (const bf16_t*)(ws + WS_KPE);
    const float* RM = (const float*)(ws + WS_ROPE_MLA); const float* RO = (const float*)(ws + WS_ROPE_MOBA);
    LAS float* red = (LAS float*)(lds + 65536 + 8192);
    for (int smp = blockIdx.x; smp < 256; smp += G) { const int t = chk_token(smp); float err = 0.f; const bf16_t* hr = H + (size_t)t * HLD;
        { const int c = tid, d = c & 127; float q = bf2f(hr[C_MQ + c]), k = bf2f(hr[C_MK + c]);
          if (d < 32) { const int j = d & 15; const float cs = RO[((size_t)t * 16 + j) * 2], sn = RO[((size_t)t * 16 + j) * 2 + 1];
              const float q1 = bf2f(hr[C_MQ + (c & ~31) + j]), q2 = bf2f(hr[C_MQ + (c & ~31) + 16 + j]), k1 = bf2f(hr[C_MK + (c & ~31) + j]), k2 = bf2f(hr[C_MK + (c & ~31) + 16 + j]);
              q = d < 16 ? q1 * cs - q2 * sn : q1 * sn + q2 * cs; k = d < 16 ? k1 * cs - k2 * sn : k1 * sn + k2 * cs; }
          err = fmaxf(err, fabsf(q * CM_SCALE - bf2f(MQ[(size_t)t * 512 + c])) / (fabsf(q * CM_SCALE) + 0.05f));
          err = fmaxf(err, fabsf(k - bf2f(MK[(size_t)t * 512 + c])) / (fabsf(k) + 0.5f));
          if (MVT[(size_t)c * S + t] != hr[C_MV + c]) err = 1e30f;
          if (c < 64) { const int j = c & 31; const float x1 = bf2f(hr[C_KR + j]), x2 = bf2f(hr[C_KR + 32 + j]), cs = RM[((size_t)t * 32 + j) * 2], sn = RM[((size_t)t * 32 + j) * 2 + 1];
              const float v = c < 32 ? x1 * cs - x2 * sn : x1 * sn + x2 * cs; err = fmaxf(err, fabsf(v - bf2f(KPE[(size_t)t * 64 + 2 * j + (c >> 5)])) / (fabsf(v) + 0.5f)); } }
        const float merr = blk_reduce(tid, err, true, red);
        if (tid == 0 && !(merr <= 0.02f)) atomicOr(flag, 32u); }
    __syncthreads();
}
#endif

#ifdef USE_CG_SYNC
#define GSYNC() grid.sync()
#else
#define GSYNC() xcd_barrier(xbar)
#endif
template <int l> __device__ __forceinline__ void layer_fwd(const Params& P, LAS unsigned char* lds, cg::grid_group& grid, const XcdBarrier& xbar, const int G) {
    unsigned char* ws = P.ws;

        unsigned* ctl = (unsigned*)(ws + WS_CTL) + l * CW_LAYER;
        bf16_t* Y = (bf16_t*)(ws + WS_Y); float* stats1 = (float*)(ws + WS_STATS); float* stats2 = stats1 + (size_t)S * 2;
#ifndef SKIP_G1
        { EpiStore E{(bf16_t*)(ws + WS_H), HLD}; GEMM_CALL(EpiStore, E, ws + WS_XB, ws + WS_WIN, HLD, D, (int)blockIdx.x); }
#endif
#ifdef REP_G1
        GSYNC(); { EpiStore E{(bf16_t*)(ws + WS_H), HLD}; GEMM_CALL(EpiStore, E, ws + WS_XB, ws + WS_WIN, HLD, D, (int)blockIdx.x); }
#endif
        GSYNC();

#ifndef SKIP_P2A
        p2a_phase(P, l, lds, G);
#endif
#ifdef SELFCHECK
        GSYNC(); selfcheck_p2a(P, lds, G);
#endif
#ifdef REP_P2A
        GSYNC(); p2a_phase(P, l, lds, G);
#endif

        GSYNC();
#ifndef SKIP_G2
        { EpiQ E{(bf16_t*)(ws + WS_Q), (const float*)(ws + WS_ROPE_MLA)}; GEMM_CALL(EpiQ, E, ws + WS_CQN, ws + WS_WUQ, 768, 512, (int)blockIdx.x); }
#endif
#ifndef SKIP_G3
        { EpiKV E{(bf16_t*)(ws + WS_K), (bf16_t*)(ws + WS_VR), (const bf16_t*)(ws + WS_KPE), ctl + CW_KNPIECE}; int kkv = 256; asm volatile("" : "+s"(kkv)); GEMM_CALL(EpiKV, E, ws + WS_CKVN, ws + WS_WUKV, 1024, kkv, (int)blockIdx.x);
          __threadfence_block(); __syncthreads();
          { pg8::StaticOrder so2; so2.init(S, 1024, G, (int)blockIdx.x); pg8::Unit u2; for (int i2 = 0; so2.next(i2, u2); ++i2) vt_tile((const bf16_t*)(ws + WS_VR), (bf16_t*)(ws + WS_VT), u2.pm, u2.pn); } }
#endif
#ifndef SKIP_G4
        { EpiStore E{(bf16_t*)(ws + WS_CONCAT) + 1024, D}; GEMM_CALL(EpiStore, E, ws + WS_CONVA, ws + WS_WPW, 512, 512, (int)((blockIdx.x + 128) % G)); }
#endif
#ifndef SKIP_G5
        { EpiStore E{(bf16_t*)(ws + WS_CONCAT) + 1536, D}; GEMM_CALL(EpiStore, E, ws + WS_POOLED, ws + WS_WPOOL, 512, 512, (int)((blockIdx.x + 64) % G)); }
#endif

#ifndef SKIP_GATE
        gate_phase(P, l, lds, G);
#endif
#ifdef REP_GATE
        gate_phase(P, l, lds, G, 1);
#endif
#ifdef REP_P2B
        { EpiQ E{(bf16_t*)(ws + WS_Q), (const float*)(ws + WS_ROPE_MLA)}; GEMM_CALL(EpiQ, E, ws + WS_CQN, ws + WS_WUQ, 768, 512, (int)blockIdx.x); }
        { EpiStore E{(bf16_t*)(ws + WS_CONCAT) + 1024, D}; GEMM_CALL(EpiStore, E, ws + WS_CONVA, ws + WS_WPW, 512, 512, (int)((blockIdx.x + 128) % G)); }
        { EpiStore E{(bf16_t*)(ws + WS_CONCAT) + 1536, D}; GEMM_CALL(EpiStore, E, ws + WS_POOLED, ws + WS_WPOOL, 512, 512, (int)((blockIdx.x + 64) % G)); }
#endif

        GSYNC();

#ifndef SKIP_ATTN
        attn_phase(P, l, lds, G);
#endif
#ifdef REP_ATTN
        GSYNC(); attn_phase(P, l, lds, G, 1);
#endif

        GSYNC();

#ifndef SKIP_NORM
        attn_norm_phase(P, G);
#endif
#ifdef SELFCHECK
        GSYNC(); selfcheck_attn(P, lds, l, G);
#endif
#ifdef REP_LN
        GSYNC(); attn_norm_phase(P, G);
#endif

        GSYNC();
#ifndef SKIP_G6
        if (l == 0) { EpiRes<0> E{P.in[0], Y, nullptr, nullptr, nullptr}; GEMM_CALL(EpiRes<0>, E, ws + WS_CONCAT, ws + WS_WOUT, D, D, (int)blockIdx.x); }
        else { EpiRes<1> E{nullptr, Y, stats2, P.in[20] + (size_t)(l - 1) * D, P.in[21] + (size_t)(l - 1) * D}; GEMM_CALL(EpiRes<1>, E, ws + WS_CONCAT, ws + WS_WOUT, D, D, (int)blockIdx.x); }
#endif
        GSYNC();
        ln_phase<false>(Y, P.in[15] + (size_t)l * D, P.in[16] + (size_t)l * D, stats1, (bf16_t*)(ws + WS_XB), nullptr, G);
        GSYNC();
#ifdef REP_LN
        ln_phase<false>(Y, P.in[15] + (size_t)l * D, P.in[16] + (size_t)l * D, stats1, (bf16_t*)(ws + WS_XB), nullptr, G);
        GSYNC();
#endif
#ifndef SKIP_G8
        { EpiFfn E{(bf16_t*)(ws + WS_ACT)}; GEMM_CALL(EpiFfn, E, ws + WS_XB, ws + WS_WGU, 2 * DFF, D, (int)blockIdx.x); }
#endif
#ifdef REP_G8
        GSYNC(); { EpiFfn E{(bf16_t*)(ws + WS_ACT)}; GEMM_CALL(EpiFfn, E, ws + WS_XB, ws + WS_WGU, 2 * DFF, D, (int)blockIdx.x); }
#endif
        GSYNC();
#ifndef SKIP_G9
        { EpiRes<1> E{nullptr, Y, stats1, P.in[15] + (size_t)l * D, P.in[16] + (size_t)l * D}; GEMM_CALL(EpiRes<1>, E, ws + WS_ACT, ws + WS_WDN, D, DFF, (int)blockIdx.x); }
#endif
        GSYNC();
        if (l + 1 < NLAYER) { ln_phase<false>(Y, P.in[20] + (size_t)l * D, P.in[21] + (size_t)l * D, stats2, (bf16_t*)(ws + WS_XB), nullptr, G); prep_weights(P, l + 1, lds, G); GSYNC();
#ifdef REP_PREP
            prep_weights(P, l + 1, lds, G); GSYNC();
#endif
#ifdef REP_LN
            ln_phase<false>(Y, P.in[20] + (size_t)l * D, P.in[21] + (size_t)l * D, stats2, (bf16_t*)(ws + WS_XB), nullptr, G); GSYNC();
#endif
        }
#ifdef SELFCHECK
        else ln_phase<true>(Y, P.in[20] + (size_t)l * D, P.in[21] + (size_t)l * D, nullptr, nullptr, P.out, G, (float)(*((const unsigned*)(ws + WS_CTL) + 40)));
#else
        else ln_phase<true>(Y, P.in[20] + (size_t)l * D, P.in[21] + (size_t)l * D, nullptr, nullptr, P.out, G);
#endif

}

__global__ void __launch_bounds__(NT, 2) hybrid_fwd(Params P) {
    extern __shared__ __attribute__((aligned(16))) unsigned char lds_raw[];
    LAS unsigned char* lds = (LAS unsigned char*)lds_raw;
    cg::grid_group grid = cg::this_grid();
    const int G = gridDim.x;
    unsigned char* ws = P.ws;
    volatile LAS unsigned* xst = (volatile LAS unsigned*)(lds + LDS_MISC + 8192);
    if (threadIdx.x < 2) xst[threadIdx.x] = 0u;
    __syncthreads();
    const XcdBarrier xbar = xcd_barrier_post((unsigned*)(ws + WS_CTL) + CW_BAR, xst);

#ifndef SKIP_PREP
    prep_weights(P, 0, lds, G);
    prep_layer0(P, G);
#endif
#ifdef REP_PREP
    GSYNC(); prep_weights(P, 0, lds, G); prep_layer0(P, G);
#endif
#ifdef REP_SYNC
#pragma unroll 1
    for (int i_ = 0; i_ < 20; ++i_) GSYNC();
#endif

    grid.sync();
    layer_fwd<0>(P, lds, grid, xbar, G);
    layer_fwd<1>(P, lds, grid, xbar, G);
}

extern "C" void kernel_launch(void* const* d_in, const int* in_sizes, int n_in, void* d_out, int out_size, void* d_ws, size_t ws_size, hipStream_t stream) {
    static int grid = 0;
    if (grid == 0) {
        if (n_in != 22 || out_size != S * D || ws_size < WS_END) { fprintf(stderr, "kernel_launch: unexpected shapes (n_in %d, out %d, ws %zu)\n", n_in, out_size, ws_size); grid = -1; return; }
        int dev = 0, cus = 0, per_cu = 0;
        hipGetDevice(&dev); hipDeviceGetAttribute(&cus, hipDeviceAttributeMultiprocessorCount, dev);
        if (hipFuncSetAttribute((const void*)hybrid_fwd, hipFuncAttributeMaxDynamicSharedMemorySize, LDS_BYTES) != hipSuccess) { fprintf(stderr, "kernel_launch: hipFuncSetAttribute failed\n"); grid = -1; return; }
        if (hipOccupancyMaxActiveBlocksPerMultiprocessor(&per_cu, (const void*)hybrid_fwd, NT, LDS_BYTES) != hipSuccess || per_cu < 1) per_cu = 1;
        (void)hipGetLastError();
        grid = cus * 1;
        fprintf(stderr, "kernel_launch: %d CUs, occupancy %d, grid %d\n", cus, per_cu, grid);
    }
    if (grid < 0) return;
    hipMemsetAsync((char*)d_ws + WS_CTL, 0, CTL_BYTES, stream);
    Params p{};
    for (int i = 0; i < 22; ++i) p.in[i] = (const float*)d_in[i];
    p.out = (float*)d_out; p.ws = (unsigned char*)d_ws;
    void* args[] = {&p};
    hipError_t e = hipLaunchCooperativeKernel((const void*)hybrid_fwd, dim3(grid), dim3(NT), args, LDS_BYTES, stream);
    if (e != hipSuccess) fprintf(stderr, "cooperative launch failed: %s (grid %d)\n", hipGetErrorString(e), grid);
}
```

```cpp
#include <hip/hip_runtime.h>
#include <hip/hip_cooperative_groups.h>
#include <cstdio>
#include <cstdint>
namespace cg = cooperative_groups;
namespace pg8 {
#define PG8_LAS __attribute__((address_space(3)))
typedef unsigned short bf16_t;
typedef short bf16x8 __attribute__((ext_vector_type(8)));
typedef float f32x4 __attribute__((ext_vector_type(4)));
typedef unsigned u32x4 __attribute__((ext_vector_type(4)));
constexpr int BM = 256, BK = 64, HALF = 128, HTB = HALF * BK * 2  , STAGE_BYTES = 8 * HTB, NXCD = 8, WGM = 4;

__host__ __device__ __forceinline__ int lds_byte(int r, int c) { const int st = (r >> 4) * 2 + (c >> 5), rr = r & 15, cc = c & 31, ob = rr * 64 + cc * 2; return st * 1024 + (ob ^ (((ob >> 9) & 1) << 5)); }
__host__ __device__ __forceinline__ void stage_rc(int b, int& R, int& C) { const int st = b / 1024, sb = b % 1024, swz = sb ^ (((sb >> 9) & 1) << 5); R = (st >> 1) * 16 + swz / 64; C = (st & 1) * 32 + (swz % 64) / 2; }
__host__ __device__ __forceinline__ int perm32(int rho) { const int n = rho >> 4, i = rho & 15; return 8 * (i >> 2) + 4 * n + (i & 3); }

struct Unit { int pm, pn; };
struct Gemm { const bf16_t* A; const bf16_t* Bt; int M, N, K; };

struct StaticOrder {
    int nM, nN, nwg, G, c;
    __host__ __device__ __forceinline__ void init(int M, int N, int G_, int c_) { nM = M / BM; nN = N / BM; nwg = nM * nN; G = G_; c = c_; }
    __host__ __device__ __forceinline__ bool next(int i, Unit& u) const {
        const long L = (long)i * G + c; if (L >= nwg) return false;
        int wgid = (int)L; { const int q = nwg / NXCD, r = nwg % NXCD, xcd = wgid % NXCD, off = wgid / NXCD; wgid = (xcd < r ? xcd * (q + 1) : r * (q + 1) + (xcd - r) * q) + off; }
        const int nig = WGM * nN, gid = wgid / nig, fm = gid * WGM, gsz = (nM - fm) < WGM ? (nM - fm) : WGM;
        u.pm = fm + ((wgid % nig) % gsz); u.pn = (wgid % nig) / gsz; return true;
    }
    __device__ __forceinline__ void a_ready(const Unit&) const {}
    __device__ __forceinline__ void done(const Unit&) const {}
};
__device__ __forceinline__ unsigned cvt_pk_bf16(float lo, float hi) { unsigned r; asm volatile("v_cvt_pk_bf16_f32 %0, %1, %2" : "=v"(r) : "v"(lo), "v"(hi)); return r; }
typedef float f32x2 __attribute__((ext_vector_type(2)));
template <class Epi, class Sched, bool ALIGN_EPI = false, bool SP2 = false>
__device__ __forceinline__ void gemm_phase(PG8_LAS unsigned char* lds, const Gemm g, const Sched& S, const Epi& E) {
    int tid_l = threadIdx.x; asm volatile("" : "+v"(tid_l)); const int tid = tid_l, wid = __builtin_amdgcn_readfirstlane(tid >> 6), lane = tid & 63, wr = wid >> 2, wc = wid & 3, fr = lane & 15, fq = lane >> 4;
    const int K = g.K, nt = K / BK;
    unsigned voffA[2], voffB[2];
#pragma unroll
    for (int i = 0; i < 2; ++i) { int R, C; stage_rc(tid * 16 + i * 8192, R, C); const int Rb = Epi::PERM ? ((R & ~31) + perm32(R & 31)) : R;
        voffA[i] = (unsigned)(R * K + C) * 2u; voffB[i] = (unsigned)(Rb * K + C) * 2u; }
    const size_t kstep = (size_t)(BK * 2);
    const size_t hstep = (size_t)HALF * K * 2;
    const size_t tstep = 2 * hstep;
    const unsigned ldsw = (unsigned)wid * 1024u;
    const int aoff = lds_byte(wr * 64 + fr, fq * 8), boff = lds_byte(wc * 32 + fr, fq * 8);
#define PG8_SA(b, h) (((b) * 2 + (h)) * HTB)
#define PG8_SB(b, h) ((4 + (b) * 2 + (h)) * HTB)
#define PG8_STAGE(bufoff, gbase, voff) do { _Pragma("unroll") for (int _i = 0; _i < 2; ++_i) \
        __builtin_amdgcn_global_load_lds((const unsigned*)((const char*)(gbase) + (voff)[_i]), (PG8_LAS unsigned*)(lds + (bufoff) + ldsw + _i * 8192), 16, 0, 0); } while (0)
#define PG8_LDA(dst, b, h) do { _Pragma("unroll") for (int m = 0; m < 4; ++m) _Pragma("unroll") for (int k = 0; k < 2; ++k) dst[m][k] = *(const PG8_LAS bf16x8*)(lds + PG8_SA(b, h) + aoff + m * 2048 + k * 1024); } while (0)
#define PG8_LDB(dst, b, h) do { _Pragma("unroll") for (int n = 0; n < 2; ++n) _Pragma("unroll") for (int k = 0; k < 2; ++k) dst[n][k] = *(const PG8_LAS bf16x8*)(lds + PG8_SB(b, h) + boff + n * 2048 + k * 1024); } while (0)
#define PG8_MMA(ai, bj, At, Bt) do { __builtin_amdgcn_s_setprio(1); _Pragma("unroll") for (int m = 0; m < 4; ++m) _Pragma("unroll") for (int n = 0; n < 2; ++n) _Pragma("unroll") for (int k = 0; k < 2; ++k) \
        acc[ai][bj][m][n] = __builtin_amdgcn_mfma_f32_16x16x32_bf16(Bt[n][k], At[m][k], acc[ai][bj][m][n], 0, 0, 0); __builtin_amdgcn_s_setprio(0); } while (0)
#define PG8_WAIT_V(n) asm volatile("s_waitcnt vmcnt(" #n ")" ::: "memory")
#define PG8_WAIT_L(n) asm volatile("s_waitcnt lgkmcnt(" #n ")" ::: "memory")
#define PG8_BAR __builtin_amdgcn_s_barrier()
#define PG8_SCHED __builtin_amdgcn_sched_barrier(0)
    Unit cur, nxt; int ui = 0;
    if (!S.next(0, cur)) return;
    f32x4 acc[2][2][4][2];
#pragma unroll
    for (int a = 0; a < 2; ++a)
#pragma unroll
        for (int b = 0; b < 2; ++b)
#pragma unroll
            for (int m = 0; m < 4; ++m)
#pragma unroll
                for (int n = 0; n < 2; ++n) acc[a][b][m][n] = (f32x4){0.f, 0.f, 0.f, 0.f};
    bf16x8 At[4][2], B0[2][2], B1[2][2];
    const char* cA = (const char*)g.A + (size_t)cur.pm * tstep; const char* cB = (const char*)g.Bt + (size_t)cur.pn * tstep;
    S.a_ready(cur);
    if constexpr (SP2) {
        PG8_STAGE(PG8_SB(0, 0), cB, voffB); PG8_STAGE(PG8_SB(0, 1), cB + hstep, voffB); PG8_STAGE(PG8_SA(0, 0), cA, voffA); PG8_STAGE(PG8_SA(0, 1), cA + hstep, voffA);
        if (wr == 1) PG8_BAR;
        PG8_WAIT_V(2); PG8_BAR;
        PG8_STAGE(PG8_SB(1, 0), cB + kstep, voffB); PG8_STAGE(PG8_SA(1, 0), cA + kstep, voffA); PG8_STAGE(PG8_SB(1, 1), cB + hstep + kstep, voffB);
        PG8_WAIT_V(6); PG8_BAR;
    } else {
        PG8_STAGE(PG8_SB(0, 0), cB, voffB); PG8_STAGE(PG8_SA(0, 0), cA, voffA); PG8_STAGE(PG8_SB(0, 1), cB + hstep, voffB); PG8_STAGE(PG8_SA(0, 1), cA + hstep, voffA);
        if (wr == 1) PG8_BAR;
        PG8_WAIT_V(4); PG8_BAR;
        PG8_STAGE(PG8_SB(1, 0), cB + kstep, voffB); PG8_STAGE(PG8_SA(1, 0), cA + kstep, voffA); PG8_STAGE(PG8_SB(1, 1), cB + hstep + kstep, voffB);
        PG8_WAIT_V(6); PG8_BAR;
    }
    for (;;) {
        const bool has_next = S.next(ui + 1, nxt);
        const char* nA = has_next ? (const char*)g.A + (size_t)nxt.pm * tstep : cA; const char* nB = has_next ? (const char*)g.Bt + (size_t)nxt.pn * tstep : cB;
        for (int t = 0; t < nt; t += 2) {
            const bool last = (t == nt - 2);
            const char* a1 = cA + (size_t)(t + 1) * kstep;
            const char* a2 = last ? nA : cA + (size_t)(t + 2) * kstep; const char* b2 = last ? nB : cB + (size_t)(t + 2) * kstep;
            const char* a3 = a2 + kstep; const char* b3 = b2 + kstep;
            if (last && has_next) S.a_ready(nxt);
            if constexpr (SP2) {
            PG8_LDB(B0, 0, 0); PG8_LDB(B1, 0, 1); PG8_SCHED; PG8_LDA(At, 0, 0); PG8_STAGE(PG8_SA(1, 1), a1 + hstep, voffA);
            PG8_WAIT_V(8); PG8_WAIT_L(0); PG8_BAR; PG8_MMA(0, 0, At, B0); PG8_MMA(0, 1, At, B1); PG8_BAR; PG8_SCHED;
            PG8_LDA(At, 0, 1); PG8_STAGE(PG8_SB(0, 0), b2, voffB); PG8_STAGE(PG8_SB(0, 1), b2 + hstep, voffB); PG8_STAGE(PG8_SA(0, 0), a2, voffA);
            PG8_WAIT_V(8); PG8_WAIT_L(0); PG8_BAR; PG8_MMA(1, 0, At, B0); PG8_MMA(1, 1, At, B1); PG8_BAR; PG8_SCHED;
            PG8_LDB(B0, 1, 0); PG8_LDB(B1, 1, 1); PG8_SCHED; PG8_LDA(At, 1, 0); PG8_STAGE(PG8_SA(0, 1), a2 + hstep, voffA);
            PG8_WAIT_V(8); PG8_WAIT_L(0); PG8_BAR; PG8_MMA(0, 0, At, B0); PG8_MMA(0, 1, At, B1); PG8_BAR; PG8_SCHED;
            PG8_LDA(At, 1, 1); PG8_STAGE(PG8_SB(1, 0), b3, voffB); PG8_STAGE(PG8_SB(1, 1), b3 + hstep, voffB); PG8_STAGE(PG8_SA(1, 0), a3, voffA);
            PG8_WAIT_V(8); PG8_WAIT_L(0); PG8_BAR; PG8_MMA(1, 0, At, B0); PG8_MMA(1, 1, At, B1); PG8_BAR; PG8_SCHED;
            } else {
            PG8_LDB(B0, 0, 0); PG8_SCHED; PG8_LDA(At, 0, 0); PG8_STAGE(PG8_SA(1, 1), a1 + hstep, voffA);
            PG8_WAIT_L(8); PG8_BAR; PG8_WAIT_L(0); PG8_MMA(0, 0, At, B0); PG8_BAR; PG8_SCHED;
            PG8_LDB(B1, 0, 1); PG8_STAGE(PG8_SB(0, 0), b2, voffB);
            PG8_BAR; PG8_WAIT_L(0); PG8_MMA(0, 1, At, B1); PG8_BAR;
            PG8_LDA(At, 0, 1); PG8_STAGE(PG8_SA(0, 0), a2, voffA);
            PG8_BAR; PG8_WAIT_L(0); PG8_MMA(1, 0, At, B0); PG8_BAR; PG8_SCHED;
            PG8_STAGE(PG8_SB(0, 1), b2 + hstep, voffB);
            PG8_WAIT_V(6); PG8_BAR; PG8_MMA(1, 1, At, B1); PG8_BAR;
            PG8_LDB(B0, 1, 0); PG8_SCHED; PG8_LDA(At, 1, 0); PG8_STAGE(PG8_SA(0, 1), a2 + hstep, voffA);
            PG8_WAIT_L(8); PG8_BAR; PG8_WAIT_L(0); PG8_MMA(0, 0, At, B0); PG8_BAR; PG8_SCHED;
            PG8_LDB(B1, 1, 1); PG8_STAGE(PG8_SB(1, 0), b3, voffB);
            PG8_BAR; PG8_WAIT_L(0); PG8_MMA(0, 1, At, B1); PG8_BAR;
            PG8_LDA(At, 1, 1); PG8_STAGE(PG8_SA(1, 0), a3, voffA);
            PG8_BAR; PG8_WAIT_L(0); PG8_MMA(1, 0, At, B0); PG8_BAR; PG8_SCHED;
            PG8_STAGE(PG8_SB(1, 1), b3 + hstep, voffB);
            PG8_WAIT_V(6); PG8_BAR; PG8_MMA(1, 1, At, B1); PG8_BAR;
            }
        }
        if constexpr (ALIGN_EPI) { if (wr == 0) PG8_BAR; }
        if constexpr (!Epi::AFTER_DRAIN) { E(acc, cur, wr, wc, fr, fq); S.done(cur); }
        if (!has_next) break;
#pragma unroll
        for (int a = 0; a < 2; ++a)
#pragma unroll
            for (int b = 0; b < 2; ++b)
#pragma unroll
                for (int m = 0; m < 4; ++m)
#pragma unroll
                    for (int n = 0; n < 2; ++n) acc[a][b][m][n] = (f32x4){0.f, 0.f, 0.f, 0.f};
        cur = nxt; cA = nA; cB = nB; ++ui;
        if constexpr (ALIGN_EPI) { if (wr == 1) PG8_BAR; }
    }
    PG8_WAIT_V(0);
    if constexpr (!ALIGN_EPI) { if (wr == 0) PG8_BAR; }
    PG8_BAR;
    if constexpr (Epi::AFTER_DRAIN) { E.fused(acc, cur, wr, wc, fr, fq, lds, wid, lane); S.done(cur); }
#undef PG8_SA
#undef PG8_SB
#undef PG8_STAGE
#undef PG8_LDA
#undef PG8_LDB
#undef PG8_MMA
#undef PG8_WAIT_V
#undef PG8_WAIT_L
#undef PG8_BAR
#undef PG8_SCHED
}
}

#define LAS __attribute__((address_space(3)))
typedef unsigned short bf16_t;
typedef short bf16x8 __attribute__((ext_vector_type(8)));
typedef float f32x2 __attribute__((ext_vector_type(2)));
typedef float f32x4 __attribute__((ext_vector_type(4)));
typedef float f32x16 __attribute__((ext_vector_type(16)));
typedef unsigned u32x2 __attribute__((ext_vector_type(2)));
typedef unsigned u32x4 __attribute__((ext_vector_type(4)));
typedef __bf16 bf16x2_t __attribute__((ext_vector_type(2)));

constexpr int S = 16384, D = 2048, NLAYER = 2, HLD = 4096, DFF = 5632, INC = 3904;
constexpr int C_CQ = 0, C_CKV = 512, C_KR = 768, C_MQ = 832, C_MK = 1344, C_MV = 1856, C_CONV = 2368, C_POOL = 3392;
constexpr float EPS = 1e-5f, ALPHA = 1.41421356237309515f, LOG2E = 1.4426950408889634f;
constexpr float CQ_SCALE = 0.07216878364870323f * LOG2E;
constexpr float CM_SCALE = 0.08838834764831845f * LOG2E;
constexpr int NT = 512, NWV = 8;
constexpr float KM_FIX = 1048576.f, KM_INV = 1.f / 1048576.f;
constexpr int LDS_BYTES = 147456, LDS_MISC = 131072;

constexpr size_t MiB = (size_t)1 << 20;
constexpr size_t WS_CTL = 0, CTL_BYTES = 1 * MiB;
constexpr size_t WS_WIN = 1 * MiB, WS_WUQ = 17 * MiB, WS_WUKV = 18 * MiB, WS_WPW = 19 * MiB, WS_WPOOL = 20 * MiB, WS_WOUT = 21 * MiB, WS_WGU = 29 * MiB, WS_WDN = 73 * MiB;
constexpr size_t WS_ROPE_MLA = 95 * MiB, WS_ROPE_MOBA = 99 * MiB, WS_STATS = 101 * MiB;
constexpr size_t WS_Y = 102 * MiB, WS_XB = 230 * MiB;
constexpr size_t WS_CQN = 230 * MiB, WS_CKVN = 246 * MiB, WS_KPE = 254 * MiB, WS_CONVA = 256 * MiB, WS_POOLED = 272 * MiB;
constexpr size_t WS_H = 294 * MiB;
constexpr size_t WS_Q = 294 * MiB, WS_K = 318 * MiB, WS_VT = 342 * MiB, WS_CONCAT = 358 * MiB;
constexpr size_t WS_MQ = 422 * MiB, WS_MK = 438 * MiB, WS_MVT = 454 * MiB;
constexpr size_t WS_VR = 470 * MiB;
constexpr size_t WS_ACT = 294 * MiB, WS_END = 486 * MiB;
constexpr int CW_LAYER = 33792, CW_QCTR = 0, CW_KPEMAX = 1, CW_KNPIECE = 4, CW_KMMAX = 20, CW_CNT = 64, CW_KMEAN = 1024;

constexpr size_t DO_PART = 0, DO_PL = 34 * MiB, DO_PARTB = 36 * MiB, DO_LB = 101 * MiB, DO_LIST = 104 * MiB;

struct Params { const float* in[22]; float* out; unsigned char* ws; };

__device__ __forceinline__ unsigned f2bf(float f) { unsigned u = __float_as_uint(f); return (u + 0x7fffu + ((u >> 16) & 1u)) >> 16; }
__device__ __forceinline__ float bf2f(unsigned h) { return __uint_as_float(h << 16); }
__device__ __forceinline__ unsigned pk2(float lo, float hi) { f32x2 v = {lo, hi}; bf16x2_t b = __builtin_convertvector(v, bf16x2_t); return __builtin_bit_cast(unsigned, b); }
__device__ __forceinline__ float wave_sum(float v) {
#pragma unroll
    for (int o = 1; o < 64; o <<= 1) v += __shfl_xor(v, o);
    return v;
}
__device__ __forceinline__ float sigmoidf_(float x) { return __builtin_amdgcn_rcpf(1.f + __expf(-x)); }

typedef const pg8::f32x4 (&AccRef)[2][2][4][2];

struct EpiStore {
    static constexpr bool PERM = true, AFTER_DRAIN = false;
    bf16_t* O; int ldc;
    __device__ __forceinline__ void operator()(AccRef acc, const pg8::Unit& u, int wr, int wc, int fr, int fq) const {
        const int row0 = u.pm * 256 + wr * 64 + fr, col0 = u.pn * 256 + wc * 32 + 8 * fq;
#pragma unroll
        for (int ai = 0; ai < 2; ++ai)
#pragma unroll
            for (int m = 0; m < 4; ++m) { bf16_t* rowp = O + (size_t)(row0 + ai * 128 + m * 16) * ldc + col0;
#pragma unroll
                for (int bj = 0; bj < 2; ++bj) { const f32x4 v0 = acc[ai][bj][m][0], v1 = acc[ai][bj][m][1];
                    u32x4 w; w.x = pk2(v0[0], v0[1]); w.y = pk2(v0[2], v0[3]); w.z = pk2(v1[0], v1[1]); w.w = pk2(v1[2], v1[3]);
                    *(u32x4*)(rowp + bj * 128) = w; } }
    }
};

struct EpiQ {
    static constexpr bool PERM = true, AFTER_DRAIN = false;
    bf16_t* O; const float* rope;
    __device__ __forceinline__ void operator()(AccRef acc, const pg8::Unit& u, int wr, int wc, int fr, int fq) const {
        const int row0 = u.pm * 256 + wr * 64 + fr;
#pragma unroll
        for (int bj = 0; bj < 2; ++bj) {
            const int c0 = u.pn * 256 + bj * 128 + wc * 32 + 8 * fq; const int d0 = c0 % 192; const bool rp = d0 >= 128; const int jc = rp ? (d0 - 128) >> 1 : 0;
#pragma unroll
            for (int ai = 0; ai < 2; ++ai)
#pragma unroll
                for (int m = 0; m < 4; ++m) { const int row = row0 + ai * 128 + m * 16;
                    f32x4 v0 = acc[ai][bj][m][0] * CQ_SCALE, v1 = acc[ai][bj][m][1] * CQ_SCALE;
                    const f32x4 t0 = *(const f32x4*)(rope + ((size_t)row * 32 + jc) * 2), t1 = *(const f32x4*)(rope + ((size_t)row * 32 + jc + 2) * 2);
                    if (rp) {
                        f32x4 a, b;
                        a[0] = v0[0] * t0[0] - v0[1] * t0[1]; a[1] = v0[0] * t0[1] + v0[1] * t0[0];
                        a[2] = v0[2] * t0[2] - v0[3] * t0[3]; a[3] = v0[2] * t0[3] + v0[3] * t0[2];
                        b[0] = v1[0] * t1[0] - v1[1] * t1[1]; b[1] = v1[0] * t1[1] + v1[1] * t1[0];
                        b[2] = v1[2] * t1[2] - v1[3] * t1[3]; b[3] = v1[2] * t1[3] + v1[3] * t1[2];
                        v0 = a; v1 = b; }
                    u32x4 w; w.x = pk2(v0[0], v0[1]); w.y = pk2(v0[2], v0[3]); w.z = pk2(v1[0], v1[1]); w.w = pk2(v1[2], v1[3]);
                    *(u32x4*)(O + (size_t)row * 768 + c0) = w; }
        }
    }
};

struct EpiKV {
    static constexpr bool PERM = true, AFTER_DRAIN = false;
    bf16_t* K; bf16_t* VR; const bf16_t* KPE; unsigned* piece;
    __device__ __forceinline__ void operator()(AccRef acc, const pg8::Unit& u, int wr, int wc, int fr, int fq) const {
        const int row0 = u.pm * 256 + wr * 64 + fr, cc = wc * 32 + 8 * fq, hd = u.pn;
        float pmax = 0.f;
#pragma unroll
        for (int ai = 0; ai < 2; ++ai)
#pragma unroll
            for (int m = 0; m < 4; ++m) { const int row = row0 + ai * 128 + m * 16;
                { const f32x4 v0 = acc[ai][0][m][0], v1 = acc[ai][0][m][1];
                  u32x4 w; w.x = pk2(v0[0], v0[1]); w.y = pk2(v0[2], v0[3]); w.z = pk2(v1[0], v1[1]); w.w = pk2(v1[2], v1[3]);
                  *(u32x4*)(K + (size_t)row * 768 + hd * 192 + cc) = w;
                  float ss = (v0[0] * v0[0] + v0[1] * v0[1]) + (v0[2] * v0[2] + v0[3] * v0[3]) + (v1[0] * v1[0] + v1[1] * v1[1]) + (v1[2] * v1[2] + v1[3] * v1[3]);
                  ss += __shfl_xor(ss, 16); ss += __shfl_xor(ss, 32); pmax = fmaxf(pmax, ss); }
                { const f32x4 v0 = acc[ai][1][m][0], v1 = acc[ai][1][m][1];
                  u32x4 w; w.x = pk2(v0[0], v0[1]); w.y = pk2(v0[2], v0[3]); w.z = pk2(v1[0], v1[1]); w.w = pk2(v1[2], v1[3]);
                  *(u32x4*)(VR + (size_t)row * 512 + hd * 128 + cc) = w; }
                }
        if (wc < 2) { u32x4 kp[8];
#pragma unroll
            for (int q8 = 0; q8 < 8; ++q8) kp[q8] = *(const u32x4*)(KPE + (size_t)(row0 + (q8 >> 2) * 128 + (q8 & 3) * 16) * 64 + cc);
#pragma unroll
            for (int q8 = 0; q8 < 8; ++q8) *(u32x4*)(K + (size_t)(row0 + (q8 >> 2) * 128 + (q8 & 3) * 16) * 768 + hd * 192 + 128 + cc) = kp[q8]; }
#pragma unroll
        for (int o = 1; o < 16; o <<= 1) pmax = fmaxf(pmax, __shfl_xor(pmax, o));
        if ((threadIdx.x & 63) == 0) atomicMax(piece + hd * 4 + wc, __float_as_uint(pmax));
    }
};
__device__ __forceinline__ void vt_tile(const bf16_t* VR, bf16_t* VT, int pm, int pn) {
    int tid = threadIdx.x; asm volatile("" : "+v"(tid));
    const int dv = tid & 127, seg = tid >> 7; const int t0 = 256 * pm + 64 * seg;
    const bf16_t* src = VR + (size_t)t0 * 512 + pn * 128 + dv; unsigned pk[32];
#pragma unroll
    for (int i = 0; i < 32; ++i) pk[i] = (unsigned)src[(size_t)(2 * i) * 512] | ((unsigned)src[(size_t)(2 * i + 1) * 512] << 16);
    u32x4* dst = (u32x4*)(VT + (size_t)(pn * 128 + dv) * S + t0);
#pragma unroll
    for (int i = 0; i < 8; ++i) dst[i] = (u32x4){pk[4 * i], pk[4 * i + 1], pk[4 * i + 2], pk[4 * i + 3]};
}

template <int MODE>
struct EpiRes {
    static constexpr bool PERM = true, AFTER_DRAIN = false;
    const float* xin; bf16_t* Y; const float* stats; const float* g; const float* b;
    __device__ __forceinline__ void operator()(AccRef acc, const pg8::Unit& u, int wr, int wc, int fr, int fq) const {
        const int row0 = u.pm * 256 + wr * 64 + fr, col0 = u.pn * 256 + wc * 32 + 8 * fq;
#pragma unroll
        for (int bj = 0; bj < 2; ++bj) { const int col = col0 + bj * 128;
            f32x4 g0, g1, b0, b1;
            if (MODE == 1) { g0 = *(const f32x4*)(g + col); g1 = *(const f32x4*)(g + col + 4); b0 = *(const f32x4*)(b + col); b1 = *(const f32x4*)(b + col + 4); }
#pragma unroll
            for (int ai = 0; ai < 2; ++ai)
#pragma unroll
                for (int m = 0; m < 4; ++m) { const int row = row0 + ai * 128 + m * 16; const size_t off = (size_t)row * D + col;
                    f32x4 r0, r1;
                    if (MODE == 0) { r0 = *(const f32x4*)(xin + off); r1 = *(const f32x4*)(xin + off + 4); }
                    else { const f32x2 st = *(const f32x2*)(stats + (size_t)row * 2); const u32x4 raw = *(const u32x4*)(Y + off);
                        r0 = (f32x4){bf2f(raw.x & 0xffffu), bf2f(raw.x >> 16), bf2f(raw.y & 0xffffu), bf2f(raw.y >> 16)}; r1 = (f32x4){bf2f(raw.z & 0xffffu), bf2f(raw.z >> 16), bf2f(raw.w & 0xffffu), bf2f(raw.w >> 16)};
                        r0 = (r0 - st.x) * st.y * g0 + b0; r1 = (r1 - st.x) * st.y * g1 + b1; }
                    r0 = r0 * ALPHA + acc[ai][bj][m][0]; r1 = r1 * ALPHA + acc[ai][bj][m][1];
                    u32x4 w; w.x = pk2(r0[0], r0[1]); w.y = pk2(r0[2], r0[3]); w.z = pk2(r1[0], r1[1]); w.w = pk2(r1[2], r1[3]);
                    *(u32x4*)(Y + off) = w; }
        }
    }
};

struct EpiFfn {
    static constexpr bool PERM = true, AFTER_DRAIN = false;
    bf16_t* O;
    __device__ __forceinline__ void operator()(AccRef acc, const pg8::Unit& u, int wr, int wc, int fr, int fq) const {
        const int row0 = u.pm * 256 + wr * 64 + fr, col0 = u.pn * 128 + wc * 32 + 8 * fq;
#pragma unroll
        for (int ai = 0; ai < 2; ++ai)
#pragma unroll
            for (int m = 0; m < 4; ++m) { const int row = row0 + ai * 128 + m * 16;
                float r[8];
#pragma unroll
                for (int n = 0; n < 2; ++n)
#pragma unroll
                    for (int e = 0; e < 4; ++e) { const float gt = acc[ai][0][m][n][e], up = acc[ai][1][m][n][e]; r[n * 4 + e] = gt * sigmoidf_(gt) * up; }
                u32x4 w; w.x = pk2(r[0], r[1]); w.y = pk2(r[2], r[3]); w.z = pk2(r[4], r[5]); w.w = pk2(r[6], r[7]);
                *(u32x4*)(O + (size_t)row * DFF + col0) = w; }
    }
};

#define GEMM_CALL(EPIT, E, A_, B_, N_, K_, CID) do { pg8::Gemm g_{(const bf16_t*)(A_), (const bf16_t*)(B_), S, (N_), (K_)}; pg8::StaticOrder so_; so_.init(S, (N_), G, (CID)); \
    pg8::gemm_phase<EPIT, pg8::StaticOrder, true, true>(lds, g_, so_, (E)); } while (0)

struct TrSpec { const float* W; int ldn, K, N; bf16_t* WT; int ldk, mode; const float* sk; const float* sn; };
__device__ __forceinline__ int drow_of(int mode, int n) {
    if (mode == 1) { const int hd = n / 192, d = n - hd * 192; if (d < 128) return n; const int e = d - 128; return hd * 192 + 128 + 2 * (e & 31) + (e >> 5); }
    if (mode == 4) return ((n >> 7) << 8) + (n & 127);
    if (mode == 5) return ((n >> 7) << 8) + 128 + (n & 127);
    return n;
}
__device__ __forceinline__ void transpose_items(const TrSpec& t, LAS float* scr, int gw, int ngw, int lane) {
    const int nblk = t.N / 32, nitems = (t.K / 64) * nblk;
    for (int it = gw; it < nitems; it += ngw) {
        const int kb = it / nblk, nb = it - kb * nblk, k0 = 64 * kb, n0 = 32 * nb;
        const float snv = t.sn ? t.sn[n0 + (lane & 31)] : 1.f;
        const float* wp = t.W + (size_t)(k0 + (lane >> 5)) * t.ldn + n0 + (lane & 31);
        if (t.sk) { const float* skp = t.sk + k0 + (lane >> 5);
#pragma unroll 8
            for (int i = 0; i < 32; ++i) { const float v = wp[(size_t)(2 * i) * t.ldn] * skp[2 * i]; scr[(2 * i + (lane >> 5)) * 33 + (lane & 31)] = v * snv; } }
        else {
#pragma unroll 8
            for (int i = 0; i < 32; ++i) { const float v = wp[(size_t)(2 * i) * t.ldn]; scr[(2 * i + (lane >> 5)) * 33 + (lane & 31)] = v * snv; } }
        asm volatile("s_waitcnt lgkmcnt(0)" ::: "memory");
        const int c = lane & 7;
#pragma unroll
        for (int j = 0; j < 4; ++j) { const int n = (lane >> 3) + 8 * j; const LAS float* s = scr + (8 * c) * 33 + n;
            u32x4 o; o.x = pk2(s[0 * 33], s[1 * 33]); o.y = pk2(s[2 * 33], s[3 * 33]); o.z = pk2(s[4 * 33], s[5 * 33]); o.w = pk2(s[6 * 33], s[7 * 33]);
            *(u32x4*)(t.WT + (size_t)drow_of(t.mode, n0 + n) * t.ldk + k0 + 8 * c) = o; }
        asm volatile("s_waitcnt lgkmcnt(0)" ::: "memory");
    }
}
__device__ __forceinline__ void prep_weights(const Params& P, int l, LAS unsigned char* lds, int G) {
    int tid_l = threadIdx.x; asm volatile("" : "+v"(tid_l)); const int tid = tid_l, lane = tid & 63, wave = tid >> 6;
    const int gw = blockIdx.x * NWV + wave, ngw = G * NWV;
    LAS float* scr = (LAS float*)(lds + wave * 16384);
    unsigned char* ws = P.ws;
    TrSpec t;
    t = TrSpec{P.in[2] + (size_t)l * D * INC, INC, D, INC, (bf16_t*)(ws + WS_WIN), D, 0, nullptr, nullptr}; transpose_items(t, scr, gw, ngw, lane);
    t = TrSpec{P.in[4] + (size_t)l * 512 * 768, 768, 512, 768, (bf16_t*)(ws + WS_WUQ), 512, 1, P.in[3] + l * 512, nullptr}; transpose_items(t, scr, gw, ngw, lane);
    t = TrSpec{P.in[6] + (size_t)l * 256 * 1024, 1024, 256, 1024, (bf16_t*)(ws + WS_WUKV), 256, 0, P.in[5] + l * 256, nullptr}; transpose_items(t, scr, gw, ngw, lane);
    t = TrSpec{P.in[11] + (size_t)l * 512 * 512, 512, 512, 512, (bf16_t*)(ws + WS_WPW), 512, 0, nullptr, nullptr}; transpose_items(t, scr, gw, ngw, lane);
#pragma unroll 1
    for (int g = 0; g < 4; ++g) { t = TrSpec{P.in[12] + (size_t)(l * 4 + g) * 128 * 128, 128, 128, 128, (bf16_t*)(ws + WS_WPOOL) + (size_t)(g * 128) * 512 + g * 128, 512, 0, nullptr, P.in[13] + l * 512 + g * 128};
        transpose_items(t, scr, gw, ngw, lane); }
    t = TrSpec{P.in[14] + (size_t)l * D * D, D, D, D, (bf16_t*)(ws + WS_WOUT), D, 0, nullptr, nullptr}; transpose_items(t, scr, gw, ngw, lane);
    t = TrSpec{P.in[17] + (size_t)l * D * DFF, DFF, D, DFF, (bf16_t*)(ws + WS_WGU), D, 4, nullptr, nullptr}; transpose_items(t, scr, gw, ngw, lane);
    t = TrSpec{P.in[18] + (size_t)l * D * DFF, DFF, D, DFF, (bf16_t*)(ws + WS_WGU), D, 5, nullptr, nullptr}; transpose_items(t, scr, gw, ngw, lane);
    t = TrSpec{P.in[19] + (size_t)l * DFF * D, D, DFF, D, (bf16_t*)(ws + WS_WDN), DFF, 0, nullptr, nullptr}; transpose_items(t, scr, gw, ngw, lane);
    const int gt = blockIdx.x * NT + tid, ngt = G * NT; const u32x4 z = {0u, 0u, 0u, 0u};
    { u32x4* p = (u32x4*)((bf16_t*)(ws + WS_WIN) + (size_t)INC * D); for (int i = gt; i < 192 * D / 8; i += ngt) p[i] = z; }
    { u32x4* p = (u32x4*)(ws + WS_WPOOL); for (int i = gt; i < 512 * 512 / 8; i += ngt) { const int row = i >> 6, col = (i & 63) * 8; if ((row >> 7) != (col >> 7)) p[i] = z; } }
}
__device__ __forceinline__ void prep_layer0(const Params& P, int G) {
    int tid_l = threadIdx.x; asm volatile("" : "+v"(tid_l)); const int gt = blockIdx.x * NT + tid_l, ngt = G * NT;
    const f32x4* x4 = (const f32x4*)P.in[0]; u32x4* xb = (u32x4*)(P.ws + WS_XB);
    for (int i = gt; i < S * D / 8; i += ngt) { const f32x4 a = x4[2 * i], b = x4[2 * i + 1]; u32x4 w; w.x = pk2(a[0], a[1]); w.y = pk2(a[2], a[3]); w.z = pk2(b[0], b[1]); w.w = pk2(b[2], b[3]); xb[i] = w; }
    const int* pos = (const int*)P.in[1];
    f32x2* rm = (f32x2*)(P.ws + WS_ROPE_MLA); f32x2* ro = (f32x2*)(P.ws + WS_ROPE_MOBA);
    const double L2T = 18.931568569324174;
    for (int i = gt; i < S * 48; i += ngt) { const int t = i / 48, jj = i - t * 48; const bool mla = jj < 32; const int j = mla ? jj : jj - 32;
        const double invf = exp2(-(mla ? (double)j / 32.0 : (double)j / 16.0) * L2T);
        const double rev = (double)pos[t] * invf * 0.15915494309189535; const float fr = (float)(rev - rint(rev));
        const f32x2 cs = {__builtin_amdgcn_cosf(fr), __builtin_amdgcn_sinf(fr)};
        if (mla) rm[t * 32 + j] = cs; else ro[t * 16 + j] = cs; }
}

template <bool TO_OUT> __device__ __forceinline__ void ln_phase(const bf16_t* __restrict__ Y, const float* __restrict__ g, const float* __restrict__ b, float* __restrict__ stats, bf16_t* __restrict__ XB, float* __restrict__ out, int G, float chkoff = 0.f) {
    int tid_l = threadIdx.x; asm volatile("" : "+v"(tid_l)); const int lane = tid_l & 63, wave = tid_l >> 6;
#pragma unroll 2
    for (int row = blockIdx.x * NWV + wave; row < S; row += G * NWV) {
        const u32x4* yr = (const u32x4*)(Y + (size_t)row * D) + lane; float v[4][8]; float s = 0.f;
#pragma unroll
        for (int j = 0; j < 4; ++j) { const u32x4 raw = yr[64 * j];
            v[j][0] = bf2f(raw.x & 0xffffu); v[j][1] = bf2f(raw.x >> 16); v[j][2] = bf2f(raw.y & 0xffffu); v[j][3] = bf2f(raw.y >> 16); v[j][4] = bf2f(raw.z & 0xffffu); v[j][5] = bf2f(raw.z >> 16); v[j][6] = bf2f(raw.w & 0xffffu); v[j][7] = bf2f(raw.w >> 16);
#pragma unroll
            for (int e = 0; e < 8; ++e) s += v[j][e]; }
        const float mean = wave_sum(s) * (1.f / D); float s2 = 0.f;
#pragma unroll
        for (int j = 0; j < 4; ++j)
#pragma unroll
            for (int e = 0; e < 8; ++e) { v[j][e] -= mean; s2 += v[j][e] * v[j][e]; }
        const float rstd = rsqrtf(wave_sum(s2) * (1.f / D) + EPS);
        if (!TO_OUT && lane == 0) *(f32x2*)(stats + (size_t)row * 2) = (f32x2){mean, rstd};
#pragma unroll
        for (int j = 0; j < 4; ++j) { const int col = 8 * (lane + 64 * j); const f32x4 g0 = *(const f32x4*)(g + col), g1 = *(const f32x4*)(g + col + 4), b0 = *(const f32x4*)(b + col), b1 = *(const f32x4*)(b + col + 4);
            f32x4 o0 = (f32x4){v[j][0], v[j][1], v[j][2], v[j][3]} * rstd * g0 + b0, o1 = (f32x4){v[j][4], v[j][5], v[j][6], v[j][7]} * rstd * g1 + b1;
            if (TO_OUT) { *(f32x4*)(out + (size_t)row * D + col) = o0 + chkoff; *(f32x4*)(out + (size_t)row * D + col + 4) = o1 + chkoff; }
            else { u32x4 w; w.x = pk2(o0[0], o0[1]); w.y = pk2(o0[2], o0[3]); w.z = pk2(o1[0], o1[1]); w.w = pk2(o1[2], o1[3]); *(u32x4*)(XB + (size_t)row * D + col) = w; } }
    }
}

__device__ __forceinline__ void p2a_phase(const Params& P, int l, LAS unsigned char* lds, int G) {
    int tid_l = threadIdx.x; asm volatile("" : "+v"(tid_l)); const int tid = tid_l, lane = tid & 63, wave = tid >> 6;
    unsigned char* ws = P.ws;
    const bf16_t* H = (const bf16_t*)(ws + WS_H);
    unsigned* ctl = (unsigned*)(ws + WS_CTL) + l * CW_LAYER;
    bf16_t* CQN = (bf16_t*)(ws + WS_CQN); bf16_t* CKVN = (bf16_t*)(ws + WS_CKVN); bf16_t* KPE = (bf16_t*)(ws + WS_KPE);
    bf16_t* CONVA = (bf16_t*)(ws + WS_CONVA); bf16_t* POOLED = (bf16_t*)(ws + WS_POOLED);
    bf16_t* MQ = (bf16_t*)(ws + WS_MQ); bf16_t* MK = (bf16_t*)(ws + WS_MK); bf16_t* MVT = (bf16_t*)(ws + WS_MVT);
    const f32x2* RM = (const f32x2*)(ws + WS_ROPE_MLA); const float* RO = (const float*)(ws + WS_ROPE_MOBA);
    LAS float* ybuf = (LAS float*)lds;
    for (int tile = blockIdx.x; tile < S / 64; tile += G) {
        const int t0 = tile * 64;
        { float ksum[8]; float kpemax = 0.f, kmmax = 0.f; const int hm = lane & 15;
#pragma unroll
          for (int e = 0; e < 8; ++e) ksum[e] = 0.f;
          struct TokIn { u32x4 cq, mq, mk; u32x2 ckv; unsigned kr1, kr2; f32x2 cs; f32x4 ro[4]; };
#define P2A_LOAD(dst, tt) do { const bf16_t* hr_ = H + (size_t)(tt) * HLD; (dst).cq = *(const u32x4*)(hr_ + C_CQ + 8 * lane); (dst).ckv = *(const u32x2*)(hr_ + C_CKV + 4 * lane); \
              (dst).kr1 = hr_[C_KR + (lane & 31)]; (dst).kr2 = hr_[C_KR + 32 + (lane & 31)]; (dst).cs = RM[(tt) * 32 + (lane & 31)]; (dst).mq = *(const u32x4*)(hr_ + C_MQ + 8 * lane); (dst).mk = *(const u32x4*)(hr_ + C_MK + 8 * lane); \
              const f32x4* tp_ = (const f32x4*)(RO + ((size_t)(tt) * 16 + 8 * (hm & 1)) * 2); (dst).ro[0] = tp_[0]; (dst).ro[1] = tp_[1]; (dst).ro[2] = tp_[2]; (dst).ro[3] = tp_[3]; } while (0)
          TokIn cur, nxt; P2A_LOAD(cur, t0 + wave * 8); nxt = cur;
#pragma unroll 1
          for (int i = 0; i < 8; ++i) {
              const int t = t0 + wave * 8 + i;
              if (i + 1 < 8) P2A_LOAD(nxt, t + 1);
              { const u32x4 raw = cur.cq; float x[8];
                x[0] = bf2f(raw.x & 0xffffu); x[1] = bf2f(raw.x >> 16); x[2] = bf2f(raw.y & 0xffffu); x[3] = bf2f(raw.y >> 16); x[4] = bf2f(raw.z & 0xffffu); x[5] = bf2f(raw.z >> 16); x[6] = bf2f(raw.w & 0xffffu); x[7] = bf2f(raw.w >> 16);
                float ss = 0.f;
#pragma unroll
                for (int e = 0; e < 8; ++e) ss += x[e] * x[e];
                const float rs = rsqrtf(wave_sum(ss) * (1.f / 512.f) + EPS);
                u32x4 w; w.x = pk2(x[0] * rs, x[1] * rs); w.y = pk2(x[2] * rs, x[3] * rs); w.z = pk2(x[4] * rs, x[5] * rs); w.w = pk2(x[6] * rs, x[7] * rs);
                *(u32x4*)(CQN + (size_t)t * 512 + 8 * lane) = w; }
              { const u32x2 raw = cur.ckv; float x[4];
                x[0] = bf2f(raw.x & 0xffffu); x[1] = bf2f(raw.x >> 16); x[2] = bf2f(raw.y & 0xffffu); x[3] = bf2f(raw.y >> 16);
                const float ss = (x[0] * x[0] + x[1] * x[1]) + (x[2] * x[2] + x[3] * x[3]);
                const float rs = rsqrtf(wave_sum(ss) * (1.f / 256.f) + EPS);
                u32x2 w; w.x = pk2(x[0] * rs, x[1] * rs); w.y = pk2(x[2] * rs, x[3] * rs);
                *(u32x2*)(CKVN + (size_t)t * 256 + 4 * lane) = w; }
              { const int j = lane & 31; const float x1 = bf2f(cur.kr1), x2 = bf2f(cur.kr2); const f32x2 cs = cur.cs;
                const float o1 = x1 * cs.x - x2 * cs.y, o2 = x1 * cs.y + x2 * cs.x;
                if (lane < 32) *(unsigned*)(KPE + (size_t)t * 64 + 2 * j) = pk2(o1, o2);
                const float n2 = wave_sum(lane < 32 ? o1 * o1 + o2 * o2 : 0.f); kpemax = fmaxf(kpemax, n2); }
#pragma unroll
              for (int which = 0; which < 2; ++which) {
                  const u32x4 raw = which ? cur.mk : cur.mq; float x[8], px[8];
                  x[0] = bf2f(raw.x & 0xffffu); x[1] = bf2f(raw.x >> 16); x[2] = bf2f(raw.y & 0xffffu); x[3] = bf2f(raw.y >> 16); x[4] = bf2f(raw.z & 0xffffu); x[5] = bf2f(raw.z >> 16); x[6] = bf2f(raw.w & 0xffffu); x[7] = bf2f(raw.w >> 16);
#pragma unroll
                  for (int e = 0; e < 8; ++e) px[e] = __shfl_xor(x[e], 2);
                  if (hm < 4) {
#pragma unroll
                      for (int e2 = 0; e2 < 4; ++e2) { const f32x4 cs = cur.ro[e2];
                          if (hm < 2) { x[2 * e2] = x[2 * e2] * cs[0] - px[2 * e2] * cs[1]; x[2 * e2 + 1] = x[2 * e2 + 1] * cs[2] - px[2 * e2 + 1] * cs[3]; }
                          else { x[2 * e2] = px[2 * e2] * cs[1] + x[2 * e2] * cs[0]; x[2 * e2 + 1] = px[2 * e2 + 1] * cs[3] + x[2 * e2 + 1] * cs[2]; } } }
                  if (which == 0) { u32x4 w; w.x = pk2(x[0] * CM_SCALE, x[1] * CM_SCALE); w.y = pk2(x[2] * CM_SCALE, x[3] * CM_SCALE); w.z = pk2(x[4] * CM_SCALE, x[5] * CM_SCALE); w.w = pk2(x[6] * CM_SCALE, x[7] * CM_SCALE);
                      *(u32x4*)(MQ + (size_t)t * 512 + 8 * lane) = w; }
                  else { u32x4 w; w.x = pk2(x[0], x[1]); w.y = pk2(x[2], x[3]); w.z = pk2(x[4], x[5]); w.w = pk2(x[6], x[7]);
                      *(u32x4*)(MK + (size_t)t * 512 + 8 * lane) = w;
                      float n2 = 0.f;
#pragma unroll
                      for (int e = 0; e < 8; ++e) { ksum[e] += x[e]; n2 += x[e] * x[e]; }
                      n2 += __shfl_xor(n2, 1); n2 += __shfl_xor(n2, 2); n2 += __shfl_xor(n2, 4); n2 += __shfl_xor(n2, 8); kmmax = fmaxf(kmmax, n2); }
              }
              cur = nxt;
          }
#undef P2A_LOAD
          { LAS f32x4* kr = (LAS f32x4*)(ybuf + wave * 512 + 8 * lane); kr[0] = (f32x4){ksum[0], ksum[1], ksum[2], ksum[3]}; kr[1] = (f32x4){ksum[4], ksum[5], ksum[6], ksum[7]}; }
          if (lane == 0) ybuf[4096 + wave * 8 + 4] = kpemax;
          if (hm == 0) ybuf[4096 + wave * 8 + (lane >> 4)] = kmmax;
          __syncthreads();
          { float a = 0.f;
#pragma unroll
            for (int w8 = 0; w8 < 8; ++w8) a += ybuf[w8 * 512 + tid];
            atomicAdd((int*)(ctl + CW_KMEAN) + ((size_t)((tid >> 7) * 64 + (t0 >> 8)) * 128 + (tid & 127)), __float2int_rn(a * KM_FIX));
            if (tid < 5) { float m = 0.f;
#pragma unroll
                for (int w8 = 0; w8 < 8; ++w8) m = fmaxf(m, ybuf[4096 + w8 * 8 + tid]);
                atomicMax(ctl + (tid == 4 ? CW_KPEMAX : CW_KMMAX + tid), __float_as_uint(m)); } }
          __syncthreads(); }
#ifdef REP_P2A_C
#pragma unroll 1
        for (int rep_ = 0; rep_ < 2; ++rep_)
#endif
        { const int c = tid;
          { const bf16_t* src = H + (size_t)t0 * HLD + C_MV + c; unsigned pk[32];
#pragma unroll
            for (int i = 0; i < 32; ++i) pk[i] = (unsigned)src[(size_t)(2 * i) * HLD] | ((unsigned)src[(size_t)(2 * i + 1) * HLD] << 16);
            u32x4* dst = (u32x4*)(MVT + (size_t)c * S + t0);
#pragma unroll
            for (int i = 0; i < 8; ++i) dst[i] = (u32x4){pk[4 * i], pk[4 * i + 1], pk[4 * i + 2], pk[4 * i + 3]}; }
          { const bf16_t* src = H + C_POOL + c; float uv[80];
#pragma unroll
            for (int i0 = 0; i0 < 80; i0 += 16) { const bf16_t* p = src + (ptrdiff_t)(t0 - 16) * HLD;
#pragma unroll
                for (int i = 0; i < 16; ++i) { const float u_ = bf2f(p[(ptrdiff_t)(i0 + i) * HLD]); uv[i0 + i] = t0 - 16 + i0 + i >= 0 ? u_ : 0.f; }
                asm volatile("" ::: "memory"); }
#define P2A_POOL(W) do { float s_ = 0.f; _Pragma("unroll") for (int i = 16 - (W); i < 16; ++i) s_ += uv[i]; \
              _Pragma("unroll") for (int i = 0; i < 64; ++i) { const int t_ = t0 + i; s_ += uv[16 + i] - uv[16 + i - (W)]; const float cnt_ = (float)(t_ + 1 < (W) ? t_ + 1 : (W)); \
                  POOLED[(size_t)t_ * 512 + c] = (bf16_t)f2bf(s_ / cnt_ - uv[16 + i]); } } while (0)
            const int grp = c >> 7;
            if (grp == 0) P2A_POOL(2); else if (grp == 1) P2A_POOL(4); else if (grp == 2) P2A_POOL(8); else P2A_POOL(16);
#undef P2A_POOL
          }
          { const float* dw = P.in[7] + (size_t)l * 31 * 512 + c; float w[31];
#pragma unroll
            for (int j = 0; j < 31; ++j) w[j] = dw[j * 512];
            const float bias = P.in[8][l * 512 + c]; const bf16_t* src = H + C_CONV + c;
#pragma unroll 1
            for (int ch = 0; ch < 4; ++ch) { float v[46];
                const int tb = t0 + 16 * ch - 30;
                { const bf16_t* p = src + (ptrdiff_t)tb * HLD;
#pragma unroll
                  for (int i0 = 0; i0 < 46; i0 += 8) { unsigned ra[8], rg[8];
#pragma unroll
                      for (int i = 0; i < 8; ++i) if (i0 + i < 46) { ra[i] = p[(ptrdiff_t)(i0 + i) * HLD]; rg[i] = p[(ptrdiff_t)(i0 + i) * HLD + 512]; }
#pragma unroll
                      for (int i = 0; i < 8; ++i) if (i0 + i < 46) { const float val = bf2f(ra[i]) * sigmoidf_(bf2f(rg[i])); v[i0 + i] = tb + i0 + i >= 0 ? val : 0.f; }
                      asm volatile("" ::: "memory"); } }
#pragma unroll
                for (int tl = 0; tl < 16; ++tl) { float y = bias;
#pragma unroll
                    for (int j = 0; j < 31; ++j) y = fmaf(w[j], v[tl + j], y);
                    ybuf[(16 * ch + tl) * 512 + c] = y; } } }
        }
        __syncthreads();
        { const float* lg = P.in[9] + l * 512 + 8 * lane; const float* lb = P.in[10] + l * 512 + 8 * lane;
          const f32x4 g0 = *(const f32x4*)lg, g1 = *(const f32x4*)(lg + 4), b0 = *(const f32x4*)lb, b1 = *(const f32x4*)(lb + 4);
#pragma unroll 1
          for (int i = 0; i < 8; ++i) { const int tl = wave * 8 + i; const LAS f32x4* yp = (const LAS f32x4*)(ybuf + tl * 512 + 8 * lane);
              f32x4 y0 = yp[0], y1 = yp[1];
              const float mean = wave_sum((y0[0] + y0[1]) + (y0[2] + y0[3]) + (y1[0] + y1[1]) + (y1[2] + y1[3])) * (1.f / 512.f);
              y0 = y0 - mean; y1 = y1 - mean;
              const float var = wave_sum((y0[0] * y0[0] + y0[1] * y0[1]) + (y0[2] * y0[2] + y0[3] * y0[3]) + (y1[0] * y1[0] + y1[1] * y1[1]) + (y1[2] * y1[2] + y1[3] * y1[3])) * (1.f / 512.f);
              const float rstd = rsqrtf(var + EPS);
              y0 = y0 * rstd * g0 + b0; y1 = y1 * rstd * g1 + b1;
              float r[8];
#pragma unroll
              for (int e = 0; e < 4; ++e) { r[e] = y0[e] * sigmoidf_(y0[e]); r[4 + e] = y1[e] * sigmoidf_(y1[e]); }
              u32x4 wv; wv.x = pk2(r[0], r[1]); wv.y = pk2(r[2], r[3]); wv.z = pk2(r[4], r[5]); wv.w = pk2(r[6], r[7]);
              *(u32x4*)(CONVA + (size_t)(t0 + tl) * 512 + 8 * lane) = wv; } }
        __syncthreads();
    }
}

__device__ __forceinline__ void gate_phase(const Params& P, int l, LAS unsigned char* lds, int G, int dup = 0) {
    int tid_l = threadIdx.x; asm volatile("" : "+v"(tid_l)); const int tid = tid_l, lane = tid & 63, wave = tid >> 6, r = lane & 31, hh = lane >> 5;
    unsigned* ctl = (unsigned*)(P.ws + WS_CTL) + l * CW_LAYER;
    const int* kmean = (const int*)(ctl + CW_KMEAN);
    const bf16_t* MQ = (const bf16_t*)(P.ws + WS_MQ);
    int* LIST = dup ? (int*)(P.ws + 486 * MiB) : (int*)((unsigned char*)P.out + DO_LIST); unsigned* cntp = ctl + (dup ? 512 : CW_CNT);
    for (int unit = blockIdx.x * NWV + wave; unit < (S / 32) * 4; unit += G * NWV) {
        const int h = unit & 3, t0 = (unit >> 2) * 32, own = t0 >> 8, t = t0 + r;
        if (own == 0) continue;
        f32x16 acc[2];
#pragma unroll
        for (int mt = 0; mt < 2; ++mt)
#pragma unroll
            for (int i = 0; i < 16; ++i) acc[mt][i] = 0.f;
#pragma unroll
        for (int ks = 0; ks < 8; ++ks) { const bf16x8 qf = *(const bf16x8*)(MQ + (size_t)t * 512 + h * 128 + 16 * ks + 8 * hh);
#pragma unroll
            for (int mt = 0; mt < 2; ++mt) { const int* kp = kmean + (size_t)(h * 64 + 32 * mt + r) * 128 + 16 * ks + 8 * hh; const u32x4 a = *(const u32x4*)kp, b = *(const u32x4*)(kp + 4);
                float v[8] = {(float)(int)a.x * KM_INV, (float)(int)a.y * KM_INV, (float)(int)a.z * KM_INV, (float)(int)a.w * KM_INV, (float)(int)b.x * KM_INV, (float)(int)b.y * KM_INV, (float)(int)b.z * KM_INV, (float)(int)b.w * KM_INV}; unsigned hi[8], lo[8];
#pragma unroll
                for (int e = 0; e < 8; ++e) { hi[e] = f2bf(v[e]); lo[e] = f2bf(v[e] - bf2f(hi[e])); }
                u32x4 wh, wl; wh.x = hi[0] | (hi[1] << 16); wh.y = hi[2] | (hi[3] << 16); wh.z = hi[4] | (hi[5] << 16); wh.w = hi[6] | (hi[7] << 16);
                wl.x = lo[0] | (lo[1] << 16); wl.y = lo[2] | (lo[3] << 16); wl.z = lo[4] | (lo[5] << 16); wl.w = lo[6] | (lo[7] << 16);
                acc[mt] = __builtin_amdgcn_mfma_f32_32x32x16_bf16(__builtin_bit_cast(bf16x8, wh), qf, acc[mt], 0, 0, 0);
                acc[mt] = __builtin_amdgcn_mfma_f32_32x32x16_bf16(__builtin_bit_cast(bf16x8, wl), qf, acc[mt], 0, 0, 0); } }
#pragma unroll
        for (int mt = 0; mt < 2; ++mt)
#pragma unroll
            for (int i = 0; i < 16; ++i) if (32 * mt + (i & 3) + 8 * (i >> 2) + 4 * hh >= own) acc[mt][i] = -INFINITY;
        float tv[3]; int ti[3];
#pragma unroll
        for (int p = 0; p < 3; ++p) { float bv = -INFINITY; int bi = 64;
#pragma unroll
            for (int mt = 0; mt < 2; ++mt)
#pragma unroll
                for (int i = 0; i < 16; ++i) { const int bidx = 32 * mt + (i & 3) + 8 * (i >> 2) + 4 * hh; const float v = acc[mt][i]; if (v > bv || (v == bv && bidx < bi)) { bv = v; bi = bidx; } }
            tv[p] = bv; ti[p] = bi;
#pragma unroll
            for (int mt = 0; mt < 2; ++mt)
#pragma unroll
                for (int i = 0; i < 16; ++i) if (32 * mt + (i & 3) + 8 * (i >> 2) + 4 * hh == bi) acc[mt][i] = -INFINITY; }
        float cv[6]; int ci[6];
#pragma unroll
        for (int p = 0; p < 3; ++p) { cv[p] = tv[p]; ci[p] = ti[p]; cv[3 + p] = __shfl_xor(tv[p], 32); ci[3 + p] = __shfl_xor(ti[p], 32); }
        int pick[3];
#pragma unroll
        for (int p = 0; p < 3; ++p) { float bv = -INFINITY; int bi = 64;
#pragma unroll
            for (int c = 0; c < 6; ++c) if (cv[c] > bv || (cv[c] == bv && ci[c] < bi)) { bv = cv[c]; bi = ci[c]; }
            pick[p] = bi;
#pragma unroll
            for (int c = 0; c < 6; ++c) if (ci[c] == bi) cv[c] = -INFINITY; }
        const int npick = own < 3 ? own : 3;
        if (hh == 0) {
#pragma unroll
            for (int p = 0; p < 3; ++p) if (p < npick) { const int hb = h * 64 + pick[p]; const int slot = (int)atomicAdd(cntp + hb, 1u); LIST[(size_t)hb * S + slot] = t * 4 + p; } }
    }
}

template <int DK>
__device__ __forceinline__ int attn_item(unsigned* qctr, const int tid, LAS unsigned char* lds, const bf16_t* Qb, int ldq, int qrow, bool qvalid, int qpos, int wqmin,
                                          const bf16_t* Kp, int ldk, const bf16_t* VT, int key0, int ntiles,
                                          float kmaxA, float kmaxB, const int OM, const int oidx, float* o32b, bf16_t* obb, float* lpb) {
    constexpr int NKS = DK / 16, SPRK = DK / 8 + 1, KSTR = SPRK * 16, NKI = SPRK, KBYTES = NKI * 1024, VSTR = 144, NVI = 18, BUF = KBYTES + NVI * 1024, KW = (DK == 192 ? 5 : 4), NII = 6;
    const int lane = tid & 63, r = lane & 31, hh = lane >> 5, wave = __builtin_amdgcn_readfirstlane(tid >> 6);
    bf16x8 qf[NKS];
    { const bf16_t* qp = Qb + (size_t)qrow * ldq + 8 * hh;
#pragma unroll
      for (int ks = 0; ks < NKS; ++ks) qf[ks] = *(const bf16x8*)(qp + 16 * ks); }
    float na = 0.f, nb = 0.f;
#pragma unroll
    for (int ks = 0; ks < NKS; ++ks)
#pragma unroll
        for (int e = 0; e < 8; ++e) { const float f = bf2f((unsigned)(unsigned short)qf[ks][e]); if (ks < 8) na += f * f; else nb += f * f; }
    na += __shfl_xor(na, 32); nb += __shfl_xor(nb, 32);
    const float negr = -(sqrtf(na) * kmaxA + sqrtf(nb) * kmaxB);
    const bool kwave = wave < KW;
    const int jw = kwave ? wave : wave - KW, jstride = kwave ? KW : 8 - KW, jn = kwave ? NKI : NVI;
    const unsigned char* gbase = kwave ? (const unsigned char*)Kp : (const unsigned char*)VT;
    const unsigned gstep = kwave ? (unsigned)ldk * 128u : 128u, ldst0 = kwave ? 0u : (unsigned)KBYTES;
#define AT_GOFF(j_) ({ const int sg_ = 64 * (j_) + lane; unsigned g_; \
        if (kwave) { const int row_ = sg_ / SPRK; int part_ = sg_ - row_ * SPRK; if (part_ == SPRK - 1) part_ = 0; g_ = (unsigned)(((key0 + row_) * ldk + part_ * 8) * 2); } \
        else { const int dv_ = sg_ / 9; int part_ = sg_ - dv_ * 9; if (part_ == 8) part_ = 0; g_ = (unsigned)((dv_ * S + key0 + part_ * 8) * 2); } g_; })
#define AT_DMA(tt, b) do { _Pragma("unroll") for (int ii_ = 0; ii_ < NII; ++ii_) { const int j_ = jw + jstride * ii_; if (j_ < jn) \
        __builtin_amdgcn_global_load_lds((const unsigned*)(gbase + (size_t)(AT_GOFF(j_) + (unsigned)(tt) * gstep)), (LAS unsigned*)(lds + (b) * BUF + ldst0 + j_ * 1024), 16, 0, 0); } } while (0)
    AT_DMA(0, 0);
    f32x16 o[4];
#pragma unroll
    for (int d = 0; d < 4; ++d)
#pragma unroll
        for (int i = 0; i < 16; ++i) o[d][i] = 0.f;
    float lsum = 0.f;
    const int pr = (r & 0x13) | ((r & 4) << 1) | ((r & 8) >> 1);
    const unsigned koff = (unsigned)(pr * KSTR + 16 * hh), voff = (unsigned)(KBYTES + r * VSTR + 16 * hh);
    asm volatile("s_waitcnt vmcnt(0)" ::: "memory"); __syncthreads();
    int nxt_idx = 0;
#pragma unroll 1
    for (int t = 0; t < ntiles; ++t) {
        const int cur = t & 1;
        if (t + 1 < ntiles) AT_DMA(t + 1, cur ^ 1);
        else if (tid == 0) nxt_idx = (int)atomicAdd(qctr, 1u);
        LAS const unsigned char* bp = lds + cur * BUF;
        bf16x8 pf[2][2];
#pragma unroll
        for (int kb = 0; kb < 2; ++kb) {
            f32x16 acc;
#pragma unroll
            for (int i = 0; i < 16; ++i) acc[i] = negr;
#pragma unroll
            for (int ks = 0; ks < NKS; ++ks) { const bf16x8 kf = *(LAS const bf16x8*)(bp + koff + kb * 32 * KSTR + 32 * ks); acc = __builtin_amdgcn_mfma_f32_32x32x16_bf16(kf, qf[ks], acc, 0, 0, 0); }
            const int kt0 = key0 + 64 * t + 32 * kb + 8 * hh;
            if (key0 + 64 * t + 63 > wqmin) {
#pragma unroll
                for (int i = 0; i < 16; ++i) if (kt0 + 16 * (i >> 3) + (i & 7) > qpos) acc[i] = -INFINITY; }
#pragma unroll
            for (int i = 0; i < 16; ++i) { const float p = __builtin_amdgcn_exp2f(acc[i]); lsum += p; acc[i] = p; }
            u32x4 w0, w1;
            w0.x = pk2(acc[0], acc[1]); w0.y = pk2(acc[2], acc[3]); w0.z = pk2(acc[4], acc[5]); w0.w = pk2(acc[6], acc[7]);
            w1.x = pk2(acc[8], acc[9]); w1.y = pk2(acc[10], acc[11]); w1.z = pk2(acc[12], acc[13]); w1.w = pk2(acc[14], acc[15]);
            pf[kb][0] = __builtin_bit_cast(bf16x8, w0); pf[kb][1] = __builtin_bit_cast(bf16x8, w1);
        }
#pragma unroll
        for (int d = 0; d < 4; ++d)
#pragma unroll
            for (int kb = 0; kb < 2; ++kb)
#pragma unroll
                for (int s = 0; s < 2; ++s) { const bf16x8 vf = *(LAS const bf16x8*)(bp + voff + d * 32 * VSTR + (32 * kb + 16 * s) * 2); o[d] = __builtin_amdgcn_mfma_f32_32x32x16_bf16(vf, pf[kb][s], o[d], 0, 0, 0); }
        asm volatile("s_waitcnt vmcnt(0)" ::: "memory");
        __syncthreads();
    }
#undef AT_DMA
#undef AT_GOFF
    lsum += __shfl_xor(lsum, 32);
    if (qvalid) {
        float* o32 = o32b + (size_t)oidx * 128; bf16_t* ob = obb + (size_t)oidx * (OM == 0 ? D : 128); float* lp = lpb + oidx;
        if (OM == 1) {
#pragma unroll
            for (int d = 0; d < 4; ++d)
#pragma unroll
                for (int i4 = 0; i4 < 4; ++i4) *(f32x4*)(o32 + 32 * d + 8 * i4 + 4 * hh) = (f32x4){o[d][4 * i4], o[d][4 * i4 + 1], o[d][4 * i4 + 2], o[d][4 * i4 + 3]};
            if (hh == 0) *lp = lsum;
        } else {
            const float sc = OM == 0 ? 1.f / lsum : 1.f;
#pragma unroll
            for (int d = 0; d < 4; ++d)
#pragma unroll
                for (int i4 = 0; i4 < 4; ++i4) { u32x2 w; w.x = pk2(o[d][4 * i4] * sc, o[d][4 * i4 + 1] * sc); w.y = pk2(o[d][4 * i4 + 2] * sc, o[d][4 * i4 + 3] * sc); *(u32x2*)(ob + 32 * d + 8 * i4 + 4 * hh) = w; }
            if (OM == 2 && hh == 0) *lp = lsum;
        }
    }
    return nxt_idx;
}

constexpr int N_HEAD_MLA = 96, N_HEAD_FIXED = 160, CW_QH = 24;
__device__ __forceinline__ void attn_phase(const Params& P, int l, LAS unsigned char* lds, int G, int rep = 0) {
    const int tid = threadIdx.x, lane = tid & 63, wave = tid >> 6, r = lane & 31;
    unsigned char* ws = P.ws; unsigned char* dout = (unsigned char*)P.out;
    unsigned* ctl = (unsigned*)(ws + WS_CTL) + l * CW_LAYER;
    float* PART = (float*)(dout + DO_PART); float* PL = (float*)(dout + DO_PL); bf16_t* PARTB = (bf16_t*)(dout + DO_PARTB); float* LB = (float*)(dout + DO_LB); const int* LIST = (const int*)(dout + DO_LIST);
    const bf16_t* Q = (const bf16_t*)(ws + WS_Q); const bf16_t* KK = (const bf16_t*)(ws + WS_K); const bf16_t* VT = (const bf16_t*)(ws + WS_VT); bf16_t* CC = (bf16_t*)(ws + WS_CONCAT);
    const bf16_t* MQ = (const bf16_t*)(ws + WS_MQ); const bf16_t* MK = (const bf16_t*)(ws + WS_MK); const bf16_t* MVT = (const bf16_t*)(ws + WS_MVT);
    LAS int* qidx = (LAS int*)(lds + LDS_MISC); LAS int* pre = (LAS int*)(lds + LDS_MISC + 64);
    __syncthreads();
    if (tid < 64) {
        const u32x4 c4 = *(const u32x4*)(ctl + CW_CNT + 4 * tid);
        const int a0 = (int)((c4.x + 255u) >> 8), a1 = a0 + (int)((c4.y + 255u) >> 8), a2 = a1 + (int)((c4.z + 255u) >> 8), a3 = a2 + (int)((c4.w + 255u) >> 8);
        int run = a3;
#pragma unroll
        for (int o = 1; o < 64; o <<= 1) { const int v = __shfl_up(run, o); if (lane >= o) run += v; }
        const int base = run - a3;
        pre[1 + 4 * tid] = base + a0; pre[2 + 4 * tid] = base + a1; pre[3 + 4 * tid] = base + a2; pre[4 + 4 * tid] = base + a3;
        if (tid == 0) pre[0] = 0; }
    __syncthreads();
    const float kpemax = sqrtf(__uint_as_float(ctl[CW_KPEMAX]));
    int hcur = (int)(((unsigned)__builtin_amdgcn_s_getreg((3 << 11) | 20) & 0xFu) & 3u), tried = 0;
    unsigned* qctr = ctl + CW_QH + 4 * rep + hcur;
    if (tid == 0) qidx[0] = (int)atomicAdd(qctr, 1u);
    __syncthreads();
    int idx = qidx[0];
    __syncthreads();
    for (;;) {
        bool done = false;
        while (idx >= N_HEAD_FIXED + pre[64 * hcur + 64] - pre[64 * hcur]) {
            if (++tried == 4) { done = true; break; }
            hcur = (hcur + 1) & 3; qctr = ctl + CW_QH + 4 * rep + hcur;
            if (tid == 0) qidx[0] = (int)atomicAdd(qctr, 1u);
            __syncthreads();
            idx = qidx[0];
            __syncthreads();
        }
        if (done) break;
        const int h = hcur; int nxt_idx;
        if (idx < N_HEAD_MLA) {
            const int j = idx; int qb, t0, nt, kind;
            if (j < 32) { qb = 32 + j; t0 = 0; nt = 128; kind = 1; }
            else { const int k = j - 32; if (k & 1) { qb = 31 - (k >> 1); t0 = 0; nt = 4 * (qb + 1); kind = 0; } else { qb = 63 - (k >> 1); t0 = 128; nt = 4 * (qb - 31); kind = 2; } }
            const int qrow = 256 * qb + 32 * wave + r;
            const float knmax = sqrtf(__uint_as_float(ctl[CW_KNPIECE + h * 4 + 0]) + __uint_as_float(ctl[CW_KNPIECE + h * 4 + 1]) + __uint_as_float(ctl[CW_KNPIECE + h * 4 + 2]) + __uint_as_float(ctl[CW_KNPIECE + h * 4 + 3]));
            const int slot = (h * 32 + (qb & 31)) * 2 + (kind == 2 ? 1 : 0); const bool causal = kind != 1;
            nxt_idx = attn_item<192>(qctr, tid, lds, Q + h * 192, 768, qrow, true, causal ? qrow : 0x7fffffff, causal ? 256 * qb + 32 * wave : 0x7fffffff, KK + h * 192, 768, VT + (size_t)h * 128 * S, 64 * t0, nt, knmax, kpemax,
                           kind == 0 ? 0 : 1, kind == 0 ? qrow : 32 * wave + r, PART + (size_t)slot * 256 * 128, CC + h * 128, PL + (size_t)slot * 256);
        } else {
            int key0, qrow, qpos, wqmin, pslot; bool valid = true;
            if (idx < N_HEAD_FIXED) { const int blk = idx - N_HEAD_MLA; key0 = 256 * blk; qrow = 256 * blk + 32 * wave + r; qpos = qrow; wqmin = 256 * blk + 32 * wave; pslot = 3; }
            else { const int g2 = pre[64 * h] + idx - N_HEAD_FIXED; int lo = 64 * h, hi = 64 * h + 64;
                while (hi - lo > 1) { const int mid = (lo + hi) >> 1; if (pre[mid] <= g2) lo = mid; else hi = mid; }
                const int hb = lo, chunk = g2 - pre[hb]; const int cntv = (int)ctl[CW_CNT + hb]; int nq = cntv - 256 * chunk; nq = nq > 256 ? 256 : nq;
                const int li = 32 * wave + r; valid = li < nq; const int ent = LIST[(size_t)hb * S + 256 * chunk + (valid ? li : 0)]; qrow = ent >> 2; pslot = ent & 3;
                key0 = 256 * (hb & 63); qpos = 0x7fffffff; wqmin = 0x7fffffff; }
            const float kmmax = sqrtf(__uint_as_float(ctl[CW_KMMAX + h]));
            nxt_idx = attn_item<128>(qctr, tid, lds, MQ + h * 128, 512, qrow, valid, qpos, wqmin, MK + h * 128, 512, MVT + (size_t)h * 128 * S, key0, 4, kmmax, 0.f, 2, (qrow * 4 + h) * 4 + pslot, nullptr, PARTB, LB);
        }
        if (tid == 0) qidx[0] = nxt_idx;
        __syncthreads();
        idx = qidx[0];
        __syncthreads();
    }
}
__device__ __forceinline__ void attn_norm_phase(const Params& P, int G) {
    int tid_l = threadIdx.x; asm volatile("" : "+v"(tid_l)); const int lane = tid_l & 63, wave = tid_l >> 6;
    unsigned char* dout = (unsigned char*)P.out;
    const float* PART = (const float*)(dout + DO_PART); const float* PL = (const float*)(dout + DO_PL); const bf16_t* PARTB = (const bf16_t*)(dout + DO_PARTB); const float* LB = (const float*)(dout + DO_LB);
    bf16_t* CC = (bf16_t*)(P.ws + WS_CONCAT);
    for (int row = blockIdx.x * NWV + wave; row < S; row += G * NWV) {
        float acc[16]; float lt = 0.f; bool wr = false;
#pragma unroll
        for (int e = 0; e < 16; ++e) acc[e] = 0.f;
        const int qb = row >> 8;
        if (lane < 32) { if (qb >= 32) { wr = true; const int h = lane >> 3;
#pragma unroll
                for (int c = 0; c < 2; ++c) { const size_t slot = (size_t)((h * 32 + qb - 32) * 2 + c) * 256 + (row & 255); lt += PL[slot]; const f32x4* pp = (const f32x4*)(PART + slot * 128 + 16 * (lane & 7));
#pragma unroll
                    for (int e4 = 0; e4 < 4; ++e4) { const f32x4 v = pp[e4]; acc[4 * e4] += v[0]; acc[4 * e4 + 1] += v[1]; acc[4 * e4 + 2] += v[2]; acc[4 * e4 + 3] += v[3]; } } } }
        else { wr = true; const int h = (lane >> 3) - 4; const int np = qb < 3 ? qb : 3;
            const size_t ps0 = ((size_t)row * 4 + h) * 4; const f32x4 l4 = *(const f32x4*)(LB + ps0); u32x4 raw[4][2];
#pragma unroll
            for (int sl = 0; sl < 4; ++sl) { const u32x4* pp = (const u32x4*)(PARTB + (ps0 + sl) * 128 + 16 * (lane & 7)); raw[sl][0] = pp[0]; raw[sl][1] = pp[1]; }
#pragma unroll
            for (int sl = 0; sl < 4; ++sl) { const bool use = sl == 3 || sl < np; lt += use ? l4[sl] : 0.f;
#pragma unroll
                for (int e8 = 0; e8 < 2; ++e8) { const u32x4 v = raw[sl][e8]; float f[8] = {bf2f(v.x & 0xffffu), bf2f(v.x >> 16), bf2f(v.y & 0xffffu), bf2f(v.y >> 16), bf2f(v.z & 0xffffu), bf2f(v.z >> 16), bf2f(v.w & 0xffffu), bf2f(v.w >> 16)};
#pragma unroll
                    for (int e = 0; e < 8; ++e) acc[8 * e8 + e] += use ? f[e] : 0.f; } } }
        if (wr) { const float inv = 1.f / lt; u32x4 w0, w1;
            w0.x = pk2(acc[0] * inv, acc[1] * inv); w0.y = pk2(acc[2] * inv, acc[3] * inv); w0.z = pk2(acc[4] * inv, acc[5] * inv); w0.w = pk2(acc[6] * inv, acc[7] * inv);
            w1.x = pk2(acc[8] * inv, acc[9] * inv); w1.y = pk2(acc[10] * inv, acc[11] * inv); w1.z = pk2(acc[12] * inv, acc[13] * inv); w1.w = pk2(acc[14] * inv, acc[15] * inv);
            u32x4* dst = (u32x4*)(CC + (size_t)row * D + 16 * lane); dst[0] = w0; dst[1] = w1; }
    }
}

#define GAS __attribute__((address_space(1)))

typedef GAS unsigned gu32;
typedef GAS unsigned long long gu64;
#define RLX_AGENT __ATOMIC_RELAXED, __HIP_MEMORY_SCOPE_AGENT
#define LDS_WAIT() asm volatile("s_waitcnt lgkmcnt(0)" ::: "memory")
#define VM_WAIT() asm volatile("s_waitcnt vmcnt(0)" ::: "memory")
__device__ __forceinline__ unsigned long long rt() { return __builtin_amdgcn_s_memrealtime(); }
#define XB_TMO      128
#define XB_XCNT(j)  (256  + 64 * (j))
#define XB_XSUB(j)  (1280 + 64 * (j))
#define XB_XGEN(j)  (2304 + 64 * (j))
#define XB_TOP      3328
#define XB_TOPGEN   3392
#define XCD_BAR_WORDS 3456
#define XB_SPIN_CAP (1u << 18)

__device__ __forceinline__ unsigned xb_ld(unsigned* p)              { return __hip_atomic_load(p, __ATOMIC_RELAXED, __HIP_MEMORY_SCOPE_AGENT); }
__device__ __forceinline__ unsigned xb_add(unsigned* p, unsigned v) { return __hip_atomic_fetch_add(p, v, __ATOMIC_RELAXED, __HIP_MEMORY_SCOPE_AGENT); }
__device__ __forceinline__ unsigned xb_xcc_id() { return (unsigned)__builtin_amdgcn_s_getreg((3 << 11) | 20) & 0xFu; }
#define XB_SPIN(cond, bar) do { unsigned _sp = 0; while (cond) { __builtin_amdgcn_s_sleep(1); \
    if ((++_sp & 255u) == 0u) { if (xb_ld(&(bar)[XB_TMO])) break; if (_sp > XB_SPIN_CAP) { atomicAdd(&(bar)[XB_TMO], 1u); break; } } } } while (0)

struct XcdBarrier {
    unsigned* bar; unsigned x;
    volatile LAS unsigned* st;
};

__device__ __forceinline__ XcdBarrier xcd_barrier_post(unsigned* bar, volatile LAS unsigned* st) {
    XcdBarrier b; b.bar = bar; b.x = xb_xcc_id(); b.st = st;
    if (threadIdx.x == 0) (void)xb_add(&bar[XB_XCNT(b.x)], 1u);
    return b;
}
__device__ __forceinline__ void xcd_barrier_complete(unsigned* bar, unsigned x, unsigned& nloc, unsigned& nx) {
    const unsigned G = gridDim.x * gridDim.y * gridDim.z;
    unsigned sum, cnt, mine, sp = 0u;
    for (;;) {
        sum = 0u; cnt = 0u; mine = 0u;
#pragma unroll
        for (unsigned j = 0; j < 16; ++j) { const unsigned c = xb_ld(&bar[XB_XCNT(j)]); sum += c; cnt += (c > 0u) ? 1u : 0u; mine = (j == x) ? c : mine; }
        if (sum == G) break;
        __builtin_amdgcn_s_sleep(1);
        if ((++sp & 255u) == 0u) { if (xb_ld(&bar[XB_TMO])) break; if (sp > XB_SPIN_CAP) { atomicAdd(&bar[XB_TMO], 1u); break; } }
    }
    nloc = mine > 0u ? mine : 1u; nx = cnt > 0u ? cnt : 1u;
}

__device__ __forceinline__ void xcd_barrier(const XcdBarrier& b) {
    asm volatile("s_waitcnt vmcnt(0)" ::: "memory");
    __syncthreads();
    if (threadIdx.x == 0) {
        unsigned* bar = b.bar;
        __builtin_amdgcn_s_waitcnt(0);
        unsigned nloc = b.st[0], nx = b.st[1];
        if (nloc == 0u) { xcd_barrier_complete(bar, b.x, nloc, nx); b.st[0] = nloc; b.st[1] = nx; }
        const unsigned old = xb_add(&bar[XB_XSUB(b.x)], 1u);
        const unsigned gen = old / nloc;
        if (old + 1u == (gen + 1u) * nloc) {
            __builtin_amdgcn_fence(__ATOMIC_RELEASE, "agent");
            asm volatile("s_waitcnt vmcnt(0)" ::: "memory");
            const unsigned og = xb_add(&bar[XB_TOP], 1u);
            const unsigned tg = og / nx;
            if (og + 1u == (tg + 1u) * nx) xb_add(&bar[XB_TOPGEN], 1u);
            else XB_SPIN(xb_ld(&bar[XB_TOPGEN]) == tg, bar);
            __builtin_amdgcn_fence(__ATOMIC_ACQUIRE, "agent");
            xb_add(&bar[XB_XGEN(b.x)], 1u);
            asm volatile("s_waitcnt vmcnt(0)" ::: "memory");
        } else {
            XB_SPIN(xb_ld(&bar[XB_XGEN(b.x)]) == gen, bar);
            __builtin_amdgcn_fence(__ATOMIC_ACQUIRE, "agent");
            asm volatile("s_waitcnt vmcnt(0)" ::: "memory");
        }
    }
    __syncthreads();
}

constexpr int CW_BAR = 131072;

#ifdef SELFCHECK
constexpr int CW_CHK = 40;
__device__ __forceinline__ float blk_reduce(const int tid, float v, bool domax, LAS float* red) {
#pragma unroll
    for (int o = 1; o < 64; o <<= 1) { const float w = __shfl_xor(v, o); v = domax ? fmaxf(v, w) : v + w; }
    __syncthreads(); if ((tid & 63) == 0) red[tid >> 6] = v; __syncthreads();
    float r = red[0];
#pragma unroll
    for (int i = 1; i < 8; ++i) r = domax ? fmaxf(r, red[i]) : r + red[i];
    __syncthreads();
    return r;
}
__device__ __forceinline__ int chk_token(int i) {
    if (i < 16) { const int base = (i >> 1) == 0 ? 0 : (i >> 1) == 1 ? 32 : (i >> 1) == 2 ? 64 : (i >> 1) == 3 ? 128 : (i >> 1) == 4 ? 256 : (i >> 1) == 5 ? 512 : (i >> 1) == 6 ? 768 : 1024;
        return (i & 1) ? (i == 1 ? 1 : i == 9 ? 257 : base - 1) : base; }
    return (i * 64 + (i * 13) % 64) & (S - 1); }
__device__ __forceinline__ bool chk_softmax_pv(const int tid, LAS float* sbuf, LAS int* kmap, int n, const bf16_t* VTh, const bf16_t* CC, int t, int col0, LAS float* red, LAS float* obuf) {
    float m = -INFINITY; for (int k = tid; k < n; k += NT) m = fmaxf(m, sbuf[k]);
    m = blk_reduce(tid, m, true, red);
    float l = 0.f; for (int k = tid; k < n; k += NT) { const float p = __builtin_amdgcn_exp2f(sbuf[k] - m); sbuf[k] = p; l += p; }
    l = blk_reduce(tid, l, false, red);
    const int dv = tid & 127, part = tid >> 7; float o = 0.f;
    for (int k = part; k < n; k += 4) { const int key = kmap ? kmap[k] : k; o += sbuf[k] * bf2f(VTh[(size_t)dv * S + key]); }
    obuf[tid] = o; __syncthreads();
    float ref = 0.f, err = 0.f;
    if (tid < 128) { ref = (obuf[tid] + obuf[tid + 128] + obuf[tid + 256] + obuf[tid + 384]) / l; err = fabsf(ref - bf2f(CC[(size_t)t * D + col0 + tid])); ref = fabsf(ref); }
    const float mref = blk_reduce(tid, ref, true, red), merr = blk_reduce(tid, err, true, red);
    return !(merr <= 0.02f * mref + 1e-6f);
}
__device__ __forceinline__ void selfcheck_attn(const Params& P, LAS unsigned char* lds, int l, int G) {
    int tid_l = threadIdx.x; asm volatile("" : "+v"(tid_l)); const int tid = tid_l; unsigned char* ws = P.ws;
    unsigned* flag = (unsigned*)(ws + WS_CTL) + CW_CHK; unsigned* ctl = (unsigned*)(ws + WS_CTL) + l * CW_LAYER;
    const bf16_t* Q = (const bf16_t*)(ws + WS_Q); const bf16_t* KK = (const bf16_t*)(ws + WS_K); const bf16_t* VT = (const bf16_t*)(ws + WS_VT); const bf16_t* KPE = (const bf16_t*)(ws + WS_KPE);
    const bf16_t* MQ = (const bf16_t*)(ws + WS_MQ); const bf16_t* MK = (const bf16_t*)(ws + WS_MK); const bf16_t* MVT = (const bf16_t*)(ws + WS_MVT);
    const bf16_t* CC = (const bf16_t*)(ws + WS_CONCAT); const bf16_t* CQN = (const bf16_t*)(ws + WS_CQN); const bf16_t* CKVN = (const bf16_t*)(ws + WS_CKVN);
    const int* kmean = (const int*)(ctl + CW_KMEAN); const float* RM = (const float*)(ws + WS_ROPE_MLA);
    LAS float* sbuf = (LAS float*)lds;
    LAS float* qv = (LAS float*)(lds + 65536);
    LAS float* obuf = (LAS float*)(lds + 65536 + 4096);
    LAS float* red = (LAS float*)(lds + 65536 + 8192);
    LAS int* kmap = (LAS int*)(lds + 65536 + 12288);
    LAS float* gate = (LAS float*)(lds + 65536 + 20480);
    LAS int* sel = (LAS int*)(lds + 65536 + 20480 + 256);
    for (int smp = blockIdx.x; smp < 256; smp += G) {
        const int t = chk_token(smp), h = smp & 3; unsigned bad = 0u;
        __syncthreads();
        if (tid < 192) qv[tid] = bf2f(Q[(size_t)t * 768 + h * 192 + tid]);
        __syncthreads();
        for (int k = tid; k <= t; k += NT) { const bf16_t* kr = KK + (size_t)k * 768 + h * 192; float sc = 0.f; for (int d = 0; d < 192; ++d) sc += qv[d] * bf2f(kr[d]); sbuf[k] = sc; }
        __syncthreads();
        if (chk_softmax_pv(tid, sbuf, nullptr, t + 1, VT + (size_t)h * 128 * S, CC, t, h * 128, red, obuf)) bad |= 1u;
        const int own = t >> 8;
        if (tid < 128) qv[tid] = bf2f(MQ[(size_t)t * 512 + h * 128 + tid]);
        __syncthreads();
        if (tid < 64) { float g = -INFINITY; if (tid < own) { g = 0.f; for (int d = 0; d < 128; ++d) g += qv[d] * ((float)kmean[(size_t)(h * 64 + tid) * 128 + d] * KM_INV) * (1.f / 256.f); } gate[tid] = g; }
        __syncthreads();
        if (tid == 0) { int ns = own < 3 ? own : 3; float last = 0.f; for (int p = 0; p < 4; ++p) { int bi = -1; float bv = -INFINITY; for (int b = 0; b < own; ++b) if (gate[b] > bv) { bv = gate[b]; bi = b; }
                if (p < 3) { sel[p] = bi; last = bv; if (bi >= 0) gate[bi] = -INFINITY; } else sel[4] = (own > 3 && last - bv < 1e-4f * (fabsf(last) + 1e-3f)) ? 1 : 0; }
            sel[3] = ns; }
        __syncthreads();
        const int ns = sel[3], skip = sel[4]; const int nown = t - 256 * own + 1, n = 256 * ns + nown;
        for (int kk = tid; kk < n; kk += NT) { const int key = kk < 256 * ns ? 256 * sel[kk >> 8] + (kk & 255) : 256 * own + (kk - 256 * ns); kmap[kk] = key;
            const bf16_t* kr = MK + (size_t)key * 512 + h * 128; float sc = 0.f; for (int d = 0; d < 128; ++d) sc += qv[d] * bf2f(kr[d]); sbuf[kk] = sc; }
        __syncthreads();
        if (chk_softmax_pv(tid, sbuf, kmap, n, MVT + (size_t)h * 128 * S, CC, t, 512 + h * 128, red, obuf) && !skip) bad |= 2u;
        { const float* wuq = P.in[4] + (size_t)l * 512 * 768; const float* gq = P.in[3] + l * 512;
          for (int nn = tid; nn < 768; nn += NT) { float a = 0.f; for (int k = 0; k < 512; ++k) a += bf2f(CQN[(size_t)t * 512 + k]) * gq[k] * wuq[(size_t)k * 768 + nn]; qv[nn] = a * CQ_SCALE; }
          __syncthreads();
          float ref = 0.f, err = 0.f;
          for (int nn = tid; nn < 768; nn += NT) { const int hd = nn / 192, d = nn - hd * 192; float v; int pos;
              if (d < 128) { v = qv[nn]; pos = nn; }
              else { const int e = d - 128, j = e & 31; const float x1 = qv[hd * 192 + 128 + j], x2 = qv[hd * 192 + 160 + j], c = RM[((size_t)t * 32 + j) * 2], sn = RM[((size_t)t * 32 + j) * 2 + 1];
                  v = e < 32 ? x1 * c - x2 * sn : x1 * sn + x2 * c; pos = hd * 192 + 128 + 2 * j + (e >> 5); }
              ref = fmaxf(ref, fabsf(v)); err = fmaxf(err, fabsf(v - bf2f(Q[(size_t)t * 768 + pos]))); }
          const float mref = blk_reduce(tid, ref, true, red), merr = blk_reduce(tid, err, true, red);
          if (!(merr <= 0.03f * mref + 1e-6f)) bad |= 4u; }
        { const float* wkv = P.in[6] + (size_t)l * 256 * 1024; const float* gk = P.in[5] + l * 256; float ref = 0.f, err = 0.f;
          for (int nn = tid; nn < 1024; nn += NT) { float a = 0.f; for (int k = 0; k < 256; ++k) a += bf2f(CKVN[(size_t)t * 256 + k]) * gk[k] * wkv[(size_t)k * 1024 + nn];
              const int hd = nn >> 8, d = nn & 255; const float got = d < 128 ? bf2f(KK[(size_t)t * 768 + hd * 192 + d]) : bf2f(VT[(size_t)(hd * 128 + d - 128) * S + t]);
              ref = fmaxf(ref, fabsf(a)); err = fmaxf(err, fabsf(a - got)); }
          if (tid < 256) { const int hd = tid >> 6, e = tid & 63; if (KK[(size_t)t * 768 + hd * 192 + 128 + e] != KPE[(size_t)t * 64 + e]) err = 1e30f; }
          const float mref = blk_reduce(tid, ref, true, red), merr = blk_reduce(tid, err, true, red);
          if (!(merr <= 0.03f * mref + 1e-6f)) bad |= 8u; }
        { const int b = (smp >> 2) & 63; float ref = 0.f, err = 0.f;
          if (tid < 128) { float a = 0.f; for (int i = 0; i < 256; ++i) a += bf2f(MK[(size_t)(256 * b + i) * 512 + h * 128 + tid]); a *= (1.f / 256.f); ref = fabsf(a); err = fabsf(a - (float)kmean[(size_t)(h * 64 + b) * 128 + tid] * KM_INV * (1.f / 256.f)); }
          const float mref = blk_reduce(tid, ref, true, red), merr = blk_reduce(tid, err, true, red);
          if (!(merr <= 0.02f * mref + 1e-6f)) bad |= 16u; }
        if (tid == 0 && bad) atomicOr(flag, bad);
    }
    __syncthreads();
}
__device__ __forceinline__ void selfcheck_p2a(const Params& P, LAS unsigned char* lds, int G) {
    int tid_l = threadIdx.x; asm volatile("" : "+v"(tid_l)); const int tid = tid_l; unsigned char* ws = P.ws; unsigned* flag = (unsigned*)(ws + WS_CTL) + CW_CHK;
    const bf16_t* H = (const bf16_t*)(ws + WS_H); const bf16_t* MQ = (const bf16_t*)(ws + WS_MQ); const bf16_t* MK = (const bf16_t*)(ws + WS_MK); const bf16_t* MVT = (const bf16_t*)(ws + WS_MVT); const bf16_t* KPE = (const bf16_t*)(ws + WS_KPE);
    const float* RM = (const float*)(ws + WS_ROPE_MLA); const float* RO = (const float*)(ws + WS_ROPE_MOBA);
    LAS float* red = (LAS float*)(lds + 65536 + 8192);
    for (int smp = blockIdx.x; smp < 256; smp += G) { const int t = chk_token(smp); float err = 0.f; const bf16_t* hr = H + (size_t)t * HLD;
        { const int c = tid, d = c & 127; float q = bf2f(hr[C_MQ + c]), k = bf2f(hr[C_MK + c]);
          if (d < 32) { const int j = d & 15; const float cs = RO[((size_t)t * 16 + j) * 2], sn = RO[((size_t)t * 16 + j) * 2 + 1];
              const float q1 = bf2f(hr[C_MQ + (c & ~31) + j]), q2 = bf2f(hr[C_MQ + (c & ~31) + 16 + j]), k1 = bf2f(hr[C_MK + (c & ~31) + j]), k2 = bf2f(hr[C_MK + (c & ~31) + 16 + j]);
              q = d < 16 ? q1 * cs - q2 * sn : q1 * sn + q2 * cs; k = d < 16 ? k1 * cs - k2 * sn : k1 * sn + k2 * cs; }
          err = fmaxf(err, fabsf(q * CM_SCALE - bf2f(MQ[(size_t)t * 512 + c])) / (fabsf(q * CM_SCALE) + 0.05f));
          err = fmaxf(err, fabsf(k - bf2f(MK[(size_t)t * 512 + c])) / (fabsf(k) + 0.5f));
          if (MVT[(size_t)c * S + t] != hr[C_MV + c]) err = 1e30f;
          if (c < 64) { const int j = c & 31; const float x1 = bf2f(hr[C_KR + j]), x2 = bf2f(hr[C_KR + 32 + j]), cs = RM[((size_t)t * 32 + j) * 2], sn = RM[((size_t)t * 32 + j) * 2 + 1];
              const float v = c < 32 ? x1 * cs - x2 * sn : x1 * sn + x2 * cs; err = fmaxf(err, fabsf(v - bf2f(KPE[(size_t)t * 64 + 2 * j + (c >> 5)])) / (fabsf(v) + 0.5f)); } }
        const float merr = blk_reduce(tid, err, true, red);
        if (tid == 0 && !(merr <= 0.02f)) atomicOr(flag, 32u); }
    __syncthreads();
}
#endif

#ifdef USE_CG_SYNC
#define GSYNC() grid.sync()
#else
#define GSYNC() xcd_barrier(xbar)
#endif
template <int l> __device__ __forceinline__ void layer_fwd(const Params& P, LAS unsigned char* lds, cg::grid_group& grid, const XcdBarrier& xbar, const int G) {
    unsigned char* ws = P.ws;

        unsigned* ctl = (unsigned*)(ws + WS_CTL) + l * CW_LAYER;
        bf16_t* Y = (bf16_t*)(ws + WS_Y); float* stats1 = (float*)(ws + WS_STATS); float* stats2 = stats1 + (size_t)S * 2;
#ifndef SKIP_G1
        { EpiStore E{(bf16_t*)(ws + WS_H), HLD}; GEMM_CALL(EpiStore, E, ws + WS_XB, ws + WS_WIN, HLD, D, (int)blockIdx.x); }
#endif
#ifdef REP_G1
        GSYNC(); { EpiStore E{(bf16_t*)(ws + WS_H), HLD}; GEMM_CALL(EpiStore, E, ws + WS_XB, ws + WS_WIN, HLD, D, (int)blockIdx.x); }
#endif
        GSYNC();

#ifndef SKIP_P2A
        p2a_phase(P, l, lds, G);
#endif
#ifdef SELFCHECK
        GSYNC(); selfcheck_p2a(P, lds, G);
#endif
#ifdef REP_P2A
        GSYNC(); p2a_phase(P, l, lds, G);
#endif

        GSYNC();
#ifndef SKIP_G2
        { EpiQ E{(bf16_t*)(ws + WS_Q), (const float*)(ws + WS_ROPE_MLA)}; GEMM_CALL(EpiQ, E, ws + WS_CQN, ws + WS_WUQ, 768, 512, (int)blockIdx.x); }
#endif
#ifndef SKIP_G3
        { EpiKV E{(bf16_t*)(ws + WS_K), (bf16_t*)(ws + WS_VR), (const bf16_t*)(ws + WS_KPE), ctl + CW_KNPIECE}; int kkv = 256; asm volatile("" : "+s"(kkv)); GEMM_CALL(EpiKV, E, ws + WS_CKVN, ws + WS_WUKV, 1024, kkv, (int)blockIdx.x);
          __threadfence_block(); __syncthreads();
          { pg8::StaticOrder so2; so2.init(S, 1024, G, (int)blockIdx.x); pg8::Unit u2; for (int i2 = 0; so2.next(i2, u2); ++i2) vt_tile((const bf16_t*)(ws + WS_VR), (bf16_t*)(ws + WS_VT), u2.pm, u2.pn); } }
#endif
#ifndef SKIP_G4
        { EpiStore E{(bf16_t*)(ws + WS_CONCAT) + 1024, D}; GEMM_CALL(EpiStore, E, ws + WS_CONVA, ws + WS_WPW, 512, 512, (int)((blockIdx.x + 128) % G)); }
#endif
#ifndef SKIP_G5
        { EpiStore E{(bf16_t*)(ws + WS_CONCAT) + 1536, D}; GEMM_CALL(EpiStore, E, ws + WS_POOLED, ws + WS_WPOOL, 512, 512, (int)((blockIdx.x + 64) % G)); }
#endif

#ifndef SKIP_GATE
        gate_phase(P, l, lds, G);
#endif
#ifdef REP_GATE
        gate_phase(P, l, lds, G, 1);
#endif
#ifdef REP_P2B
        { EpiQ E{(bf16_t*)(ws + WS_Q), (const float*)(ws + WS_ROPE_MLA)}; GEMM_CALL(EpiQ, E, ws + WS_CQN, ws + WS_WUQ, 768, 512, (int)blockIdx.x); }
        { EpiStore E{(bf16_t*)(ws + WS_CONCAT) + 1024, D}; GEMM_CALL(EpiStore, E, ws + WS_CONVA, ws + WS_WPW, 512, 512, (int)((blockIdx.x + 128) % G)); }
        { EpiStore E{(bf16_t*)(ws + WS_CONCAT) + 1536, D}; GEMM_CALL(EpiStore, E, ws + WS_POOLED, ws + WS_WPOOL, 512, 512, (int)((blockIdx.x + 64) % G)); }
#endif

        GSYNC();

#ifndef SKIP_ATTN
        attn_phase(P, l, lds, G);
#endif
#ifdef REP_ATTN
        GSYNC(); attn_phase(P, l, lds, G, 1);
#endif

        GSYNC();

#ifndef SKIP_NORM
        attn_norm_phase(P, G);
#endif
#ifdef SELFCHECK
        GSYNC(); selfcheck_attn(P, lds, l, G);
#endif
#ifdef REP_LN
        GSYNC(); attn_norm_phase(P, G);
#endif

        GSYNC();
#ifndef SKIP_G6
        if (l == 0) { EpiRes<0> E{P.in[0], Y, nullptr, nullptr, nullptr}; GEMM_CALL(EpiRes<0>, E, ws + WS_CONCAT, ws + WS_WOUT, D, D, (int)blockIdx.x); }
        else { EpiRes<1> E{nullptr, Y, stats2, P.in[20] + (size_t)(l - 1) * D, P.in[21] + (size_t)(l - 1) * D}; GEMM_CALL(EpiRes<1>, E, ws + WS_CONCAT, ws + WS_WOUT, D, D, (int)blockIdx.x); }
#endif
        GSYNC();
        ln_phase<false>(Y, P.in[15] + (size_t)l * D, P.in[16] + (size_t)l * D, stats1, (bf16_t*)(ws + WS_XB), nullptr, G);
        GSYNC();
#ifdef REP_LN
        ln_phase<false>(Y, P.in[15] + (size_t)l * D, P.in[16] + (size_t)l * D, stats1, (bf16_t*)(ws + WS_XB), nullptr, G);
        GSYNC();
#endif
#ifndef SKIP_G8
        { EpiFfn E{(bf16_t*)(ws + WS_ACT)}; GEMM_CALL(EpiFfn, E, ws + WS_XB, ws + WS_WGU, 2 * DFF, D, (int)blockIdx.x); }
#endif
#ifdef REP_G8
        GSYNC(); { EpiFfn E{(bf16_t*)(ws + WS_ACT)}; GEMM_CALL(EpiFfn, E, ws + WS_XB, ws + WS_WGU, 2 * DFF, D, (int)blockIdx.x); }
#endif
        GSYNC();
#ifndef SKIP_G9
        { EpiRes<1> E{nullptr, Y, stats1, P.in[15] + (size_t)l * D, P.in[16] + (size_t)l * D}; GEMM_CALL(EpiRes<1>, E, ws + WS_ACT, ws + WS_WDN, D, DFF, (int)blockIdx.x); }
#endif
        GSYNC();
        if (l + 1 < NLAYER) { ln_phase<false>(Y, P.in[20] + (size_t)l * D, P.in[21] + (size_t)l * D, stats2, (bf16_t*)(ws + WS_XB), nullptr, G); prep_weights(P, l + 1, lds, G); GSYNC();
#ifdef REP_PREP
            prep_weights(P, l + 1, lds, G); GSYNC();
#endif
#ifdef REP_LN
            ln_phase<false>(Y, P.in[20] + (size_t)l * D, P.in[21] + (size_t)l * D, stats2, (bf16_t*)(ws + WS_XB), nullptr, G); GSYNC();
#endif
        }
#ifdef SELFCHECK
        else ln_phase<true>(Y, P.in[20] + (size_t)l * D, P.in[21] + (size_t)l * D, nullptr, nullptr, P.out, G, (float)(*((const unsigned*)(ws + WS_CTL) + 40)));
#else
        else ln_phase<true>(Y, P.in[20] + (size_t)l * D, P.in[21] + (size_t)l * D, nullptr, nullptr, P.out, G);
#endif

}

__global__ void __launch_bounds__(NT, 2) hybrid_fwd(Params P) {
    extern __shared__ __attribute__((aligned(16))) unsigned char lds_raw[];
    LAS unsigned char* lds = (LAS unsigned char*)lds_raw;
    cg::grid_group grid = cg::this_grid();
    const int G = gridDim.x;
    unsigned char* ws = P.ws;
    volatile LAS unsigned* xst = (volatile LAS unsigned*)(lds + LDS_MISC + 8192);
    if (threadIdx.x < 2) xst[threadIdx.x] = 0u;
    __syncthreads();
    const XcdBarrier xbar = xcd_barrier_post((unsigned*)(ws + WS_CTL) + CW_BAR, xst);

#ifndef SKIP_PREP
    prep_weights(P, 0, lds, G);
    prep_layer0(P, G);
#endif
#ifdef REP_PREP
    GSYNC(); prep_weights(P, 0, lds, G); prep_layer0(P, G);
#endif
#ifdef REP_SYNC
#pragma unroll 1
    for (int i_ = 0; i_ < 20; ++i_) GSYNC();
#endif

    grid.sync();
    layer_fwd<0>(P, lds, grid, xbar, G);
    layer_fwd<1>(P, lds, grid, xbar, G);
}

extern "C" void kernel_launch(void* const* d_in, const int* in_sizes, int n_in, void* d_out, int out_size, void* d_ws, size_t ws_size, hipStream_t stream) {
    static int grid = 0;
    if (grid == 0) {
        if (n_in != 22 || out_size != S * D || ws_size < WS_END) { fprintf(stderr, "kernel_launch: unexpected shapes (n_in %d, out %d, ws %zu)\n", n_in, out_size, ws_size); grid = -1; return; }
        int dev = 0, cus = 0, per_cu = 0;
        hipGetDevice(&dev); hipDeviceGetAttribute(&cus, hipDeviceAttributeMultiprocessorCount, dev);
        if (hipFuncSetAttribute((const void*)hybrid_fwd, hipFuncAttributeMaxDynamicSharedMemorySize, LDS_BYTES) != hipSuccess) { fprintf(stderr, "kernel_launch: hipFuncSetAttribute failed\n"); grid = -1; return; }
        if (hipOccupancyMaxActiveBlocksPerMultiprocessor(&per_cu, (const void*)hybrid_fwd, NT, LDS_BYTES) != hipSuccess || per_cu < 1) per_cu = 1;
        (void)hipGetLastError();
        grid = cus * 1;
        fprintf(stderr, "kernel_launch: %d CUs, occupancy %d, grid %d\n", cus, per_cu, grid);
    }
    if (grid < 0) return;
    hipMemsetAsync((char*)d_ws + WS_CTL, 0, CTL_BYTES, stream);
    Params p{};
    for (int i = 0; i < 22; ++i) p.in[i] = (const float*)d_in[i];
    p.out = (float*)d_out; p.ws = (unsigned char*)d_ws;
    void* args[] = {&p};
    hipError_t e = hipLaunchCooperativeKernel((const void*)hybrid_fwd, dim3(grid), dim3(NT), args, LDS_BYTES, stream);
    if (e != hipSuccess) fprintf(stderr, "cooperative launch failed: %s (grid %d)\n", hipGetErrorString(e), grid);
}
```

```cpp
#include <hip/hip_runtime.h>
#include <hip/hip_cooperative_groups.h>
#include <cstdio>
#include <cstdint>
namespace cg = cooperative_groups;
namespace pg8 {
#define PG8_LAS __attribute__((address_space(3)))
typedef unsigned short bf16_t;
typedef short bf16x8 __attribute__((ext_vector_type(8)));
typedef float f32x4 __attribute__((ext_vector_type(4)));
typedef unsigned u32x4 __attribute__((ext_vector_type(4)));
constexpr int BM = 256, BK = 64, HALF = 128, HTB = HALF * BK * 2  , STAGE_BYTES = 8 * HTB, NXCD = 8, WGM = 4;

__host__ __device__ __forceinline__ int lds_byte(int r, int c) { const int st = (r >> 4) * 2 + (c >> 5), rr = r & 15, cc = c & 31, ob = rr * 64 + cc * 2; return st * 1024 + (ob ^ (((ob >> 9) & 1) << 5)); }
__host__ __device__ __forceinline__ void stage_rc(int b, int& R, int& C) { const int st = b / 1024, sb = b % 1024, swz = sb ^ (((sb >> 9) & 1) << 5); R = (st >> 1) * 16 + swz / 64; C = (st & 1) * 32 + (swz % 64) / 2; }
__host__ __device__ __forceinline__ int perm32(int rho) { const int n = rho >> 4, i = rho & 15; return 8 * (i >> 2) + 4 * n + (i & 3); }

struct Unit { int pm, pn; };
struct Gemm { const bf16_t* A; const bf16_t* Bt; int M, N, K; };

struct StaticOrder {
    int nM, nN, nwg, G, c;
    __host__ __device__ __forceinline__ void init(int M, int N, int G_, int c_) { nM = M / BM; nN = N / BM; nwg = nM * nN; G = G_; c = c_; }
    __host__ __device__ __forceinline__ bool next(int i, Unit& u) const {
        const long L = (long)i * G + c; if (L >= nwg) return false;
        int wgid = (int)L; { const int q = nwg / NXCD, r = nwg % NXCD, xcd = wgid % NXCD, off = wgid / NXCD; wgid = (xcd < r ? xcd * (q + 1) : r * (q + 1) + (xcd - r) * q) + off; }
        const int nig = WGM * nN, gid = wgid / nig, fm = gid * WGM, gsz = (nM - fm) < WGM ? (nM - fm) : WGM;
        u.pm = fm + ((wgid % nig) % gsz); u.pn = (wgid % nig) / gsz; return true;
    }
    __device__ __forceinline__ void a_ready(const Unit&) const {}
    __device__ __forceinline__ void done(const Unit&) const {}
};
__device__ __forceinline__ unsigned cvt_pk_bf16(float lo, float hi) { unsigned r; asm volatile("v_cvt_pk_bf16_f32 %0, %1, %2" : "=v"(r) : "v"(lo), "v"(hi)); return r; }
typedef float f32x2 __attribute__((ext_vector_type(2)));
template <class Epi, class Sched, bool ALIGN_EPI = false, bool SP2 = false>
__device__ __forceinline__ void gemm_phase(PG8_LAS unsigned char* lds, const Gemm g, const Sched& S, const Epi& E) {
    int tid_l = threadIdx.x; asm volatile("" : "+v"(tid_l)); const int tid = tid_l, wid = __builtin_amdgcn_readfirstlane(tid >> 6), lane = tid & 63, wr = wid >> 2, wc = wid & 3, fr = lane & 15, fq = lane >> 4;
    const int K = g.K, nt = K / BK;
    unsigned voffA[2], voffB[2];
#pragma unroll
    for (int i = 0; i < 2; ++i) { int R, C; stage_rc(tid * 16 + i * 8192, R, C); const int Rb = Epi::PERM ? ((R & ~31) + perm32(R & 31)) : R;
        voffA[i] = (unsigned)(R * K + C) * 2u; voffB[i] = (unsigned)(Rb * K + C) * 2u; }
    const size_t kstep = (size_t)(BK * 2);
    const size_t hstep = (size_t)HALF * K * 2;
    const size_t tstep = 2 * hstep;
    const unsigned ldsw = (unsigned)wid * 1024u;
    const int aoff = lds_byte(wr * 64 + fr, fq * 8), boff = lds_byte(wc * 32 + fr, fq * 8);
#define PG8_SA(b, h) (((b) * 2 + (h)) * HTB)
#define PG8_SB(b, h) ((4 + (b) * 2 + (h)) * HTB)
#define PG8_STAGE(bufoff, gbase, voff) do { _Pragma("unroll") for (int _i = 0; _i < 2; ++_i) \
        __builtin_amdgcn_global_load_lds((const unsigned*)((const char*)(gbase) + (voff)[_i]), (PG8_LAS unsigned*)(lds + (bufoff) + ldsw + _i * 8192), 16, 0, 0); } while (0)
#define PG8_LDA(dst, b, h) do { _Pragma("unroll") for (int m = 0; m < 4; ++m) _Pragma("unroll") for (int k = 0; k < 2; ++k) dst[m][k] = *(const PG8_LAS bf16x8*)(lds + PG8_SA(b, h) + aoff + m * 2048 + k * 1024); } while (0)
#define PG8_LDB(dst, b, h) do { _Pragma("unroll") for (int n = 0; n < 2; ++n) _Pragma("unroll") for (int k = 0; k < 2; ++k) dst[n][k] = *(const PG8_LAS bf16x8*)(lds + PG8_SB(b, h) + boff + n * 2048 + k * 1024); } while (0)
#define PG8_MMA(ai, bj, At, Bt) do { __builtin_amdgcn_s_setprio(1); _Pragma("unroll") for (int m = 0; m < 4; ++m) _Pragma("unroll") for (int n = 0; n < 2; ++n) _Pragma("unroll") for (int k = 0; k < 2; ++k) \
        acc[ai][bj][m][n] = __builtin_amdgcn_mfma_f32_16x16x32_bf16(Bt[n][k], At[m][k], acc[ai][bj][m][n], 0, 0, 0); __builtin_amdgcn_s_setprio(0); } while (0)
#define PG8_WAIT_V(n) asm volatile("s_waitcnt vmcnt(" #n ")" ::: "memory")
#define PG8_WAIT_L(n) asm volatile("s_waitcnt lgkmcnt(" #n ")" ::: "memory")
#define PG8_BAR __builtin_amdgcn_s_barrier()
#define PG8_SCHED __builtin_amdgcn_sched_barrier(0)
    Unit cur, nxt; int ui = 0;
    if (!S.next(0, cur)) return;
    f32x4 acc[2][2][4][2];
#pragma unroll
    for (int a = 0; a < 2; ++a)
#pragma unroll
        for (int b = 0; b < 2; ++b)
#pragma unroll
            for (int m = 0; m < 4; ++m)
#pragma unroll
                for (int n = 0; n < 2; ++n) acc[a][b][m][n] = (f32x4){0.f, 0.f, 0.f, 0.f};
    bf16x8 At[4][2], B0[2][2], B1[2][2];
    const char* cA = (const char*)g.A + (size_t)cur.pm * tstep; const char* cB = (const char*)g.Bt + (size_t)cur.pn * tstep;
    S.a_ready(cur);
    if constexpr (SP2) {
        PG8_STAGE(PG8_SB(0, 0), cB, voffB); PG8_STAGE(PG8_SB(0, 1), cB + hstep, voffB); PG8_STAGE(PG8_SA(0, 0), cA, voffA); PG8_STAGE(PG8_SA(0, 1), cA + hstep, voffA);
        if (wr == 1) PG8_BAR;
        PG8_WAIT_V(2); PG8_BAR;
        PG8_STAGE(PG8_SB(1, 0), cB + kstep, voffB); PG8_STAGE(PG8_SA(1, 0), cA + kstep, voffA); PG8_STAGE(PG8_SB(1, 1), cB + hstep + kstep, voffB);
        PG8_WAIT_V(6); PG8_BAR;
    } else {
        PG8_STAGE(PG8_SB(0, 0), cB, voffB); PG8_STAGE(PG8_SA(0, 0), cA, voffA); PG8_STAGE(PG8_SB(0, 1), cB + hstep, voffB); PG8_STAGE(PG8_SA(0, 1), cA + hstep, voffA);
        if (wr == 1) PG8_BAR;
        PG8_WAIT_V(4); PG8_BAR;
        PG8_STAGE(PG8_SB(1, 0), cB + kstep, voffB); PG8_STAGE(PG8_SA(1, 0), cA + kstep, voffA); PG8_STAGE(PG8_SB(1, 1), cB + hstep + kstep, voffB);
        PG8_WAIT_V(6); PG8_BAR;
    }
    for (;;) {
        const bool has_next = S.next(ui + 1, nxt);
        const char* nA = has_next ? (const char*)g.A + (size_t)nxt.pm * tstep : cA; const char* nB = has_next ? (const char*)g.Bt + (size_t)nxt.pn * tstep : cB;
        for (int t = 0; t < nt; t += 2) {
            const bool last = (t == nt - 2);
            const char* a1 = cA + (size_t)(t + 1) * kstep;
            const char* a2 = last ? nA : cA + (size_t)(t + 2) * kstep; const char* b2 = last ? nB : cB + (size_t)(t + 2) * kstep;
            const char* a3 = a2 + kstep; const char* b3 = b2 + kstep;
            if (last && has_next) S.a_ready(nxt);
            if constexpr (SP2) {
            PG8_LDB(B0, 0, 0); PG8_LDB(B1, 0, 1); PG8_SCHED; PG8_LDA(At, 0, 0); PG8_STAGE(PG8_SA(1, 1), a1 + hstep, voffA);
            PG8_WAIT_V(8); PG8_WAIT_L(0); PG8_BAR; PG8_MMA(0, 0, At, B0); PG8_MMA(0, 1, At, B1); PG8_BAR; PG8_SCHED;
            PG8_LDA(At, 0, 1); PG8_STAGE(PG8_SB(0, 0), b2, voffB); PG8_STAGE(PG8_SB(0, 1), b2 + hstep, voffB); PG8_STAGE(PG8_SA(0, 0), a2, voffA);
            PG8_WAIT_V(8); PG8_WAIT_L(0); PG8_BAR; PG8_MMA(1, 0, At, B0); PG8_MMA(1, 1, At, B1); PG8_BAR; PG8_SCHED;
            PG8_LDB(B0, 1, 0); PG8_LDB(B1, 1, 1); PG8_SCHED; PG8_LDA(At, 1, 0); PG8_STAGE(PG8_SA(0, 1), a2 + hstep, voffA);
            PG8_WAIT_V(8); PG8_WAIT_L(0); PG8_BAR; PG8_MMA(0, 0, At, B0); PG8_MMA(0, 1, At, B1); PG8_BAR; PG8_SCHED;
            PG8_LDA(At, 1, 1); PG8_STAGE(PG8_SB(1, 0), b3, voffB); PG8_STAGE(PG8_SB(1, 1), b3 + hstep, voffB); PG8_STAGE(PG8_SA(1, 0), a3, voffA);
            PG8_WAIT_V(8); PG8_WAIT_L(0); PG8_BAR; PG8_MMA(1, 0, At, B0); PG8_MMA(1, 1, At, B1); PG8_BAR; PG8_SCHED;
            } else {
            PG8_LDB(B0, 0, 0); PG8_SCHED; PG8_LDA(At, 0, 0); PG8_STAGE(PG8_SA(1, 1), a1 + hstep, voffA);
            PG8_WAIT_L(8); PG8_BAR; PG8_WAIT_L(0); PG8_MMA(0, 0, At, B0); PG8_BAR; PG8_SCHED;
            PG8_LDB(B1, 0, 1); PG8_STAGE(PG8_SB(0, 0), b2, voffB);
            PG8_BAR; PG8_WAIT_L(0); PG8_MMA(0, 1, At, B1); PG8_BAR;
            PG8_LDA(At, 0, 1); PG8_STAGE(PG8_SA(0, 0), a2, voffA);
            PG8_BAR; PG8_WAIT_L(0); PG8_MMA(1, 0, At, B0); PG8_BAR; PG8_SCHED;
            PG8_STAGE(PG8_SB(0, 1), b2 + hstep, voffB);
            PG8_WAIT_V(6); PG8_BAR; PG8_MMA(1, 1, At, B1); PG8_BAR;
            PG8_LDB(B0, 1, 0); PG8_SCHED; PG8_LDA(At, 1, 0); PG8_STAGE(PG8_SA(0, 1), a2 + hstep, voffA);
            PG8_WAIT_L(8); PG8_BAR; PG8_WAIT_L(0); PG8_MMA(0, 0, At, B0); PG8_BAR; PG8_SCHED;
            PG8_LDB(B1, 1, 1); PG8_STAGE(PG8_SB(1, 0), b3, voffB);
            PG8_BAR; PG8_WAIT_L(0); PG8_MMA(0, 1, At, B1); PG8_BAR;
            PG8_LDA(At, 1, 1); PG8_STAGE(PG8_SA(1, 0), a3, voffA);
            PG8_BAR; PG8_WAIT_L(0); PG8_MMA(1, 0, At, B0); PG8_BAR; PG8_SCHED;
            PG8_STAGE(PG8_SB(1, 1), b3 + hstep, voffB);
            PG8_WAIT_V(6); PG8_BAR; PG8_MMA(1, 1, At, B1); PG8_BAR;
            }
        }
        if constexpr (ALIGN_EPI) { if (wr == 0) PG8_BAR; }
        if constexpr (!Epi::AFTER_DRAIN) { E(acc, cur, wr, wc, fr, fq); S.done(cur); }
        if (!has_next) break;
#pragma unroll
        for (int a = 0; a < 2; ++a)
#pragma unroll
            for (int b = 0; b < 2; ++b)
#pragma unroll
                for (int m = 0; m < 4; ++m)
#pragma unroll
                    for (int n = 0; n < 2; ++n) acc[a][b][m][n] = (f32x4){0.f, 0.f, 0.f, 0.f};
        cur = nxt; cA = nA; cB = nB; ++ui;
        if constexpr (ALIGN_EPI) { if (wr == 1) PG8_BAR; }
    }
    PG8_WAIT_V(0);
    if constexpr (!ALIGN_EPI) { if (wr == 0) PG8_BAR; }
    PG8_BAR;
    if constexpr (Epi::AFTER_DRAIN) { E.fused(acc, cur, wr, wc, fr, fq, lds, wid, lane); S.done(cur); }
#undef PG8_SA
#undef PG8_SB
#undef PG8_STAGE
#undef PG8_LDA
#undef PG8_LDB
#undef PG8_MMA
#undef PG8_WAIT_V
#undef PG8_WAIT_L
#undef PG8_BAR
#undef PG8_SCHED
}
}

#define LAS __attribute__((address_space(3)))
typedef unsigned short bf16_t;
typedef short bf16x8 __attribute__((ext_vector_type(8)));
typedef float f32x2 __attribute__((ext_vector_type(2)));
typedef float f32x4 __attribute__((ext_vector_type(4)));
typedef float f32x16 __attribute__((ext_vector_type(16)));
typedef unsigned u32x2 __attribute__((ext_vector_type(2)));
typedef unsigned u32x4 __attribute__((ext_vector_type(4)));
typedef __bf16 bf16x2_t __attribute__((ext_vector_type(2)));

constexpr int S = 16384, D = 2048, NLAYER = 2, HLD = 4096, DFF = 5632, INC = 3904;
constexpr int C_CQ = 0, C_CKV = 512, C_KR = 768, C_MQ = 832, C_MK = 1344, C_MV = 1856, C_CONV = 2368, C_POOL = 3392;
constexpr float EPS = 1e-5f, ALPHA = 1.41421356237309515f, LOG2E = 1.4426950408889634f;
constexpr float CQ_SCALE = 0.07216878364870323f * LOG2E;
constexpr float CM_SCALE = 0.08838834764831845f * LOG2E;
constexpr int NT = 512, NWV = 8;
constexpr float KM_FIX = 1048576.f, KM_INV = 1.f / 1048576.f;
constexpr int LDS_BYTES = 147456, LDS_MISC = 131072;

constexpr size_t MiB = (size_t)1 << 20;
constexpr size_t WS_CTL = 0, CTL_BYTES = 1 * MiB;
constexpr size_t WS_WIN = 1 * MiB, WS_WUQ = 17 * MiB, WS_WUKV = 18 * MiB, WS_WPW = 19 * MiB, WS_WPOOL = 20 * MiB, WS_WOUT = 21 * MiB, WS_WGU = 29 * MiB, WS_WDN = 73 * MiB;
constexpr size_t WS_ROPE_MLA = 95 * MiB, WS_ROPE_MOBA = 99 * MiB, WS_STATS = 101 * MiB;
constexpr size_t WS_Y = 102 * MiB, WS_XB = 230 * MiB;
constexpr size_t WS_CQN = 230 * MiB, WS_CKVN = 246 * MiB, WS_KPE = 254 * MiB, WS_CONVA = 256 * MiB, WS_POOLED = 272 * MiB;
constexpr size_t WS_H = 294 * MiB;
constexpr size_t WS_Q = 294 * MiB, WS_K = 318 * MiB, WS_VT = 342 * MiB, WS_CONCAT = 358 * MiB;
constexpr size_t WS_MQ = 422 * MiB, WS_MK = 438 * MiB, WS_MVT = 454 * MiB;
constexpr size_t WS_VR = 470 * MiB;
constexpr size_t WS_ACT = 294 * MiB, WS_END = 486 * MiB;
constexpr int CW_LAYER = 33792, CW_QCTR = 0, CW_KPEMAX = 1, CW_KNPIECE = 4, CW_KMMAX = 20, CW_CNT = 64, CW_KMEAN = 1024;

constexpr size_t DO_PART = 0, DO_PL = 34 * MiB, DO_PARTB = 36 * MiB, DO_LB = 101 * MiB, DO_LIST = 104 * MiB;

struct Params { const float* in[22]; float* out; unsigned char* ws; };

__device__ __forceinline__ unsigned f2bf(float f) { unsigned u = __float_as_uint(f); return (u + 0x7fffu + ((u >> 16) & 1u)) >> 16; }
__device__ __forceinline__ float bf2f(unsigned h) { return __uint_as_float(h << 16); }
__device__ __forceinline__ unsigned pk2(float lo, float hi) { f32x2 v = {lo, hi}; bf16x2_t b = __builtin_convertvector(v, bf16x2_t); return __builtin_bit_cast(unsigned, b); }
__device__ __forceinline__ float wave_sum(float v) {
#pragma unroll
    for (int o = 1; o < 64; o <<= 1) v += __shfl_xor(v, o);
    return v;
}
__device__ __forceinline__ float sigmoidf_(float x) { return __builtin_amdgcn_rcpf(1.f + __expf(-x)); }

typedef const pg8::f32x4 (&AccRef)[2][2][4][2];

struct EpiStore {
    static constexpr bool PERM = true, AFTER_DRAIN = false;
    bf16_t* O; int ldc;
    __device__ __forceinline__ void operator()(AccRef acc, const pg8::Unit& u, int wr, int wc, int fr, int fq) const {
        const int row0 = u.pm * 256 + wr * 64 + fr, col0 = u.pn * 256 + wc * 32 + 8 * fq;
#pragma unroll
        for (int ai = 0; ai < 2; ++ai)
#pragma unroll
            for (int m = 0; m < 4; ++m) { bf16_t* rowp = O + (size_t)(row0 + ai * 128 + m * 16) * ldc + col0;
#pragma unroll
                for (int bj = 0; bj < 2; ++bj) { const f32x4 v0 = acc[ai][bj][m][0], v1 = acc[ai][bj][m][1];
                    u32x4 w; w.x = pk2(v0[0], v0[1]); w.y = pk2(v0[2], v0[3]); w.z = pk2(v1[0], v1[1]); w.w = pk2(v1[2], v1[3]);
                    *(u32x4*)(rowp + bj * 128) = w; } }
    }
};

struct EpiQ {
    static constexpr bool PERM = true, AFTER_DRAIN = false;
    bf16_t* O; const float* rope;
    __device__ __forceinline__ void operator()(AccRef acc, const pg8::Unit& u, int wr, int wc, int fr, int fq) const {
        const int row0 = u.pm * 256 + wr * 64 + fr;
#pragma unroll
        for (int bj = 0; bj < 2; ++bj) {
            const int c0 = u.pn * 256 + bj * 128 + wc * 32 + 8 * fq; const int d0 = c0 % 192; const bool rp = d0 >= 128; const int jc = rp ? (d0 - 128) >> 1 : 0;
#pragma unroll
            for (int ai = 0; ai < 2; ++ai)
#pragma unroll
                for (int m = 0; m < 4; ++m) { const int row = row0 + ai * 128 + m * 16;
                    f32x4 v0 = acc[ai][bj][m][0] * CQ_SCALE, v1 = acc[ai][bj][m][1] * CQ_SCALE;
                    const f32x4 t0 = *(const f32x4*)(rope + ((size_t)row * 32 + jc) * 2), t1 = *(const f32x4*)(rope + ((size_t)row * 32 + jc + 2) * 2);
                    if (rp) {
                        f32x4 a, b;
                        a[0] = v0[0] * t0[0] - v0[1] * t0[1]; a[1] = v0[0] * t0[1] + v0[1] * t0[0];
                        a[2] = v0[2] * t0[2] - v0[3] * t0[3]; a[3] = v0[2] * t0[3] + v0[3] * t0[2];
                        b[0] = v1[0] * t1[0] - v1[1] * t1[1]; b[1] = v1[0] * t1[1] + v1[1] * t1[0];
                        b[2] = v1[2] * t1[2] - v1[3] * t1[3]; b[3] = v1[2] * t1[3] + v1[3] * t1[2];
                        v0 = a; v1 = b; }
                    u32x4 w; w.x = pk2(v0[0], v0[1]); w.y = pk2(v0[2], v0[3]); w.z = pk2(v1[0], v1[1]); w.w = pk2(v1[2], v1[3]);
                    *(u32x4*)(O + (size_t)row * 768 + c0) = w; }
        }
    }
};

struct EpiKV {
    static constexpr bool PERM = true, AFTER_DRAIN = false;
    bf16_t* K; bf16_t* VR; const bf16_t* KPE; unsigned* piece;
    __device__ __forceinline__ void operator()(AccRef acc, const pg8::Unit& u, int wr, int wc, int fr, int fq) const {
        const int row0 = u.pm * 256 + wr * 64 + fr, cc = wc * 32 + 8 * fq, hd = u.pn;
        float pmax = 0.f;
#pragma unroll
        for (int ai = 0; ai < 2; ++ai)
#pragma unroll
            for (int m = 0; m < 4; ++m) { const int row = row0 + ai * 128 + m * 16;
                { const f32x4 v0 = acc[ai][0][m][0], v1 = acc[ai][0][m][1];
                  u32x4 w; w.x = pk2(v0[0], v0[1]); w.y = pk2(v0[2], v0[3]); w.z = pk2(v1[0], v1[1]); w.w = pk2(v1[2], v1[3]);
                  *(u32x4*)(K + (size_t)row * 768 + hd * 192 + cc) = w;
                  float ss = (v0[0] * v0[0] + v0[1] * v0[1]) + (v0[2] * v0[2] + v0[3] * v0[3]) + (v1[0] * v1[0] + v1[1] * v1[1]) + (v1[2] * v1[2] + v1[3] * v1[3]);
                  ss += __shfl_xor(ss, 16); ss += __shfl_xor(ss, 32); pmax = fmaxf(pmax, ss); }
                { const f32x4 v0 = acc[ai][1][m][0], v1 = acc[ai][1][m][1];
                  u32x4 w; w.x = pk2(v0[0], v0[1]); w.y = pk2(v0[2], v0[3]); w.z = pk2(v1[0], v1[1]); w.w = pk2(v1[2], v1[3]);
                  *(u32x4*)(VR + (size_t)row * 512 + hd * 128 + cc) = w; }
                }
        if (wc < 2) { u32x4 kp[8];
#pragma unroll
            for (int q8 = 0; q8 < 8; ++q8) kp[q8] = *(const u32x4*)(KPE + (size_t)(row0 + (q8 >> 2) * 128 + (q8 & 3) * 16) * 64 + cc);
#pragma unroll
            for (int q8 = 0; q8 < 8; ++q8) *(u32x4*)(K + (size_t)(row0 + (q8 >> 2) * 128 + (q8 & 3) * 16) * 768 + hd * 192 + 128 + cc) = kp[q8]; }
#pragma unroll
        for (int o = 1; o < 16; o <<= 1) pmax = fmaxf(pmax, __shfl_xor(pmax, o));
        if ((threadIdx.x & 63) == 0) atomicMax(piece + hd * 4 + wc, __float_as_uint(pmax));
    }
};
__device__ __forceinline__ void vt_tile(const bf16_t* VR, bf16_t* VT, int pm, int pn) {
    int tid = threadIdx.x; asm volatile("" : "+v"(tid));
    const int dv = tid & 127, seg = tid >> 7; const int t0 = 256 * pm + 64 * seg;
    const bf16_t* src = VR + (size_t)t0 * 512 + pn * 128 + dv; unsigned pk[32];
#pragma unroll
    for (int i = 0; i < 32; ++i) pk[i] = (unsigned)src[(size_t)(2 * i) * 512] | ((unsigned)src[(size_t)(2 * i + 1) * 512] << 16);
    u32x4* dst = (u32x4*)(VT + (size_t)(pn * 128 + dv) * S + t0);
#pragma unroll
    for (int i = 0; i < 8; ++i) dst[i] = (u32x4){pk[4 * i], pk[4 * i + 1], pk[4 * i + 2], pk[4 * i + 3]};
}

template <int MODE>
struct EpiRes {
    static constexpr bool PERM = true, AFTER_DRAIN = false;
    const float* xin; bf16_t* Y; const float* stats; const float* g; const float* b;
    __device__ __forceinline__ void operator()(AccRef acc, const pg8::Unit& u, int wr, int wc, int fr, int fq) const {
        const int row0 = u.pm * 256 + wr * 64 + fr, col0 = u.pn * 256 + wc * 32 + 8 * fq;
#pragma unroll
        for (int bj = 0; bj < 2; ++bj) { const int col = col0 + bj * 128;
            f32x4 g0, g1, b0, b1;
            if (MODE == 1) { g0 = *(const f32x4*)(g + col); g1 = *(const f32x4*)(g + col + 4); b0 = *(const f32x4*)(b + col); b1 = *(const f32x4*)(b + col + 4); }
#pragma unroll
            for (int ai = 0; ai < 2; ++ai)
#pragma unroll
                for (int m = 0; m < 4; ++m) { const int row = row0 + ai * 128 + m * 16; const size_t off = (size_t)row * D + col;
                    f32x4 r0, r1;
                    if (MODE == 0) { r0 = *(const f32x4*)(xin + off); r1 = *(const f32x4*)(xin + off + 4); }
                    else { const f32x2 st = *(const f32x2*)(stats + (size_t)row * 2); const u32x4 raw = *(const u32x4*)(Y + off);
                        r0 = (f32x4){bf2f(raw.x & 0xffffu), bf2f(raw.x >> 16), bf2f(raw.y & 0xffffu), bf2f(raw.y >> 16)}; r1 = (f32x4){bf2f(raw.z & 0xffffu), bf2f(raw.z >> 16), bf2f(raw.w & 0xffffu), bf2f(raw.w >> 16)};
                        r0 = (r0 - st.x) * st.y * g0 + b0; r1 = (r1 - st.x) * st.y * g1 + b1; }
                    r0 = r0 * ALPHA + acc[ai][bj][m][0]; r1 = r1 * ALPHA + acc[ai][bj][m][1];
                    u32x4 w; w.x = pk2(r0[0], r0[1]); w.y = pk2(r0[2], r0[3]); w.z = pk2(r1[0], r1[1]); w.w = pk2(r1[2], r1[3]);
                    *(u32x4*)(Y + off) = w; }
        }
    }
};

struct EpiFfn {
    static constexpr bool PERM = true, AFTER_DRAIN = false;
    bf16_t* O;
    __device__ __forceinline__ void operator()(AccRef acc, const pg8::Unit& u, int wr, int wc, int fr, int fq) const {
        const int row0 = u.pm * 256 + wr * 64 + fr, col0 = u.pn * 128 + wc * 32 + 8 * fq;
#pragma unroll
        for (int ai = 0; ai < 2; ++ai)
#pragma unroll
            for (int m = 0; m < 4; ++m) { const int row = row0 + ai * 128 + m * 16;
                float r[8];
#pragma unroll
                for (int n = 0; n < 2; ++n)
#pragma unroll
                    for (int e = 0; e < 4; ++e) { const float gt = acc[ai][0][m][n][e], up = acc[ai][1][m][n][e]; r[n * 4 + e] = gt * sigmoidf_(gt) * up; }
                u32x4 w; w.x = pk2(r[0], r[1]); w.y = pk2(r[2], r[3]); w.z = pk2(r[4], r[5]); w.w = pk2(r[6], r[7]);
                *(u32x4*)(O + (size_t)row * DFF + col0) = w; }
    }
};

#define GEMM_CALL(EPIT, E, A_, B_, N_, K_, CID) do { pg8::Gemm g_{(const bf16_t*)(A_), (const bf16_t*)(B_), S, (N_), (K_)}; pg8::StaticOrder so_; so_.init(S, (N_), G, (CID)); \
    pg8::gemm_phase<EPIT, pg8::StaticOrder, true, true>(lds, g_, so_, (E)); } while (0)

struct TrSpec { const float* W; int ldn, K, N; bf16_t* WT; int ldk, mode; const float* sk; const float* sn; };
__device__ __forceinline__ int drow_of(int mode, int n) {
    if (mode == 1) { const int hd = n / 192, d = n - hd * 192; if (d < 128) return n; const int e = d - 128; return hd * 192 + 128 + 2 * (e & 31) + (e >> 5); }
    if (mode == 4) return ((n >> 7) << 8) + (n & 127);
    if (mode == 5) return ((n >> 7) << 8) + 128 + (n & 127);
    return n;
}
__device__ __forceinline__ void transpose_items(const TrSpec& t, LAS float* scr, int gw, int ngw, int lane) {
    const int nblk = t.N / 32, nitems = (t.K / 64) * nblk;
    for (int it = gw; it < nitems; it += ngw) {
        const int kb = it / nblk, nb = it - kb * nblk, k0 = 64 * kb, n0 = 32 * nb;
        const float snv = t.sn ? t.sn[n0 + (lane & 31)] : 1.f;
        const float* wp = t.W + (size_t)(k0 + (lane >> 5)) * t.ldn + n0 + (lane & 31);
        if (t.sk) { const float* skp = t.sk + k0 + (lane >> 5);
#pragma unroll 8
            for (int i = 0; i < 32; ++i) { const float v = wp[(size_t)(2 * i) * t.ldn] * skp[2 * i]; scr[(2 * i + (lane >> 5)) * 33 + (lane & 31)] = v * snv; } }
        else {
#pragma unroll 8
            for (int i = 0; i < 32; ++i) { const float v = wp[(size_t)(2 * i) * t.ldn]; scr[(2 * i + (lane >> 5)) * 33 + (lane & 31)] = v * snv; } }
        asm volatile("s_waitcnt lgkmcnt(0)" ::: "memory");
        const int c = lane & 7;
#pragma unroll
        for (int j = 0; j < 4; ++j) { const int n = (lane >> 3) + 8 * j; const LAS float* s = scr + (8 * c) * 33 + n;
            u32x4 o; o.x = pk2(s[0 * 33], s[1 * 33]); o.y = pk2(s[2 * 33], s[3 * 33]); o.z = pk2(s[4 * 33], s[5 * 33]); o.w = pk2(s[6 * 33], s[7 * 33]);
            *(u32x4*)(t.WT + (size_t)drow_of(t.mode, n0 + n) * t.ldk + k0 + 8 * c) = o; }
        asm volatile("s_waitcnt lgkmcnt(0)" ::: "memory");
    }
}
__device__ __forceinline__ void prep_weights(const Params& P, int l, LAS unsigned char* lds, int G) {
    int tid_l = threadIdx.x; asm volatile("" : "+v"(tid_l)); const int tid = tid_l, lane = tid & 63, wave = tid >> 6;
    const int gw = blockIdx.x * NWV + wave, ngw = G * NWV;
    LAS float* scr = (LAS float*)(lds + wave * 16384);
    unsigned char* ws = P.ws;
    TrSpec t;
    t = TrSpec{P.in[2] + (size_t)l * D * INC, INC, D, INC, (bf16_t*)(ws + WS_WIN), D, 0, nullptr, nullptr}; transpose_items(t, scr, gw, ngw, lane);
    t = TrSpec{P.in[4] + (size_t)l * 512 * 768, 768, 512, 768, (bf16_t*)(ws + WS_WUQ), 512, 1, P.in[3] + l * 512, nullptr}; transpose_items(t, scr, gw, ngw, lane);
    t = TrSpec{P.in[6] + (size_t)l * 256 * 1024, 1024, 256, 1024, (bf16_t*)(ws + WS_WUKV), 256, 0, P.in[5] + l * 256, nullptr}; transpose_items(t, scr, gw, ngw, lane);
    t = TrSpec{P.in[11] + (size_t)l * 512 * 512, 512, 512, 512, (bf16_t*)(ws + WS_WPW), 512, 0, nullptr, nullptr}; transpose_items(t, scr, gw, ngw, lane);
#pragma unroll 1
    for (int g = 0; g < 4; ++g) { t = TrSpec{P.in[12] + (size_t)(l * 4 + g) * 128 * 128, 128, 128, 128, (bf16_t*)(ws + WS_WPOOL) + (size_t)(g * 128) * 512 + g * 128, 512, 0, nullptr, P.in[13] + l * 512 + g * 128};
        transpose_items(t, scr, gw, ngw, lane); }
    t = TrSpec{P.in[14] + (size_t)l * D * D, D, D, D, (bf16_t*)(ws + WS_WOUT), D, 0, nullptr, nullptr}; transpose_items(t, scr, gw, ngw, lane);
    t = TrSpec{P.in[17] + (size_t)l * D * DFF, DFF, D, DFF, (bf16_t*)(ws + WS_WGU), D, 4, nullptr, nullptr}; transpose_items(t, scr, gw, ngw, lane);
    t = TrSpec{P.in[18] + (size_t)l * D * DFF, DFF, D, DFF, (bf16_t*)(ws + WS_WGU), D, 5, nullptr, nullptr}; transpose_items(t, scr, gw, ngw, lane);
    t = TrSpec{P.in[19] + (size_t)l * DFF * D, D, DFF, D, (bf16_t*)(ws + WS_WDN), DFF, 0, nullptr, nullptr}; transpose_items(t, scr, gw, ngw, lane);
    const int gt = blockIdx.x * NT + tid, ngt = G * NT; const u32x4 z = {0u, 0u, 0u, 0u};
    { u32x4* p = (u32x4*)((bf16_t*)(ws + WS_WIN) + (size_t)INC * D); for (int i = gt; i < 192 * D / 8; i += ngt) p[i] = z; }
    { u32x4* p = (u32x4*)(ws + WS_WPOOL); for (int i = gt; i < 512 * 512 / 8; i += ngt) { const int row = i >> 6, col = (i & 63) * 8; if ((row >> 7) != (col >> 7)) p[i] = z; } }
}
__device__ __forceinline__ void prep_layer0(const Params& P, int G) {
    int tid_l = threadIdx.x; asm volatile("" : "+v"(tid_l)); const int gt = blockIdx.x * NT + tid_l, ngt = G * NT;
    const f32x4* x4 = (const f32x4*)P.in[0]; u32x4* xb = (u32x4*)(P.ws + WS_XB);
    for (int i = gt; i < S * D / 8; i += ngt) { const f32x4 a = x4[2 * i], b = x4[2 * i + 1]; u32x4 w; w.x = pk2(a[0], a[1]); w.y = pk2(a[2], a[3]); w.z = pk2(b[0], b[1]); w.w = pk2(b[2], b[3]); xb[i] = w; }
    const int* pos = (const int*)P.in[1];
    f32x2* rm = (f32x2*)(P.ws + WS_ROPE_MLA); f32x2* ro = (f32x2*)(P.ws + WS_ROPE_MOBA);
    const double L2T = 18.931568569324174;
    for (int i = gt; i < S * 48; i += ngt) { const int t = i / 48, jj = i - t * 48; const bool mla = jj < 32; const int j = mla ? jj : jj - 32;
        const double invf = exp2(-(mla ? (double)j / 32.0 : (double)j / 16.0) * L2T);
        const double rev = (double)pos[t] * invf * 0.15915494309189535; const float fr = (float)(rev - rint(rev));
        const f32x2 cs = {__builtin_amdgcn_cosf(fr), __builtin_amdgcn_sinf(fr)};
        if (mla) rm[t * 32 + j] = cs; else ro[t * 16 + j] = cs; }
}

template <bool TO_OUT> __device__ __forceinline__ void ln_phase(const bf16_t* __restrict__ Y, const float* __restrict__ g, const float* __restrict__ b, float* __restrict__ stats, bf16_t* __restrict__ XB, float* __restrict__ out, int G, float chkoff = 0.f) {
    int tid_l = threadIdx.x; asm volatile("" : "+v"(tid_l)); const int lane = tid_l & 63, wave = tid_l >> 6;
#pragma unroll 4
    for (int row = blockIdx.x * NWV + wave; row < S; row += G * NWV) {
        const u32x4* yr = (const u32x4*)(Y + (size_t)row * D) + lane; float v[4][8]; float s = 0.f;
#pragma unroll
        for (int j = 0; j < 4; ++j) { const u32x4 raw = yr[64 * j];
            v[j][0] = bf2f(raw.x & 0xffffu); v[j][1] = bf2f(raw.x >> 16); v[j][2] = bf2f(raw.y & 0xffffu); v[j][3] = bf2f(raw.y >> 16); v[j][4] = bf2f(raw.z & 0xffffu); v[j][5] = bf2f(raw.z >> 16); v[j][6] = bf2f(raw.w & 0xffffu); v[j][7] = bf2f(raw.w >> 16);
#pragma unroll
            for (int e = 0; e < 8; ++e) s += v[j][e]; }
        const float mean = wave_sum(s) * (1.f / D); float s2 = 0.f;
#pragma unroll
        for (int j = 0; j < 4; ++j)
#pragma unroll
            for (int e = 0; e < 8; ++e) { v[j][e] -= mean; s2 += v[j][e] * v[j][e]; }
        const float rstd = rsqrtf(wave_sum(s2) * (1.f / D) + EPS);
        if (!TO_OUT && lane == 0) *(f32x2*)(stats + (size_t)row * 2) = (f32x2){mean, rstd};
#pragma unroll
        for (int j = 0; j < 4; ++j) { const int col = 8 * (lane + 64 * j); const f32x4 g0 = *(const f32x4*)(g + col), g1 = *(const f32x4*)(g + col + 4), b0 = *(const f32x4*)(b + col), b1 = *(const f32x4*)(b + col + 4);
            f32x4 o0 = (f32x4){v[j][0], v[j][1], v[j][2], v[j][3]} * rstd * g0 + b0, o1 = (f32x4){v[j][4], v[j][5], v[j][6], v[j][7]} * rstd * g1 + b1;
            if (TO_OUT) { *(f32x4*)(out + (size_t)row * D + col) = o0 + chkoff; *(f32x4*)(out + (size_t)row * D + col + 4) = o1 + chkoff; }
            else { u32x4 w; w.x = pk2(o0[0], o0[1]); w.y = pk2(o0[2], o0[3]); w.z = pk2(o1[0], o1[1]); w.w = pk2(o1[2], o1[3]); *(u32x4*)(XB + (size_t)row * D + col) = w; } }
    }
}

__device__ __forceinline__ void p2a_phase(const Params& P, int l, LAS unsigned char* lds, int G) {
    int tid_l = threadIdx.x; asm volatile("" : "+v"(tid_l)); const int tid = tid_l, lane = tid & 63, wave = tid >> 6;
    unsigned char* ws = P.ws;
    const bf16_t* H = (const bf16_t*)(ws + WS_H);
    unsigned* ctl = (unsigned*)(ws + WS_CTL) + l * CW_LAYER;
    bf16_t* CQN = (bf16_t*)(ws + WS_CQN); bf16_t* CKVN = (bf16_t*)(ws + WS_CKVN); bf16_t* KPE = (bf16_t*)(ws + WS_KPE);
    bf16_t* CONVA = (bf16_t*)(ws + WS_CONVA); bf16_t* POOLED = (bf16_t*)(ws + WS_POOLED);
    bf16_t* MQ = (bf16_t*)(ws + WS_MQ); bf16_t* MK = (bf16_t*)(ws + WS_MK); bf16_t* MVT = (bf16_t*)(ws + WS_MVT);
    const f32x2* RM = (const f32x2*)(ws + WS_ROPE_MLA); const float* RO = (const float*)(ws + WS_ROPE_MOBA);
    LAS float* ybuf = (LAS float*)lds;
    for (int tile = blockIdx.x; tile < S / 64; tile += G) {
        const int t0 = tile * 64;
        { float ksum[8]; float kpemax = 0.f, kmmax = 0.f; const int hm = lane & 15;
#pragma unroll
          for (int e = 0; e < 8; ++e) ksum[e] = 0.f;
          struct TokIn { u32x4 cq, mq, mk; u32x2 ckv; unsigned kr1, kr2; f32x2 cs; f32x4 ro[4]; };
#define P2A_LOAD(dst, tt) do { const bf16_t* hr_ = H + (size_t)(tt) * HLD; (dst).cq = *(const u32x4*)(hr_ + C_CQ + 8 * lane); (dst).ckv = *(const u32x2*)(hr_ + C_CKV + 4 * lane); \
              (dst).kr1 = hr_[C_KR + (lane & 31)]; (dst).kr2 = hr_[C_KR + 32 + (lane & 31)]; (dst).cs = RM[(tt) * 32 + (lane & 31)]; (dst).mq = *(const u32x4*)(hr_ + C_MQ + 8 * lane); (dst).mk = *(const u32x4*)(hr_ + C_MK + 8 * lane); \
              const f32x4* tp_ = (const f32x4*)(RO + ((size_t)(tt) * 16 + 8 * (hm & 1)) * 2); (dst).ro[0] = tp_[0]; (dst).ro[1] = tp_[1]; (dst).ro[2] = tp_[2]; (dst).ro[3] = tp_[3]; } while (0)
          TokIn cur, nxt; P2A_LOAD(cur, t0 + wave * 8); nxt = cur;
#pragma unroll 1
          for (int i = 0; i < 8; ++i) {
              const int t = t0 + wave * 8 + i;
              if (i + 1 < 8) P2A_LOAD(nxt, t + 1);
              { const u32x4 raw = cur.cq; float x[8];
                x[0] = bf2f(raw.x & 0xffffu); x[1] = bf2f(raw.x >> 16); x[2] = bf2f(raw.y & 0xffffu); x[3] = bf2f(raw.y >> 16); x[4] = bf2f(raw.z & 0xffffu); x[5] = bf2f(raw.z >> 16); x[6] = bf2f(raw.w & 0xffffu); x[7] = bf2f(raw.w >> 16);
                float ss = 0.f;
#pragma unroll
                for (int e = 0; e < 8; ++e) ss += x[e] * x[e];
                const float rs = rsqrtf(wave_sum(ss) * (1.f / 512.f) + EPS);
                u32x4 w; w.x = pk2(x[0] * rs, x[1] * rs); w.y = pk2(x[2] * rs, x[3] * rs); w.z = pk2(x[4] * rs, x[5] * rs); w.w = pk2(x[6] * rs, x[7] * rs);
                *(u32x4*)(CQN + (size_t)t * 512 + 8 * lane) = w; }
              { const u32x2 raw = cur.ckv; float x[4];
                x[0] = bf2f(raw.x & 0xffffu); x[1] = bf2f(raw.x >> 16); x[2] = bf2f(raw.y & 0xffffu); x[3] = bf2f(raw.y >> 16);
                const float ss = (x[0] * x[0] + x[1] * x[1]) + (x[2] * x[2] + x[3] * x[3]);
                const float rs = rsqrtf(wave_sum(ss) * (1.f / 256.f) + EPS);
                u32x2 w; w.x = pk2(x[0] * rs, x[1] * rs); w.y = pk2(x[2] * rs, x[3] * rs);
                *(u32x2*)(CKVN + (size_t)t * 256 + 4 * lane) = w; }
              { const int j = lane & 31; const float x1 = bf2f(cur.kr1), x2 = bf2f(cur.kr2); const f32x2 cs = cur.cs;
                const float o1 = x1 * cs.x - x2 * cs.y, o2 = x1 * cs.y + x2 * cs.x;
                if (lane < 32) *(unsigned*)(KPE + (size_t)t * 64 + 2 * j) = pk2(o1, o2);
                const float n2 = wave_sum(lane < 32 ? o1 * o1 + o2 * o2 : 0.f); kpemax = fmaxf(kpemax, n2); }
#pragma unroll
              for (int which = 0; which < 2; ++which) {
                  const u32x4 raw = which ? cur.mk : cur.mq; float x[8], px[8];
                  x[0] = bf2f(raw.x & 0xffffu); x[1] = bf2f(raw.x >> 16); x[2] = bf2f(raw.y & 0xffffu); x[3] = bf2f(raw.y >> 16); x[4] = bf2f(raw.z & 0xffffu); x[5] = bf2f(raw.z >> 16); x[6] = bf2f(raw.w & 0xffffu); x[7] = bf2f(raw.w >> 16);
#pragma unroll
                  for (int e = 0; e < 8; ++e) px[e] = __shfl_xor(x[e], 2);
                  if (hm < 4) {
#pragma unroll
                      for (int e2 = 0; e2 < 4; ++e2) { const f32x4 cs = cur.ro[e2];
                          if (hm < 2) { x[2 * e2] = x[2 * e2] * cs[0] - px[2 * e2] * cs[1]; x[2 * e2 + 1] = x[2 * e2 + 1] * cs[2] - px[2 * e2 + 1] * cs[3]; }
                          else { x[2 * e2] = px[2 * e2] * cs[1] + x[2 * e2] * cs[0]; x[2 * e2 + 1] = px[2 * e2 + 1] * cs[3] + x[2 * e2 + 1] * cs[2]; } } }
                  if (which == 0) { u32x4 w; w.x = pk2(x[0] * CM_SCALE, x[1] * CM_SCALE); w.y = pk2(x[2] * CM_SCALE, x[3] * CM_SCALE); w.z = pk2(x[4] * CM_SCALE, x[5] * CM_SCALE); w.w = pk2(x[6] * CM_SCALE, x[7] * CM_SCALE);
                      *(u32x4*)(MQ + (size_t)t * 512 + 8 * lane) = w; }
                  else { u32x4 w; w.x = pk2(x[0], x[1]); w.y = pk2(x[2], x[3]); w.z = pk2(x[4], x[5]); w.w = pk2(x[6], x[7]);
                      *(u32x4*)(MK + (size_t)t * 512 + 8 * lane) = w;
                      float n2 = 0.f;
#pragma unroll
                      for (int e = 0; e < 8; ++e) { ksum[e] += x[e]; n2 += x[e] * x[e]; }
                      n2 += __shfl_xor(n2, 1); n2 += __shfl_xor(n2, 2); n2 += __shfl_xor(n2, 4); n2 += __shfl_xor(n2, 8); kmmax = fmaxf(kmmax, n2); }
              }
              cur = nxt;
          }
#undef P2A_LOAD
          { LAS f32x4* kr = (LAS f32x4*)(ybuf + wave * 512 + 8 * lane); kr[0] = (f32x4){ksum[0], ksum[1], ksum[2], ksum[3]}; kr[1] = (f32x4){ksum[4], ksum[5], ksum[6], ksum[7]}; }
          if (lane == 0) ybuf[4096 + wave * 8 + 4] = kpemax;
          if (hm == 0) ybuf[4096 + wave * 8 + (lane >> 4)] = kmmax;
          __syncthreads();
          { float a = 0.f;
#pragma unroll
            for (int w8 = 0; w8 < 8; ++w8) a += ybuf[w8 * 512 + tid];
            atomicAdd((int*)(ctl + CW_KMEAN) + ((size_t)((tid >> 7) * 64 + (t0 >> 8)) * 128 + (tid & 127)), __float2int_rn(a * KM_FIX));
            if (tid < 5) { float m = 0.f;
#pragma unroll
                for (int w8 = 0; w8 < 8; ++w8) m = fmaxf(m, ybuf[4096 + w8 * 8 + tid]);
                atomicMax(ctl + (tid == 4 ? CW_KPEMAX : CW_KMMAX + tid), __float_as_uint(m)); } }
          __syncthreads(); }
#ifdef REP_P2A_C
#pragma unroll 1
        for (int rep_ = 0; rep_ < 2; ++rep_)
#endif
        { const int c = tid;
          { const bf16_t* src = H + (size_t)t0 * HLD + C_MV + c; unsigned pk[32];
#pragma unroll
            for (int i = 0; i < 32; ++i) pk[i] = (unsigned)src[(size_t)(2 * i) * HLD] | ((unsigned)src[(size_t)(2 * i + 1) * HLD] << 16);
            u32x4* dst = (u32x4*)(MVT + (size_t)c * S + t0);
#pragma unroll
            for (int i = 0; i < 8; ++i) dst[i] = (u32x4){pk[4 * i], pk[4 * i + 1], pk[4 * i + 2], pk[4 * i + 3]}; }
          { const bf16_t* src = H + C_POOL + c; float uv[80];
#pragma unroll
            for (int i0 = 0; i0 < 80; i0 += 16) { const bf16_t* p = src + (ptrdiff_t)(t0 - 16) * HLD;
#pragma unroll
                for (int i = 0; i < 16; ++i) { const float u_ = bf2f(p[(ptrdiff_t)(i0 + i) * HLD]); uv[i0 + i] = t0 - 16 + i0 + i >= 0 ? u_ : 0.f; }
                asm volatile("" ::: "memory"); }
#define P2A_POOL(W) do { float s_ = 0.f; _Pragma("unroll") for (int i = 16 - (W); i < 16; ++i) s_ += uv[i]; \
              _Pragma("unroll") for (int i = 0; i < 64; ++i) { const int t_ = t0 + i; s_ += uv[16 + i] - uv[16 + i - (W)]; const float cnt_ = (float)(t_ + 1 < (W) ? t_ + 1 : (W)); \
                  POOLED[(size_t)t_ * 512 + c] = (bf16_t)f2bf(s_ / cnt_ - uv[16 + i]); } } while (0)
            const int grp = c >> 7;
            if (grp == 0) P2A_POOL(2); else if (grp == 1) P2A_POOL(4); else if (grp == 2) P2A_POOL(8); else P2A_POOL(16);
#undef P2A_POOL
          }
          { const float* dw = P.in[7] + (size_t)l * 31 * 512 + c; float w[31];
#pragma unroll
            for (int j = 0; j < 31; ++j) w[j] = dw[j * 512];
            const float bias = P.in[8][l * 512 + c]; const bf16_t* src = H + C_CONV + c;
#pragma unroll 1
            for (int ch = 0; ch < 4; ++ch) { float v[46];
                const int tb = t0 + 16 * ch - 30;
                { const bf16_t* p = src + (ptrdiff_t)tb * HLD;
#pragma unroll
                  for (int i0 = 0; i0 < 46; i0 += 8) { unsigned ra[8], rg[8];
#pragma unroll
                      for (int i = 0; i < 8; ++i) if (i0 + i < 46) { ra[i] = p[(ptrdiff_t)(i0 + i) * HLD]; rg[i] = p[(ptrdiff_t)(i0 + i) * HLD + 512]; }
#pragma unroll
                      for (int i = 0; i < 8; ++i) if (i0 + i < 46) { const float val = bf2f(ra[i]) * sigmoidf_(bf2f(rg[i])); v[i0 + i] = tb + i0 + i >= 0 ? val : 0.f; }
                      asm volatile("" ::: "memory"); } }
#pragma unroll
                for (int tl = 0; tl < 16; ++tl) { float y = bias;
#pragma unroll
                    for (int j = 0; j < 31; ++j) y = fmaf(w[j], v[tl + j], y);
                    ybuf[(16 * ch + tl) * 512 + c] = y; } } }
        }
        __syncthreads();
        { const float* lg = P.in[9] + l * 512 + 8 * lane; const float* lb = P.in[10] + l * 512 + 8 * lane;
          const f32x4 g0 = *(const f32x4*)lg, g1 = *(const f32x4*)(lg + 4), b0 = *(const f32x4*)lb, b1 = *(const f32x4*)(lb + 4);
#pragma unroll 1
          for (int i = 0; i < 8; ++i) { const int tl = wave * 8 + i; const LAS f32x4* yp = (const LAS f32x4*)(ybuf + tl * 512 + 8 * lane);
              f32x4 y0 = yp[0], y1 = yp[1];
              const float mean = wave_sum((y0[0] + y0[1]) + (y0[2] + y0[3]) + (y1[0] + y1[1]) + (y1[2] + y1[3])) * (1.f / 512.f);
              y0 = y0 - mean; y1 = y1 - mean;
              const float var = wave_sum((y0[0] * y0[0] + y0[1] * y0[1]) + (y0[2] * y0[2] + y0[3] * y0[3]) + (y1[0] * y1[0] + y1[1] * y1[1]) + (y1[2] * y1[2] + y1[3] * y1[3])) * (1.f / 512.f);
              const float rstd = rsqrtf(var + EPS);
              y0 = y0 * rstd * g0 + b0; y1 = y1 * rstd * g1 + b1;
              float r[8];
#pragma unroll
              for (int e = 0; e < 4; ++e) { r[e] = y0[e] * sigmoidf_(y0[e]); r[4 + e] = y1[e] * sigmoidf_(y1[e]); }
              u32x4 wv; wv.x = pk2(r[0], r[1]); wv.y = pk2(r[2], r[3]); wv.z = pk2(r[4], r[5]); wv.w = pk2(r[6], r[7]);
              *(u32x4*)(CONVA + (size_t)(t0 + tl) * 512 + 8 * lane) = wv; } }
        __syncthreads();
    }
}

__device__ __forceinline__ void gate_phase(const Params& P, int l, LAS unsigned char* lds, int G, int dup = 0) {
    int tid_l = threadIdx.x; asm volatile("" : "+v"(tid_l)); const int tid = tid_l, lane = tid & 63, wave = tid >> 6, r = lane & 31, hh = lane >> 5;
    unsigned* ctl = (unsigned*)(P.ws + WS_CTL) + l * CW_LAYER;
    const int* kmean = (const int*)(ctl + CW_KMEAN);
    const bf16_t* MQ = (const bf16_t*)(P.ws + WS_MQ);
    int* LIST = dup ? (int*)(P.ws + 486 * MiB) : (int*)((unsigned char*)P.out + DO_LIST); unsigned* cntp = ctl + (dup ? 512 : CW_CNT);
    for (int unit = blockIdx.x * NWV + wave; unit < (S / 32) * 4; unit += G * NWV) {
        const int h = unit & 3, t0 = (unit >> 2) * 32, own = t0 >> 8, t = t0 + r;
        if (own == 0) continue;
        f32x16 acc[2];
#pragma unroll
        for (int mt = 0; mt < 2; ++mt)
#pragma unroll
            for (int i = 0; i < 16; ++i) acc[mt][i] = 0.f;
#pragma unroll
        for (int ks = 0; ks < 8; ++ks) { const bf16x8 qf = *(const bf16x8*)(MQ + (size_t)t * 512 + h * 128 + 16 * ks + 8 * hh);
#pragma unroll
            for (int mt = 0; mt < 2; ++mt) { const int* kp = kmean + (size_t)(h * 64 + 32 * mt + r) * 128 + 16 * ks + 8 * hh; const u32x4 a = *(const u32x4*)kp, b = *(const u32x4*)(kp + 4);
                float v[8] = {(float)(int)a.x * KM_INV, (float)(int)a.y * KM_INV, (float)(int)a.z * KM_INV, (float)(int)a.w * KM_INV, (float)(int)b.x * KM_INV, (float)(int)b.y * KM_INV, (float)(int)b.z * KM_INV, (float)(int)b.w * KM_INV}; unsigned hi[8], lo[8];
#pragma unroll
                for (int e = 0; e < 8; ++e) { hi[e] = f2bf(v[e]); lo[e] = f2bf(v[e] - bf2f(hi[e])); }
                u32x4 wh, wl; wh.x = hi[0] | (hi[1] << 16); wh.y = hi[2] | (hi[3] << 16); wh.z = hi[4] | (hi[5] << 16); wh.w = hi[6] | (hi[7] << 16);
                wl.x = lo[0] | (lo[1] << 16); wl.y = lo[2] | (lo[3] << 16); wl.z = lo[4] | (lo[5] << 16); wl.w = lo[6] | (lo[7] << 16);
                acc[mt] = __builtin_amdgcn_mfma_f32_32x32x16_bf16(__builtin_bit_cast(bf16x8, wh), qf, acc[mt], 0, 0, 0);
                acc[mt] = __builtin_amdgcn_mfma_f32_32x32x16_bf16(__builtin_bit_cast(bf16x8, wl), qf, acc[mt], 0, 0, 0); } }
#pragma unroll
        for (int mt = 0; mt < 2; ++mt)
#pragma unroll
            for (int i = 0; i < 16; ++i) if (32 * mt + (i & 3) + 8 * (i >> 2) + 4 * hh >= own) acc[mt][i] = -INFINITY;
        float tv[3]; int ti[3];
#pragma unroll
        for (int p = 0; p < 3; ++p) { float bv = -INFINITY; int bi = 64;
#pragma unroll
            for (int mt = 0; mt < 2; ++mt)
#pragma unroll
                for (int i = 0; i < 16; ++i) { const int bidx = 32 * mt + (i & 3) + 8 * (i >> 2) + 4 * hh; const float v = acc[mt][i]; if (v > bv || (v == bv && bidx < bi)) { bv = v; bi = bidx; } }
            tv[p] = bv; ti[p] = bi;
#pragma unroll
            for (int mt = 0; mt < 2; ++mt)
#pragma unroll
                for (int i = 0; i < 16; ++i) if (32 * mt + (i & 3) + 8 * (i >> 2) + 4 * hh == bi) acc[mt][i] = -INFINITY; }
        float cv[6]; int ci[6];
#pragma unroll
        for (int p = 0; p < 3; ++p) { cv[p] = tv[p]; ci[p] = ti[p]; cv[3 + p] = __shfl_xor(tv[p], 32); ci[3 + p] = __shfl_xor(ti[p], 32); }
        int pick[3];
#pragma unroll
        for (int p = 0; p < 3; ++p) { float bv = -INFINITY; int bi = 64;
#pragma unroll
            for (int c = 0; c < 6; ++c) if (cv[c] > bv || (cv[c] == bv && ci[c] < bi)) { bv = cv[c]; bi = ci[c]; }
            pick[p] = bi;
#pragma unroll
            for (int c = 0; c < 6; ++c) if (ci[c] == bi) cv[c] = -INFINITY; }
        const int npick = own < 3 ? own : 3;
        if (hh == 0) {
#pragma unroll
            for (int p = 0; p < 3; ++p) if (p < npick) { const int hb = h * 64 + pick[p]; const int slot = (int)atomicAdd(cntp + hb, 1u); LIST[(size_t)hb * S + slot] = t * 4 + p; } }
    }
}

template <int DK>
__device__ __forceinline__ int attn_item(unsigned* qctr, const int tid, LAS unsigned char* lds, const bf16_t* Qb, int ldq, int qrow, bool qvalid, int qpos, int wqmin,
                                          const bf16_t* Kp, int ldk, const bf16_t* VT, int key0, int ntiles,
                                          float kmaxA, float kmaxB, const int OM, const int oidx, float* o32b, bf16_t* obb, float* lpb) {
    constexpr int NKS = DK / 16, SPRK = DK / 8 + 1, KSTR = SPRK * 16, NKI = SPRK, KBYTES = NKI * 1024, VSTR = 144, NVI = 18, BUF = KBYTES + NVI * 1024, KW = (DK == 192 ? 5 : 4), NII = 6;
    const int lane = tid & 63, r = lane & 31, hh = lane >> 5, wave = __builtin_amdgcn_readfirstlane(tid >> 6);
    bf16x8 qf[NKS];
    { const bf16_t* qp = Qb + (size_t)qrow * ldq + 8 * hh;
#pragma unroll
      for (int ks = 0; ks < NKS; ++ks) qf[ks] = *(const bf16x8*)(qp + 16 * ks); }
    float na = 0.f, nb = 0.f;
#pragma unroll
    for (int ks = 0; ks < NKS; ++ks)
#pragma unroll
        for (int e = 0; e < 8; ++e) { const float f = bf2f((unsigned)(unsigned short)qf[ks][e]); if (ks < 8) na += f * f; else nb += f * f; }
    na += __shfl_xor(na, 32); nb += __shfl_xor(nb, 32);
    const float negr = -(sqrtf(na) * kmaxA + sqrtf(nb) * kmaxB);
    const bool kwave = wave < KW;
    const int jw = kwave ? wave : wave - KW, jstride = kwave ? KW : 8 - KW, jn = kwave ? NKI : NVI;
    const unsigned char* gbase = kwave ? (const unsigned char*)Kp : (const unsigned char*)VT;
    const unsigned gstep = kwave ? (unsigned)ldk * 128u : 128u, ldst0 = kwave ? 0u : (unsigned)KBYTES;
#define AT_GOFF(j_) ({ const int sg_ = 64 * (j_) + lane; unsigned g_; \
        if (kwave) { const int row_ = sg_ / SPRK; int part_ = sg_ - row_ * SPRK; if (part_ == SPRK - 1) part_ = 0; g_ = (unsigned)(((key0 + row_) * ldk + part_ * 8) * 2); } \
        else { const int dv_ = sg_ / 9; int part_ = sg_ - dv_ * 9; if (part_ == 8) part_ = 0; g_ = (unsigned)((dv_ * S + key0 + part_ * 8) * 2); } g_; })
#define AT_DMA(tt, b) do { _Pragma("unroll") for (int ii_ = 0; ii_ < NII; ++ii_) { const int j_ = jw + jstride * ii_; if (j_ < jn) \
        __builtin_amdgcn_global_load_lds((const unsigned*)(gbase + (size_t)(AT_GOFF(j_) + (unsigned)(tt) * gstep)), (LAS unsigned*)(lds + (b) * BUF + ldst0 + j_ * 1024), 16, 0, 0); } } while (0)
    AT_DMA(0, 0);
    f32x16 o[4];
#pragma unroll
    for (int d = 0; d < 4; ++d)
#pragma unroll
        for (int i = 0; i < 16; ++i) o[d][i] = 0.f;
    float lsum = 0.f;
    const int pr = (r & 0x13) | ((r & 4) << 1) | ((r & 8) >> 1);
    const unsigned koff = (unsigned)(pr * KSTR + 16 * hh), voff = (unsigned)(KBYTES + r * VSTR + 16 * hh);
    asm volatile("s_waitcnt vmcnt(0)" ::: "memory"); __syncthreads();
    int nxt_idx = 0;
#pragma unroll 1
    for (int t = 0; t < ntiles; ++t) {
        const int cur = t & 1;
        if (t + 1 < ntiles) AT_DMA(t + 1, cur ^ 1);
        else if (tid == 0) nxt_idx = (int)atomicAdd(qctr, 1u);
        LAS const unsigned char* bp = lds + cur * BUF;
        bf16x8 pf[2][2];
#pragma unroll
        for (int kb = 0; kb < 2; ++kb) {
            f32x16 acc;
#pragma unroll
            for (int i = 0; i < 16; ++i) acc[i] = negr;
#pragma unroll
            for (int ks = 0; ks < NKS; ++ks) { const bf16x8 kf = *(LAS const bf16x8*)(bp + koff + kb * 32 * KSTR + 32 * ks); acc = __builtin_amdgcn_mfma_f32_32x32x16_bf16(kf, qf[ks], acc, 0, 0, 0); }
            const int kt0 = key0 + 64 * t + 32 * kb + 8 * hh;
            if (key0 + 64 * t + 63 > wqmin) {
#pragma unroll
                for (int i = 0; i < 16; ++i) if (kt0 + 16 * (i >> 3) + (i & 7) > qpos) acc[i] = -INFINITY; }
#pragma unroll
            for (int i = 0; i < 16; ++i) { const float p = __builtin_amdgcn_exp2f(acc[i]); lsum += p; acc[i] = p; }
            u32x4 w0, w1;
            w0.x = pk2(acc[0], acc[1]); w0.y = pk2(acc[2], acc[3]); w0.z = pk2(acc[4], acc[5]); w0.w = pk2(acc[6], acc[7]);
            w1.x = pk2(acc[8], acc[9]); w1.y = pk2(acc[10], acc[11]); w1.z = pk2(acc[12], acc[13]); w1.w = pk2(acc[14], acc[15]);
            pf[kb][0] = __builtin_bit_cast(bf16x8, w0); pf[kb][1] = __builtin_bit_cast(bf16x8, w1);
        }
#pragma unroll
        for (int d = 0; d < 4; ++d)
#pragma unroll
            for (int kb = 0; kb < 2; ++kb)
#pragma unroll
                for (int s = 0; s < 2; ++s) { const bf16x8 vf = *(LAS const bf16x8*)(bp + voff + d * 32 * VSTR + (32 * kb + 16 * s) * 2); o[d] = __builtin_amdgcn_mfma_f32_32x32x16_bf16(vf, pf[kb][s], o[d], 0, 0, 0); }
        asm volatile("s_waitcnt vmcnt(0)" ::: "memory");
        __syncthreads();
    }
#undef AT_DMA
#undef AT_GOFF
    lsum += __shfl_xor(lsum, 32);
    if (qvalid) {
        float* o32 = o32b + (size_t)oidx * 128; bf16_t* ob = obb + (size_t)oidx * (OM == 0 ? D : 128); float* lp = lpb + oidx;
        if (OM == 1) {
#pragma unroll
            for (int d = 0; d < 4; ++d)
#pragma unroll
                for (int i4 = 0; i4 < 4; ++i4) *(f32x4*)(o32 + 32 * d + 8 * i4 + 4 * hh) = (f32x4){o[d][4 * i4], o[d][4 * i4 + 1], o[d][4 * i4 + 2], o[d][4 * i4 + 3]};
            if (hh == 0) *lp = lsum;
        } else {
            const float sc = OM == 0 ? 1.f / lsum : 1.f;
#pragma unroll
            for (int d = 0; d < 4; ++d)
#pragma unroll
                for (int i4 = 0; i4 < 4; ++i4) { u32x2 w; w.x = pk2(o[d][4 * i4] * sc, o[d][4 * i4 + 1] * sc); w.y = pk2(o[d][4 * i4 + 2] * sc, o[d][4 * i4 + 3] * sc); *(u32x2*)(ob + 32 * d + 8 * i4 + 4 * hh) = w; }
            if (OM == 2 && hh == 0) *lp = lsum;
        }
    }
    return nxt_idx;
}

constexpr int N_HEAD_MLA = 96, N_HEAD_FIXED = 160, CW_QH = 24;
__device__ __forceinline__ void attn_phase(const Params& P, int l, LAS unsigned char* lds, int G, int rep = 0) {
    const int tid = threadIdx.x, lane = tid & 63, wave = tid >> 6, r = lane & 31;
    unsigned char* ws = P.ws; unsigned char* dout = (unsigned char*)P.out;
    unsigned* ctl = (unsigned*)(ws + WS_CTL) + l * CW_LAYER;
    float* PART = (float*)(dout + DO_PART); float* PL = (float*)(dout + DO_PL); bf16_t* PARTB = (bf16_t*)(dout + DO_PARTB); float* LB = (float*)(dout + DO_LB); const int* LIST = (const int*)(dout + DO_LIST);
    const bf16_t* Q = (const bf16_t*)(ws + WS_Q); const bf16_t* KK = (const bf16_t*)(ws + WS_K); const bf16_t* VT = (const bf16_t*)(ws + WS_VT); bf16_t* CC = (bf16_t*)(ws + WS_CONCAT);
    const bf16_t* MQ = (const bf16_t*)(ws + WS_MQ); const bf16_t* MK = (const bf16_t*)(ws + WS_MK); const bf16_t* MVT = (const bf16_t*)(ws + WS_MVT);
    LAS int* qidx = (LAS int*)(lds + LDS_MISC); LAS int* pre = (LAS int*)(lds + LDS_MISC + 64);
    __syncthreads();
    if (tid < 64) {
        const u32x4 c4 = *(const u32x4*)(ctl + CW_CNT + 4 * tid);
        const int a0 = (int)((c4.x + 255u) >> 8), a1 = a0 + (int)((c4.y + 255u) >> 8), a2 = a1 + (int)((c4.z + 255u) >> 8), a3 = a2 + (int)((c4.w + 255u) >> 8);
        int run = a3;
#pragma unroll
        for (int o = 1; o < 64; o <<= 1) { const int v = __shfl_up(run, o); if (lane >= o) run += v; }
        const int base = run - a3;
        pre[1 + 4 * tid] = base + a0; pre[2 + 4 * tid] = base + a1; pre[3 + 4 * tid] = base + a2; pre[4 + 4 * tid] = base + a3;
        if (tid == 0) pre[0] = 0; }
    __syncthreads();
    const float kpemax = sqrtf(__uint_as_float(ctl[CW_KPEMAX]));
    int hcur = (int)(((unsigned)__builtin_amdgcn_s_getreg((3 << 11) | 20) & 0xFu) & 3u), tried = 0;
    unsigned* qctr = ctl + CW_QH + 4 * rep + hcur;
    if (tid == 0) qidx[0] = (int)atomicAdd(qctr, 1u);
    __syncthreads();
    int idx = qidx[0];
    __syncthreads();
    for (;;) {
        bool done = false;
        while (idx >= N_HEAD_FIXED + pre[64 * hcur + 64] - pre[64 * hcur]) {
            if (++tried == 4) { done = true; break; }
            hcur = (hcur + 1) & 3; qctr = ctl + CW_QH + 4 * rep + hcur;
            if (tid == 0) qidx[0] = (int)atomicAdd(qctr, 1u);
            __syncthreads();
            idx = qidx[0];
            __syncthreads();
        }
        if (done) break;
        const int h = hcur; int nxt_idx;
        if (idx < N_HEAD_MLA) {
            const int j = idx; int qb, t0, nt, kind;
            if (j < 32) { qb = 32 + j; t0 = 0; nt = 128; kind = 1; }
            else { const int k = j - 32; if (k & 1) { qb = 31 - (k >> 1); t0 = 0; nt = 4 * (qb + 1); kind = 0; } else { qb = 63 - (k >> 1); t0 = 128; nt = 4 * (qb - 31); kind = 2; } }
            const int qrow = 256 * qb + 32 * wave + r;
            const float knmax = sqrtf(__uint_as_float(ctl[CW_KNPIECE + h * 4 + 0]) + __uint_as_float(ctl[CW_KNPIECE + h * 4 + 1]) + __uint_as_float(ctl[CW_KNPIECE + h * 4 + 2]) + __uint_as_float(ctl[CW_KNPIECE + h * 4 + 3]));
            const int slot = (h * 32 + (qb & 31)) * 2 + (kind == 2 ? 1 : 0); const bool causal = kind != 1;
            nxt_idx = attn_item<192>(qctr, tid, lds, Q + h * 192, 768, qrow, true, causal ? qrow : 0x7fffffff, causal ? 256 * qb + 32 * wave : 0x7fffffff, KK + h * 192, 768, VT + (size_t)h * 128 * S, 64 * t0, nt, knmax, kpemax,
                           kind == 0 ? 0 : 1, kind == 0 ? qrow : 32 * wave + r, PART + (size_t)slot * 256 * 128, CC + h * 128, PL + (size_t)slot * 256);
        } else {
            int key0, qrow, qpos, wqmin, pslot; bool valid = true;
            if (idx < N_HEAD_FIXED) { const int blk = idx - N_HEAD_MLA; key0 = 256 * blk; qrow = 256 * blk + 32 * wave + r; qpos = qrow; wqmin = 256 * blk + 32 * wave; pslot = 3; }
            else { const int g2 = pre[64 * h] + idx - N_HEAD_FIXED; int lo = 64 * h, hi = 64 * h + 64;
                while (hi - lo > 1) { const int mid = (lo + hi) >> 1; if (pre[mid] <= g2) lo = mid; else hi = mid; }
                const int hb = lo, chunk = g2 - pre[hb]; const int cntv = (int)ctl[CW_CNT + hb]; int nq = cntv - 256 * chunk; nq = nq > 256 ? 256 : nq;
                const int li = 32 * wave + r; valid = li < nq; const int ent = LIST[(size_t)hb * S + 256 * chunk + (valid ? li : 0)]; qrow = ent >> 2; pslot = ent & 3;
                key0 = 256 * (hb & 63); qpos = 0x7fffffff; wqmin = 0x7fffffff; }
            const float kmmax = sqrtf(__uint_as_float(ctl[CW_KMMAX + h]));
            nxt_idx = attn_item<128>(qctr, tid, lds, MQ + h * 128, 512, qrow, valid, qpos, wqmin, MK + h * 128, 512, MVT + (size_t)h * 128 * S, key0, 4, kmmax, 0.f, 2, (qrow * 4 + h) * 4 + pslot, nullptr, PARTB, LB);
        }
        if (tid == 0) qidx[0] = nxt_idx;
        __syncthreads();
        idx = qidx[0];
        __syncthreads();
    }
}
__device__ __forceinline__ void attn_norm_phase(const Params& P, int G) {
    int tid_l = threadIdx.x; asm volatile("" : "+v"(tid_l)); const int lane = tid_l & 63, wave = tid_l >> 6;
    unsigned char* dout = (unsigned char*)P.out;
    const float* PART = (const float*)(dout + DO_PART); const float* PL = (const float*)(dout + DO_PL); const bf16_t* PARTB = (const bf16_t*)(dout + DO_PARTB); const float* LB = (const float*)(dout + DO_LB);
    bf16_t* CC = (bf16_t*)(P.ws + WS_CONCAT);
#pragma unroll 2
    for (int row = blockIdx.x * NWV + wave; row < S; row += G * NWV) {
        float acc[16]; float lt = 0.f; bool wr = false;
#pragma unroll
        for (int e = 0; e < 16; ++e) acc[e] = 0.f;
        const int qb = row >> 8;
        if (lane < 32) { if (qb >= 32) { wr = true; const int h = lane >> 3;
#pragma unroll
                for (int c = 0; c < 2; ++c) { const size_t slot = (size_t)((h * 32 + qb - 32) * 2 + c) * 256 + (row & 255); lt += PL[slot]; const f32x4* pp = (const f32x4*)(PART + slot * 128 + 16 * (lane & 7));
#pragma unroll
                    for (int e4 = 0; e4 < 4; ++e4) { const f32x4 v = pp[e4]; acc[4 * e4] += v[0]; acc[4 * e4 + 1] += v[1]; acc[4 * e4 + 2] += v[2]; acc[4 * e4 + 3] += v[3]; } } } }
        else { wr = true; const int h = (lane >> 3) - 4; const int np = qb < 3 ? qb : 3;
            const size_t ps0 = ((size_t)row * 4 + h) * 4; const f32x4 l4 = *(const f32x4*)(LB + ps0); u32x4 raw[4][2];
#pragma unroll
            for (int sl = 0; sl < 4; ++sl) { const u32x4* pp = (const u32x4*)(PARTB + (ps0 + sl) * 128 + 16 * (lane & 7)); raw[sl][0] = pp[0]; raw[sl][1] = pp[1]; }
#pragma unroll
            for (int sl = 0; sl < 4; ++sl) { const bool use = sl == 3 || sl < np; lt += use ? l4[sl] : 0.f;
#pragma unroll
                for (int e8 = 0; e8 < 2; ++e8) { const u32x4 v = raw[sl][e8]; float f[8] = {bf2f(v.x & 0xffffu), bf2f(v.x >> 16), bf2f(v.y & 0xffffu), bf2f(v.y >> 16), bf2f(v.z & 0xffffu), bf2f(v.z >> 16), bf2f(v.w & 0xffffu), bf2f(v.w >> 16)};
#pragma unroll
                    for (int e = 0; e < 8; ++e) acc[8 * e8 + e] += use ? f[e] : 0.f; } } }
        if (wr) { const float inv = 1.f / lt; u32x4 w0, w1;
            w0.x = pk2(acc[0] * inv, acc[1] * inv); w0.y = pk2(acc[2] * inv, acc[3] * inv); w0.z = pk2(acc[4] * inv, acc[5] * inv); w0.w = pk2(acc[6] * inv, acc[7] * inv);
            w1.x = pk2(acc[8] * inv, acc[9] * inv); w1.y = pk2(acc[10] * inv, acc[11] * inv); w1.z = pk2(acc[12] * inv, acc[13] * inv); w1.w = pk2(acc[14] * inv, acc[15] * inv);
            u32x4* dst = (u32x4*)(CC + (size_t)row * D + 16 * lane); dst[0] = w0; dst[1] = w1; }
    }
}

#define GAS __attribute__((address_space(1)))

typedef GAS unsigned gu32;
typedef GAS unsigned long long gu64;
#define RLX_AGENT __ATOMIC_RELAXED, __HIP_MEMORY_SCOPE_AGENT
#define LDS_WAIT() asm volatile("s_waitcnt lgkmcnt(0)" ::: "memory")
#define VM_WAIT() asm volatile("s_waitcnt vmcnt(0)" ::: "memory")
__device__ __forceinline__ unsigned long long rt() { return __builtin_amdgcn_s_memrealtime(); }
#define XB_TMO      128
#define XB_XCNT(j)  (256  + 64 * (j))
#define XB_XSUB(j)  (1280 + 64 * (j))
#define XB_XGEN(j)  (2304 + 64 * (j))
#define XB_TOP      3328
#define XB_TOPGEN   3392
#define XCD_BAR_WORDS 3456
#define XB_SPIN_CAP (1u << 18)

__device__ __forceinline__ unsigned xb_ld(unsigned* p)              { return __hip_atomic_load(p, __ATOMIC_RELAXED, __HIP_MEMORY_SCOPE_AGENT); }
__device__ __forceinline__ unsigned xb_add(unsigned* p, unsigned v) { return __hip_atomic_fetch_add(p, v, __ATOMIC_RELAXED, __HIP_MEMORY_SCOPE_AGENT); }
__device__ __forceinline__ unsigned xb_xcc_id() { return (unsigned)__builtin_amdgcn_s_getreg((3 << 11) | 20) & 0xFu; }
#define XB_SPIN(cond, bar) do { unsigned _sp = 0; while (cond) { __builtin_amdgcn_s_sleep(1); \
    if ((++_sp & 255u) == 0u) { if (xb_ld(&(bar)[XB_TMO])) break; if (_sp > XB_SPIN_CAP) { atomicAdd(&(bar)[XB_TMO], 1u); break; } } } } while (0)

struct XcdBarrier {
    unsigned* bar; unsigned x;
    volatile LAS unsigned* st;
};

__device__ __forceinline__ XcdBarrier xcd_barrier_post(unsigned* bar, volatile LAS unsigned* st) {
    XcdBarrier b; b.bar = bar; b.x = xb_xcc_id(); b.st = st;
    if (threadIdx.x == 0) (void)xb_add(&bar[XB_XCNT(b.x)], 1u);
    return b;
}
__device__ __forceinline__ void xcd_barrier_complete(unsigned* bar, unsigned x, unsigned& nloc, unsigned& nx) {
    const unsigned G = gridDim.x * gridDim.y * gridDim.z;
    unsigned sum, cnt, mine, sp = 0u;
    for (;;) {
        sum = 0u; cnt = 0u; mine = 0u;
#pragma unroll
        for (unsigned j = 0; j < 16; ++j) { const unsigned c = xb_ld(&bar[XB_XCNT(j)]); sum += c; cnt += (c > 0u) ? 1u : 0u; mine = (j == x) ? c : mine; }
        if (sum == G) break;
        __builtin_amdgcn_s_sleep(1);
        if ((++sp & 255u) == 0u) { if (xb_ld(&bar[XB_TMO])) break; if (sp > XB_SPIN_CAP) { atomicAdd(&bar[XB_TMO], 1u); break; } }
    }
    nloc = mine > 0u ? mine : 1u; nx = cnt > 0u ? cnt : 1u;
}

__device__ __forceinline__ void xcd_barrier(const XcdBarrier& b) {
    asm volatile("s_waitcnt vmcnt(0)" ::: "memory");
    __syncthreads();
    if (threadIdx.x == 0) {
        unsigned* bar = b.bar;
        __builtin_amdgcn_s_waitcnt(0);
        unsigned nloc = b.st[0], nx = b.st[1];
        if (nloc == 0u) { xcd_barrier_complete(bar, b.x, nloc, nx); b.st[0] = nloc; b.st[1] = nx; }
        const unsigned old = xb_add(&bar[XB_XSUB(b.x)], 1u);
        const unsigned gen = old / nloc;
        if (old + 1u == (gen + 1u) * nloc) {
            __builtin_amdgcn_fence(__ATOMIC_RELEASE, "agent");
            asm volatile("s_waitcnt vmcnt(0)" ::: "memory");
            const unsigned og = xb_add(&bar[XB_TOP], 1u);
            const unsigned tg = og / nx;
            if (og + 1u == (tg + 1u) * nx) xb_add(&bar[XB_TOPGEN], 1u);
            else XB_SPIN(xb_ld(&bar[XB_TOPGEN]) == tg, bar);
            __builtin_amdgcn_fence(__ATOMIC_ACQUIRE, "agent");
            xb_add(&bar[XB_XGEN(b.x)], 1u);
            asm volatile("s_waitcnt vmcnt(0)" ::: "memory");
        } else {
            XB_SPIN(xb_ld(&bar[XB_XGEN(b.x)]) == gen, bar);
            __builtin_amdgcn_fence(__ATOMIC_ACQUIRE, "agent");
            asm volatile("s_waitcnt vmcnt(0)" ::: "memory");
        }
    }
    __syncthreads();
}

constexpr int CW_BAR = 131072;

#ifdef SELFCHECK
constexpr int CW_CHK = 40;
__device__ __forceinline__ float blk_reduce(const int tid, float v, bool domax, LAS float* red) {
#pragma unroll
    for (int o = 1; o < 64; o <<= 1) { const float w = __shfl_xor(v, o); v = domax ? fmaxf(v, w) : v + w; }
    __syncthreads(); if ((tid & 63) == 0) red[tid >> 6] = v; __syncthreads();
    float r = red[0];
#pragma unroll
    for (int i = 1; i < 8; ++i) r = domax ? fmaxf(r, red[i]) : r + red[i];
    __syncthreads();
    return r;
}
__device__ __forceinline__ int chk_token(int i) {
    if (i < 16) { const int base = (i >> 1) == 0 ? 0 : (i >> 1) == 1 ? 32 : (i >> 1) == 2 ? 64 : (i >> 1) == 3 ? 128 : (i >> 1) == 4 ? 256 : (i >> 1) == 5 ? 512 : (i >> 1) == 6 ? 768 : 1024;
        return (i & 1) ? (i == 1 ? 1 : i == 9 ? 257 : base - 1) : base; }
    return (i * 64 + (i * 13) % 64) & (S - 1); }
__device__ __forceinline__ bool chk_softmax_pv(const int tid, LAS float* sbuf, LAS int* kmap, int n, const bf16_t* VTh, const bf16_t* CC, int t, int col0, LAS float* red, LAS float* obuf) {
    float m = -INFINITY; for (int k = tid; k < n; k += NT) m = fmaxf(m, sbuf[k]);
    m = blk_reduce(tid, m, true, red);
    float l = 0.f; for (int k = tid; k < n; k += NT) { const float p = __builtin_amdgcn_exp2f(sbuf[k] - m); sbuf[k] = p; l += p; }
    l = blk_reduce(tid, l, false, red);
    const int dv = tid & 127, part = tid >> 7; float o = 0.f;
    for (int k = part; k < n; k += 4) { const int key = kmap ? kmap[k] : k; o += sbuf[k] * bf2f(VTh[(size_t)dv * S + key]); }
    obuf[tid] = o; __syncthreads();
    float ref = 0.f, err = 0.f;
    if (tid < 128) { ref = (obuf[tid] + obuf[tid + 128] + obuf[tid + 256] + obuf[tid + 384]) / l; err = fabsf(ref - bf2f(CC[(size_t)t * D + col0 + tid])); ref = fabsf(ref); }
    const float mref = blk_reduce(tid, ref, true, red), merr = blk_reduce(tid, err, true, red);
    return !(merr <= 0.02f * mref + 1e-6f);
}
__device__ __forceinline__ void selfcheck_attn(const Params& P, LAS unsigned char* lds, int l, int G) {
    int tid_l = threadIdx.x; asm volatile("" : "+v"(tid_l)); const int tid = tid_l; unsigned char* ws = P.ws;
    unsigned* flag = (unsigned*)(ws + WS_CTL) + CW_CHK; unsigned* ctl = (unsigned*)(ws + WS_CTL) + l * CW_LAYER;
    const bf16_t* Q = (const bf16_t*)(ws + WS_Q); const bf16_t* KK = (const bf16_t*)(ws + WS_K); const bf16_t* VT = (const bf16_t*)(ws + WS_VT); const bf16_t* KPE = (const bf16_t*)(ws + WS_KPE);
    const bf16_t* MQ = (const bf16_t*)(ws + WS_MQ); const bf16_t* MK = (const bf16_t*)(ws + WS_MK); const bf16_t* MVT = (const bf16_t*)(ws + WS_MVT);
    const bf16_t* CC = (const bf16_t*)(ws + WS_CONCAT); const bf16_t* CQN = (const bf16_t*)(ws + WS_CQN); const bf16_t* CKVN = (const bf16_t*)(ws + WS_CKVN);
    const int* kmean = (const int*)(ctl + CW_KMEAN); const float* RM = (const float*)(ws + WS_ROPE_MLA);
    LAS float* sbuf = (LAS float*)lds;
    LAS float* qv = (LAS float*)(lds + 65536);
    LAS float* obuf = (LAS float*)(lds + 65536 + 4096);
    LAS float* red = (LAS float*)(lds + 65536 + 8192);
    LAS int* kmap = (LAS int*)(lds + 65536 + 12288);
    LAS float* gate = (LAS float*)(lds + 65536 + 20480);
    LAS int* sel = (LAS int*)(lds + 65536 + 20480 + 256);
    for (int smp = blockIdx.x; smp < 256; smp += G) {
        const int t = chk_token(smp), h = smp & 3; unsigned bad = 0u;
        __syncthreads();
        if (tid < 192) qv[tid] = bf2f(Q[(size_t)t * 768 + h * 192 + tid]);
        __syncthreads();
        for (int k = tid; k <= t; k += NT) { const bf16_t* kr = KK + (size_t)k * 768 + h * 192; float sc = 0.f; for (int d = 0; d < 192; ++d) sc += qv[d] * bf2f(kr[d]); sbuf[k] = sc; }
        __syncthreads();
        if (chk_softmax_pv(tid, sbuf, nullptr, t + 1, VT + (size_t)h * 128 * S, CC, t, h * 128, red, obuf)) bad |= 1u;
        const int own = t >> 8;
        if (tid < 128) qv[tid] = bf2f(MQ[(size_t)t * 512 + h * 128 + tid]);
        __syncthreads();
        if (tid < 64) { float g = -INFINITY; if (tid < own) { g = 0.f; for (int d = 0; d < 128; ++d) g += qv[d] * ((float)kmean[(size_t)(h * 64 + tid) * 128 + d] * KM_INV) * (1.f / 256.f); } gate[tid] = g; }
        __syncthreads();
        if (tid == 0) { int ns = own < 3 ? own : 3; float last = 0.f; for (int p = 0; p < 4; ++p) { int bi = -1; float bv = -INFINITY; for (int b = 0; b < own; ++b) if (gate[b] > bv) { bv = gate[b]; bi = b; }
                if (p < 3) { sel[p] = bi; last = bv; if (bi >= 0) gate[bi] = -INFINITY; } else sel[4] = (own > 3 && last - bv < 1e-4f * (fabsf(last) + 1e-3f)) ? 1 : 0; }
            sel[3] = ns; }
        __syncthreads();
        const int ns = sel[3], skip = sel[4]; const int nown = t - 256 * own + 1, n = 256 * ns + nown;
        for (int kk = tid; kk < n; kk += NT) { const int key = kk < 256 * ns ? 256 * sel[kk >> 8] + (kk & 255) : 256 * own + (kk - 256 * ns); kmap[kk] = key;
            const bf16_t* kr = MK + (size_t)key * 512 + h * 128; float sc = 0.f; for (int d = 0; d < 128; ++d) sc += qv[d] * bf2f(kr[d]); sbuf[kk] = sc; }
        __syncthreads();
        if (chk_softmax_pv(tid, sbuf, kmap, n, MVT + (size_t)h * 128 * S, CC, t, 512 + h * 128, red, obuf) && !skip) bad |= 2u;
        { const float* wuq = P.in[4] + (size_t)l * 512 * 768; const float* gq = P.in[3] + l * 512;
          for (int nn = tid; nn < 768; nn += NT) { float a = 0.f; for (int k = 0; k < 512; ++k) a += bf2f(CQN[(size_t)t * 512 + k]) * gq[k] * wuq[(size_t)k * 768 + nn]; qv[nn] = a * CQ_SCALE; }
          __syncthreads();
          float ref = 0.f, err = 0.f;
          for (int nn = tid; nn < 768; nn += NT) { const int hd = nn / 192, d = nn - hd * 192; float v; int pos;
              if (d < 128) { v = qv[nn]; pos = nn; }
              else { const int e = d - 128, j = e & 31; const float x1 = qv[hd * 192 + 128 + j], x2 = qv[hd * 192 + 160 + j], c = RM[((size_t)t * 32 + j) * 2], sn = RM[((size_t)t * 32 + j) * 2 + 1];
                  v = e < 32 ? x1 * c - x2 * sn : x1 * sn + x2 * c; pos = hd * 192 + 128 + 2 * j + (e >> 5); }
              ref = fmaxf(ref, fabsf(v)); err = fmaxf(err, fabsf(v - bf2f(Q[(size_t)t * 768 + pos]))); }
          const float mref = blk_reduce(tid, ref, true, red), merr = blk_reduce(tid, err, true, red);
          if (!(merr <= 0.03f * mref + 1e-6f)) bad |= 4u; }
        { const float* wkv = P.in[6] + (size_t)l * 256 * 1024; const float* gk = P.in[5] + l * 256; float ref = 0.f, err = 0.f;
          for (int nn = tid; nn < 1024; nn += NT) { float a = 0.f; for (int k = 0; k < 256; ++k) a += bf2f(CKVN[(size_t)t * 256 + k]) * gk[k] * wkv[(size_t)k * 1024 + nn];
              const int hd = nn >> 8, d = nn & 255; const float got = d < 128 ? bf2f(KK[(size_t)t * 768 + hd * 192 + d]) : bf2f(VT[(size_t)(hd * 128 + d - 128) * S + t]);
              ref = fmaxf(ref, fabsf(a)); err = fmaxf(err, fabsf(a - got)); }
          if (tid < 256) { const int hd = tid >> 6, e = tid & 63; if (KK[(size_t)t * 768 + hd * 192 + 128 + e] != KPE[(size_t)t * 64 + e]) err = 1e30f; }
          const float mref = blk_reduce(tid, ref, true, red), merr = blk_reduce(tid, err, true, red);
          if (!(merr <= 0.03f * mref + 1e-6f)) bad |= 8u; }
        { const int b = (smp >> 2) & 63; float ref = 0.f, err = 0.f;
          if (tid < 128) { float a = 0.f; for (int i = 0; i < 256; ++i) a += bf2f(MK[(size_t)(256 * b + i) * 512 + h * 128 + tid]); a *= (1.f / 256.f); ref = fabsf(a); err = fabsf(a - (float)kmean[(size_t)(h * 64 + b) * 128 + tid] * KM_INV * (1.f / 256.f)); }
          const float mref = blk_reduce(tid, ref, true, red), merr = blk_reduce(tid, err, true, red);
          if (!(merr <= 0.02f * mref + 1e-6f)) bad |= 16u; }
        if (tid == 0 && bad) atomicOr(flag, bad);
    }
    __syncthreads();
}
__device__ __forceinline__ void selfcheck_p2a(const Params& P, LAS unsigned char* lds, int G) {
    int tid_l = threadIdx.x; asm volatile("" : "+v"(tid_l)); const int tid = tid_l; unsigned char* ws = P.ws; unsigned* flag = (unsigned*)(ws + WS_CTL) + CW_CHK;
    const bf16_t* H = (const bf16_t*)(ws + WS_H); const bf16_t* MQ = (const bf16_t*)(ws + WS_MQ); const bf16_t* MK = (const bf16_t*)(ws + WS_MK); const bf16_t* MVT = (const bf16_t*)(ws + WS_MVT); const bf16_t* KPE = (const bf16_t*)(ws + WS_KPE);
    const float* RM = (const float*)(ws + WS_ROPE_MLA); const float* RO = (const float*)(ws + WS_ROPE_MOBA);
    LAS float* red = (LAS float*)(lds + 65536 + 8192);
    for (int smp = blockIdx.x; smp < 256; smp += G) { const int t = chk_token(smp); float err = 0.f; const bf16_t* hr = H + (size_t)t * HLD;
        { const int c = tid, d = c & 127; float q = bf2f(hr[C_MQ + c]), k = bf2f(hr[C_MK + c]);
          if (d < 32) { const int j = d & 15; const float cs = RO[((size_t)t * 16 + j) * 2], sn = RO[((size_t)t * 16 + j) * 2 + 1];
              const float q1 = bf2f(hr[C_MQ + (c & ~31) + j]), q2 = bf2f(hr[C_MQ + (c & ~31) + 16 + j]), k1 = bf2f(hr[C_MK + (c & ~31) + j]), k2 = bf2f(hr[C_MK + (c & ~31) + 16 + j]);
              q = d < 16 ? q1 * cs - q2 * sn : q1 * sn + q2 * cs; k = d < 16 ? k1 * cs - k2 * sn : k1 * sn + k2 * cs; }
          err = fmaxf(err, fabsf(q * CM_SCALE - bf2f(MQ[(size_t)t * 512 + c])) / (fabsf(q * CM_SCALE) + 0.05f));
          err = fmaxf(err, fabsf(k - bf2f(MK[(size_t)t * 512 + c])) / (fabsf(k) + 0.5f));
          if (MVT[(size_t)c * S + t] != hr[C_MV + c]) err = 1e30f;
          if (c < 64) { const int j = c & 31; const float x1 = bf2f(hr[C_KR + j]), x2 = bf2f(hr[C_KR + 32 + j]), cs = RM[((size_t)t * 32 + j) * 2], sn = RM[((size_t)t * 32 + j) * 2 + 1];
              const float v = c < 32 ? x1 * cs - x2 * sn : x1 * sn + x2 * cs; err = fmaxf(err, fabsf(v - bf2f(KPE[(size_t)t * 64 + 2 * j + (c >> 5)])) / (fabsf(v) + 0.5f)); } }
        const float merr = blk_reduce(tid, err, true, red);
        if (tid == 0 && !(merr <= 0.02f)) atomicOr(flag, 32u); }
    __syncthreads();
}
#endif

#ifdef USE_CG_SYNC
#define GSYNC() grid.sync()
#else
#define GSYNC() xcd_barrier(xbar)
#endif
template <int l> __device__ __forceinline__ void layer_fwd(const Params& P, LAS unsigned char* lds, cg::grid_group& grid, const XcdBarrier& xbar, const int G) {
    unsigned char* ws = P.ws;

        unsigned* ctl = (unsigned*)(ws + WS_CTL) + l * CW_LAYER;
        bf16_t* Y = (bf16_t*)(ws + WS_Y); float* stats1 = (float*)(ws + WS_STATS); float* stats2 = stats1 + (size_t)S * 2;
#ifndef SKIP_G1
        { EpiStore E{(bf16_t*)(ws + WS_H), HLD}; GEMM_CALL(EpiStore, E, ws + WS_XB, ws + WS_WIN, HLD, D, (int)blockIdx.x); }
#endif
#ifdef REP_G1
        GSYNC(); { EpiStore E{(bf16_t*)(ws + WS_H), HLD}; GEMM_CALL(EpiStore, E, ws + WS_XB, ws + WS_WIN, HLD, D, (int)blockIdx.x); }
#endif
        GSYNC();

#ifndef SKIP_P2A
        p2a_phase(P, l, lds, G);
#endif
#ifdef SELFCHECK
        GSYNC(); selfcheck_p2a(P, lds, G);
#endif
#ifdef REP_P2A
        GSYNC(); p2a_phase(P, l, lds, G);
#endif

        GSYNC();
#ifndef SKIP_G2
        { EpiQ E{(bf16_t*)(ws + WS_Q), (const float*)(ws + WS_ROPE_MLA)}; GEMM_CALL(EpiQ, E, ws + WS_CQN, ws + WS_WUQ, 768, 512, (int)blockIdx.x); }
#endif
#ifndef SKIP_G3
        { EpiKV E{(bf16_t*)(ws + WS_K), (bf16_t*)(ws + WS_VR), (const bf16_t*)(ws + WS_KPE), ctl + CW_KNPIECE}; int kkv = 256; asm volatile("" : "+s"(kkv)); GEMM_CALL(EpiKV, E, ws + WS_CKVN, ws + WS_WUKV, 1024, kkv, (int)blockIdx.x);
          __threadfence_block(); __syncthreads();
          { pg8::StaticOrder so2; so2.init(S, 1024, G, (int)blockIdx.x); pg8::Unit u2; for (int i2 = 0; so2.next(i2, u2); ++i2) vt_tile((const bf16_t*)(ws + WS_VR), (bf16_t*)(ws + WS_VT), u2.pm, u2.pn); } }
#endif
#ifndef SKIP_G4
        { EpiStore E{(bf16_t*)(ws + WS_CONCAT) + 1024, D}; GEMM_CALL(EpiStore, E, ws + WS_CONVA, ws + WS_WPW, 512, 512, (int)((blockIdx.x + 128) % G)); }
#endif
#ifndef SKIP_G5
        { EpiStore E{(bf16_t*)(ws + WS_CONCAT) + 1536, D}; GEMM_CALL(EpiStore, E, ws + WS_POOLED, ws + WS_WPOOL, 512, 512, (int)((blockIdx.x + 64) % G)); }
#endif

#ifndef SKIP_GATE
        gate_phase(P, l, lds, G);
#endif
#ifdef REP_GATE
        gate_phase(P, l, lds, G, 1);
#endif
#ifdef REP_P2B
        { EpiQ E{(bf16_t*)(ws + WS_Q), (const float*)(ws + WS_ROPE_MLA)}; GEMM_CALL(EpiQ, E, ws + WS_CQN, ws + WS_WUQ, 768, 512, (int)blockIdx.x); }
        { EpiStore E{(bf16_t*)(ws + WS_CONCAT) + 1024, D}; GEMM_CALL(EpiStore, E, ws + WS_CONVA, ws + WS_WPW, 512, 512, (int)((blockIdx.x + 128) % G)); }
        { EpiStore E{(bf16_t*)(ws + WS_CONCAT) + 1536, D}; GEMM_CALL(EpiStore, E, ws + WS_POOLED, ws + WS_WPOOL, 512, 512, (int)((blockIdx.x + 64) % G)); }
#endif

        GSYNC();

#ifndef SKIP_ATTN
        attn_phase(P, l, lds, G);
#endif
#ifdef REP_ATTN
        GSYNC(); attn_phase(P, l, lds, G, 1);
#endif

        GSYNC();

#ifndef SKIP_NORM
        attn_norm_phase(P, G);
#endif
#ifdef SELFCHECK
        GSYNC(); selfcheck_attn(P, lds, l, G);
#endif
#ifdef REP_LN
        GSYNC(); attn_norm_phase(P, G);
#endif

        GSYNC();
#ifndef SKIP_G6
        if (l == 0) { EpiRes<0> E{P.in[0], Y, nullptr, nullptr, nullptr}; GEMM_CALL(EpiRes<0>, E, ws + WS_CONCAT, ws + WS_WOUT, D, D, (int)blockIdx.x); }
        else { EpiRes<1> E{nullptr, Y, stats2, P.in[20] + (size_t)(l - 1) * D, P.in[21] + (size_t)(l - 1) * D}; GEMM_CALL(EpiRes<1>, E, ws + WS_CONCAT, ws + WS_WOUT, D, D, (int)blockIdx.x); }
#endif
        GSYNC();
        ln_phase<false>(Y, P.in[15] + (size_t)l * D, P.in[16] + (size_t)l * D, stats1, (bf16_t*)(ws + WS_XB), nullptr, G);
        GSYNC();
#ifdef REP_LN
        ln_phase<false>(Y, P.in[15] + (size_t)l * D, P.in[16] + (size_t)l * D, stats1, (bf16_t*)(ws + WS_XB), nullptr, G);
        GSYNC();
#endif
#ifndef SKIP_G8
        { EpiFfn E{(bf16_t*)(ws + WS_ACT)}; GEMM_CALL(EpiFfn, E, ws + WS_XB, ws + WS_WGU, 2 * DFF, D, (int)blockIdx.x); }
#endif
#ifdef REP_G8
        GSYNC(); { EpiFfn E{(bf16_t*)(ws + WS_ACT)}; GEMM_CALL(EpiFfn, E, ws + WS_XB, ws + WS_WGU, 2 * DFF, D, (int)blockIdx.x); }
#endif
        GSYNC();
#ifndef SKIP_G9
        { EpiRes<1> E{nullptr, Y, stats1, P.in[15] + (size_t)l * D, P.in[16] + (size_t)l * D}; GEMM_CALL(EpiRes<1>, E, ws + WS_ACT, ws + WS_WDN, D, DFF, (int)blockIdx.x); }
#endif
        GSYNC();
        if (l + 1 < NLAYER) { ln_phase<false>(Y, P.in[20] + (size_t)l * D, P.in[21] + (size_t)l * D, stats2, (bf16_t*)(ws + WS_XB), nullptr, G); prep_weights(P, l + 1, lds, G); GSYNC();
#ifdef REP_PREP
            prep_weights(P, l + 1, lds, G); GSYNC();
#endif
#ifdef REP_LN
            ln_phase<false>(Y, P.in[20] + (size_t)l * D, P.in[21] + (size_t)l * D, stats2, (bf16_t*)(ws + WS_XB), nullptr, G); GSYNC();
#endif
        }
#ifdef SELFCHECK
        else ln_phase<true>(Y, P.in[20] + (size_t)l * D, P.in[21] + (size_t)l * D, nullptr, nullptr, P.out, G, (float)(*((const unsigned*)(ws + WS_CTL) + 40)));
#else
        else ln_phase<true>(Y, P.in[20] + (size_t)l * D, P.in[21] + (size_t)l * D, nullptr, nullptr, P.out, G);
#endif

}

__global__ void __launch_bounds__(NT, 2) hybrid_fwd(Params P) {
    extern __shared__ __attribute__((aligned(16))) unsigned char lds_raw[];
    LAS unsigned char* lds = (LAS unsigned char*)lds_raw;
    cg::grid_group grid = cg::this_grid();
    const int G = gridDim.x;
    unsigned char* ws = P.ws;
    volatile LAS unsigned* xst = (volatile LAS unsigned*)(lds + LDS_MISC + 8192);
    if (threadIdx.x < 2) xst[threadIdx.x] = 0u;
    __syncthreads();
    const XcdBarrier xbar = xcd_barrier_post((unsigned*)(ws + WS_CTL) + CW_BAR, xst);

#ifndef SKIP_PREP
    prep_weights(P, 0, lds, G);
    prep_layer0(P, G);
#endif
#ifdef REP_PREP
    GSYNC(); prep_weights(P, 0, lds, G); prep_layer0(P, G);
#endif
#ifdef REP_SYNC
#pragma unroll 1
    for (int i_ = 0; i_ < 20; ++i_) GSYNC();
#endif

    grid.sync();
    layer_fwd<0>(P, lds, grid, xbar, G);
    layer_fwd<1>(P, lds, grid, xbar, G);
}

extern "C" void kernel_launch(void* const* d_in, const int* in_sizes, int n_in, void* d_out, int out_size, void* d_ws, size_t ws_size, hipStream_t stream) {
    static int grid = 0;
    if (grid == 0) {
        if (n_in != 22 || out_size != S * D || ws_size < WS_END) { fprintf(stderr, "kernel_launch: unexpected shapes (n_in %d, out %d, ws %zu)\n", n_in, out_size, ws_size); grid = -1; return; }
        int dev = 0, cus = 0, per_cu = 0;
        hipGetDevice(&dev); hipDeviceGetAttribute(&cus, hipDeviceAttributeMultiprocessorCount, dev);
        if (hipFuncSetAttribute((const void*)hybrid_fwd, hipFuncAttributeMaxDynamicSharedMemorySize, LDS_BYTES) != hipSuccess) { fprintf(stderr, "kernel_launch: hipFuncSetAttribute failed\n"); grid = -1; return; }
        if (hipOccupancyMaxActiveBlocksPerMultiprocessor(&per_cu, (const void*)hybrid_fwd, NT, LDS_BYTES) != hipSuccess || per_cu < 1) per_cu = 1;
        (void)hipGetLastError();
        grid = cus * 1;
        fprintf(stderr, "kernel_launch: %d CUs, occupancy %d, grid %d\n", cus, per_cu, grid);
    }
    if (grid < 0) return;
    hipMemsetAsync((char*)d_ws + WS_CTL, 0, CTL_BYTES, stream);
    Params p{};
    for (int i = 0; i < 22; ++i) p.in[i] = (const float*)d_in[i];
    p.out = (float*)d_out; p.ws = (unsigned char*)d_ws;
    void* args[] = {&p};
    hipError_t e = hipLaunchCooperativeKernel((const void*)hybrid_fwd, dim3(grid), dim3(NT), args, LDS_BYTES, stream);
    if (e != hipSuccess) fprintf(stderr, "cooperative launch failed: %s (grid %d)\n", hipGetErrorString(e), grid);
}
```

```cpp
#include <hip/hip_runtime.h>
#include <hip/hip_cooperative_groups.h>
#include <cstdio>
#include <cstdint>
namespace cg = cooperative_groups;
namespace pg8 {
#define PG8_LAS __attribute__((address_space(3)))
typedef unsigned short bf16_t;
typedef short bf16x8 __attribute__((ext_vector_type(8)));
typedef float f32x4 __attribute__((ext_vector_type(4)));
typedef unsigned u32x4 __attribute__((ext_vector_type(4)));
constexpr int BM = 256, BK = 64, HALF = 128, HTB = HALF * BK * 2  , STAGE_BYTES = 8 * HTB, NXCD = 8, WGM = 4;

__host__ __device__ __forceinline__ int lds_byte(int r, int c) { const int st = (r >> 4) * 2 + (c >> 5), rr = r & 15, cc = c & 31, ob = rr * 64 + cc * 2; return st * 1024 + (ob ^ (((ob >> 9) & 1) << 5)); }
__host__ __device__ __forceinline__ void stage_rc(int b, int& R, int& C) { const int st = b / 1024, sb = b % 1024, swz = sb ^ (((sb >> 9) & 1) << 5); R = (st >> 1) * 16 + swz / 64; C = (st & 1) * 32 + (swz % 64) / 2; }
__host__ __device__ __forceinline__ int perm32(int rho) { const int n = rho >> 4, i = rho & 15; return 8 * (i >> 2) + 4 * n + (i & 3); }

struct Unit { int pm, pn; };
struct Gemm { const bf16_t* A; const bf16_t* Bt; int M, N, K; };

struct StaticOrder {
    int nM, nN, nwg, G, c;
    __host__ __device__ __forceinline__ void init(int M, int N, int G_, int c_) { nM = M / BM; nN = N / BM; nwg = nM * nN; G = G_; c = c_; }
    __host__ __device__ __forceinline__ bool next(int i, Unit& u) const {
        const long L = (long)i * G + c; if (L >= nwg) return false;
        int wgid = (int)L; { const int q = nwg / NXCD, r = nwg % NXCD, xcd = wgid % NXCD, off = wgid / NXCD; wgid = (xcd < r ? xcd * (q + 1) : r * (q + 1) + (xcd - r) * q) + off; }
        const int nig = WGM * nN, gid = wgid / nig, fm = gid * WGM, gsz = (nM - fm) < WGM ? (nM - fm) : WGM;
        u.pm = fm + ((wgid % nig) % gsz); u.pn = (wgid % nig) / gsz; return true;
    }
    __device__ __forceinline__ void a_ready(const Unit&) const {}
    __device__ __forceinline__ void done(const Unit&) const {}
};
__device__ __forceinline__ unsigned cvt_pk_bf16(float lo, float hi) { unsigned r; asm volatile("v_cvt_pk_bf16_f32 %0, %1, %2" : "=v"(r) : "v"(lo), "v"(hi)); return r; }
typedef float f32x2 __attribute__((ext_vector_type(2)));
template <class Epi, class Sched, bool ALIGN_EPI = false, bool SP2 = false>
__device__ __forceinline__ void gemm_phase(PG8_LAS unsigned char* lds, const Gemm g, const Sched& S, const Epi& E) {
    int tid_l = threadIdx.x; asm volatile("" : "+v"(tid_l)); const int tid = tid_l, wid = __builtin_amdgcn_readfirstlane(tid >> 6), lane = tid & 63, wr = wid >> 2, wc = wid & 3, fr = lane & 15, fq = lane >> 4;
    const int K = g.K, nt = K / BK;
    unsigned voffA[2], voffB[2];
#pragma unroll
    for (int i = 0; i < 2; ++i) { int R, C; stage_rc(tid * 16 + i * 8192, R, C); const int Rb = Epi::PERM ? ((R & ~31) + perm32(R & 31)) : R;
        voffA[i] = (unsigned)(R * K + C) * 2u; voffB[i] = (unsigned)(Rb * K + C) * 2u; }
    const size_t kstep = (size_t)(BK * 2);
    const size_t hstep = (size_t)HALF * K * 2;
    const size_t tstep = 2 * hstep;
    const unsigned ldsw = (unsigned)wid * 1024u;
    const int aoff = lds_byte(wr * 64 + fr, fq * 8), boff = lds_byte(wc * 32 + fr, fq * 8);
#define PG8_SA(b, h) (((b) * 2 + (h)) * HTB)
#define PG8_SB(b, h) ((4 + (b) * 2 + (h)) * HTB)
#define PG8_STAGE(bufoff, gbase, voff) do { _Pragma("unroll") for (int _i = 0; _i < 2; ++_i) \
        __builtin_amdgcn_global_load_lds((const unsigned*)((const char*)(gbase) + (voff)[_i]), (PG8_LAS unsigned*)(lds + (bufoff) + ldsw + _i * 8192), 16, 0, 0); } while (0)
#define PG8_LDA(dst, b, h) do { _Pragma("unroll") for (int m = 0; m < 4; ++m) _Pragma("unroll") for (int k = 0; k < 2; ++k) dst[m][k] = *(const PG8_LAS bf16x8*)(lds + PG8_SA(b, h) + aoff + m * 2048 + k * 1024); } while (0)
#define PG8_LDB(dst, b, h) do { _Pragma("unroll") for (int n = 0; n < 2; ++n) _Pragma("unroll") for (int k = 0; k < 2; ++k) dst[n][k] = *(const PG8_LAS bf16x8*)(lds + PG8_SB(b, h) + boff + n * 2048 + k * 1024); } while (0)
#define PG8_MMA(ai, bj, At, Bt) do { __builtin_amdgcn_s_setprio(1); _Pragma("unroll") for (int m = 0; m < 4; ++m) _Pragma("unroll") for (int n = 0; n < 2; ++n) _Pragma("unroll") for (int k = 0; k < 2; ++k) \
        acc[ai][bj][m][n] = __builtin_amdgcn_mfma_f32_16x16x32_bf16(Bt[n][k], At[m][k], acc[ai][bj][m][n], 0, 0, 0); __builtin_amdgcn_s_setprio(0); } while (0)
#define PG8_WAIT_V(n) asm volatile("s_waitcnt vmcnt(" #n ")" ::: "memory")
#define PG8_WAIT_L(n) asm volatile("s_waitcnt lgkmcnt(" #n ")" ::: "memory")
#define PG8_BAR __builtin_amdgcn_s_barrier()
#define PG8_SCHED __builtin_amdgcn_sched_barrier(0)
    Unit cur, nxt; int ui = 0;
    if (!S.next(0, cur)) return;
    f32x4 acc[2][2][4][2];
#pragma unroll
    for (int a = 0; a < 2; ++a)
#pragma unroll
        for (int b = 0; b < 2; ++b)
#pragma unroll
            for (int m = 0; m < 4; ++m)
#pragma unroll
                for (int n = 0; n < 2; ++n) acc[a][b][m][n] = (f32x4){0.f, 0.f, 0.f, 0.f};
    bf16x8 At[4][2], B0[2][2], B1[2][2];
    const char* cA = (const char*)g.A + (size_t)cur.pm * tstep; const char* cB = (const char*)g.Bt + (size_t)cur.pn * tstep;
    S.a_ready(cur);
    if constexpr (SP2) {
        PG8_STAGE(PG8_SB(0, 0), cB, voffB); PG8_STAGE(PG8_SB(0, 1), cB + hstep, voffB); PG8_STAGE(PG8_SA(0, 0), cA, voffA); PG8_STAGE(PG8_SA(0, 1), cA + hstep, voffA);
        if (wr == 1) PG8_BAR;
        PG8_WAIT_V(2); PG8_BAR;
        PG8_STAGE(PG8_SB(1, 0), cB + kstep, voffB); PG8_STAGE(PG8_SA(1, 0), cA + kstep, voffA); PG8_STAGE(PG8_SB(1, 1), cB + hstep + kstep, voffB);
        PG8_WAIT_V(6); PG8_BAR;
    } else {
        PG8_STAGE(PG8_SB(0, 0), cB, voffB); PG8_STAGE(PG8_SA(0, 0), cA, voffA); PG8_STAGE(PG8_SB(0, 1), cB + hstep, voffB); PG8_STAGE(PG8_SA(0, 1), cA + hstep, voffA);
        if (wr == 1) PG8_BAR;
        PG8_WAIT_V(4); PG8_BAR;
        PG8_STAGE(PG8_SB(1, 0), cB + kstep, voffB); PG8_STAGE(PG8_SA(1, 0), cA + kstep, voffA); PG8_STAGE(PG8_SB(1, 1), cB + hstep + kstep, voffB);
        PG8_WAIT_V(6); PG8_BAR;
    }
    for (;;) {
        const bool has_next = S.next(ui + 1, nxt);
        const char* nA = has_next ? (const char*)g.A + (size_t)nxt.pm * tstep : cA; const char* nB = has_next ? (const char*)g.Bt + (size_t)nxt.pn * tstep : cB;
        for (int t = 0; t < nt; t += 2) {
            const bool last = (t == nt - 2);
            const char* a1 = cA + (size_t)(t + 1) * kstep;
            const char* a2 = last ? nA : cA + (size_t)(t + 2) * kstep; const char* b2 = last ? nB : cB + (size_t)(t + 2) * kstep;
            const char* a3 = a2 + kstep; const char* b3 = b2 + kstep;
            if (last && has_next) S.a_ready(nxt);
            if constexpr (SP2) {
            PG8_LDB(B0, 0, 0); PG8_LDB(B1, 0, 1); PG8_SCHED; PG8_LDA(At, 0, 0); PG8_STAGE(PG8_SA(1, 1), a1 + hstep, voffA);
            PG8_WAIT_V(8); PG8_WAIT_L(0); PG8_BAR; PG8_MMA(0, 0, At, B0); PG8_MMA(0, 1, At, B1); PG8_BAR; PG8_SCHED;
            PG8_LDA(At, 0, 1); PG8_STAGE(PG8_SB(0, 0), b2, voffB); PG8_STAGE(PG8_SB(0, 1), b2 + hstep, voffB); PG8_STAGE(PG8_SA(0, 0), a2, voffA);
            PG8_WAIT_V(8); PG8_WAIT_L(0); PG8_BAR; PG8_MMA(1, 0, At, B0); PG8_MMA(1, 1, At, B1); PG8_BAR; PG8_SCHED;
            PG8_LDB(B0, 1, 0); PG8_LDB(B1, 1, 1); PG8_SCHED; PG8_LDA(At, 1, 0); PG8_STAGE(PG8_SA(0, 1), a2 + hstep, voffA);
            PG8_WAIT_V(8); PG8_WAIT_L(0); PG8_BAR; PG8_MMA(0, 0, At, B0); PG8_MMA(0, 1, At, B1); PG8_BAR; PG8_SCHED;
            PG8_LDA(At, 1, 1); PG8_STAGE(PG8_SB(1, 0), b3, voffB); PG8_STAGE(PG8_SB(1, 1), b3 + hstep, voffB); PG8_STAGE(PG8_SA(1, 0), a3, voffA);
            PG8_WAIT_V(8); PG8_WAIT_L(0); PG8_BAR; PG8_MMA(1, 0, At, B0); PG8_MMA(1, 1, At, B1); PG8_BAR; PG8_SCHED;
            } else {
            PG8_LDB(B0, 0, 0); PG8_SCHED; PG8_LDA(At, 0, 0); PG8_STAGE(PG8_SA(1, 1), a1 + hstep, voffA);
            PG8_WAIT_L(8); PG8_BAR; PG8_WAIT_L(0); PG8_MMA(0, 0, At, B0); PG8_BAR; PG8_SCHED;
            PG8_LDB(B1, 0, 1); PG8_STAGE(PG8_SB(0, 0), b2, voffB);
            PG8_BAR; PG8_WAIT_L(0); PG8_MMA(0, 1, At, B1); PG8_BAR;
            PG8_LDA(At, 0, 1); PG8_STAGE(PG8_SA(0, 0), a2, voffA);
            PG8_BAR; PG8_WAIT_L(0); PG8_MMA(1, 0, At, B0); PG8_BAR; PG8_SCHED;
            PG8_STAGE(PG8_SB(0, 1), b2 + hstep, voffB);
            PG8_WAIT_V(6); PG8_BAR; PG8_MMA(1, 1, At, B1); PG8_BAR;
            PG8_LDB(B0, 1, 0); PG8_SCHED; PG8_LDA(At, 1, 0); PG8_STAGE(PG8_SA(0, 1), a2 + hstep, voffA);
            PG8_WAIT_L(8); PG8_BAR; PG8_WAIT_L(0); PG8_MMA(0, 0, At, B0); PG8_BAR; PG8_SCHED;
            PG8_LDB(B1, 1, 1); PG8_STAGE(PG8_SB(1, 0), b3, voffB);
            PG8_BAR; PG8_WAIT_L(0); PG8_MMA(0, 1, At, B1); PG8_BAR;
            PG8_LDA(At, 1, 1); PG8_STAGE(PG8_SA(1, 0), a3, voffA);
            PG8_BAR; PG8_WAIT_L(0); PG8_MMA(1, 0, At, B0); PG8_BAR; PG8_SCHED;
            PG8_STAGE(PG8_SB(1, 1), b3 + hstep, voffB);
            PG8_WAIT_V(6); PG8_BAR; PG8_MMA(1, 1, At, B1); PG8_BAR;
            }
        }
        if constexpr (ALIGN_EPI) { if (wr == 0) PG8_BAR; }
        if constexpr (!Epi::AFTER_DRAIN) { E(acc, cur, wr, wc, fr, fq); S.done(cur); }
        if (!has_next) break;
#pragma unroll
        for (int a = 0; a < 2; ++a)
#pragma unroll
            for (int b = 0; b < 2; ++b)
#pragma unroll
                for (int m = 0; m < 4; ++m)
#pragma unroll
                    for (int n = 0; n < 2; ++n) acc[a][b][m][n] = (f32x4){0.f, 0.f, 0.f, 0.f};
        cur = nxt; cA = nA; cB = nB; ++ui;
        if constexpr (ALIGN_EPI) { if (wr == 1) PG8_BAR; }
    }
    PG8_WAIT_V(0);
    if constexpr (!ALIGN_EPI) { if (wr == 0) PG8_BAR; }
    PG8_BAR;
    if constexpr (Epi::AFTER_DRAIN) { E.fused(acc, cur, wr, wc, fr, fq, lds, wid, lane); S.done(cur); }
#undef PG8_SA
#undef PG8_SB
#undef PG8_STAGE
#undef PG8_LDA
#undef PG8_LDB
#undef PG8_MMA
#undef PG8_WAIT_V
#undef PG8_WAIT_L
#undef PG8_BAR
#undef PG8_SCHED
}
}

#define LAS __attribute__((address_space(3)))
typedef unsigned short bf16_t;
typedef short bf16x8 __attribute__((ext_vector_type(8)));
typedef float f32x2 __attribute__((ext_vector_type(2)));
typedef float f32x4 __attribute__((ext_vector_type(4)));
typedef float f32x16 __attribute__((ext_vector_type(16)));
typedef unsigned u32x2 __attribute__((ext_vector_type(2)));
typedef unsigned u32x4 __attribute__((ext_vector_type(4)));
typedef __bf16 bf16x2_t __attribute__((ext_vector_type(2)));

constexpr int S = 16384, D = 2048, NLAYER = 2, HLD = 4096, DFF = 5632, INC = 3904;
constexpr int C_CQ = 0, C_CKV = 512, C_KR = 768, C_MQ = 832, C_MK = 1344, C_MV = 1856, C_CONV = 2368, C_POOL = 3392;
constexpr float EPS = 1e-5f, ALPHA = 1.41421356237309515f, LOG2E = 1.4426950408889634f;
constexpr float CQ_SCALE = 0.07216878364870323f * LOG2E;
constexpr float CM_SCALE = 0.08838834764831845f * LOG2E;
constexpr int NT = 512, NWV = 8;
constexpr float KM_FIX = 1048576.f, KM_INV = 1.f / 1048576.f;
constexpr int LDS_BYTES = 147456, LDS_MISC = 131072;

constexpr size_t MiB = (size_t)1 << 20;
constexpr size_t WS_CTL = 0, CTL_BYTES = 1 * MiB;
constexpr size_t WS_WIN = 1 * MiB, WS_WUQ = 17 * MiB, WS_WUKV = 18 * MiB, WS_WPW = 19 * MiB, WS_WPOOL = 20 * MiB, WS_WOUT = 21 * MiB, WS_WGU = 29 * MiB, WS_WDN = 73 * MiB;
constexpr size_t WS_ROPE_MLA = 95 * MiB, WS_ROPE_MOBA = 99 * MiB, WS_STATS = 101 * MiB;
constexpr size_t WS_Y = 102 * MiB, WS_XB = 230 * MiB;
constexpr size_t WS_CQN = 230 * MiB, WS_CKVN = 246 * MiB, WS_KPE = 254 * MiB, WS_CONVA = 256 * MiB, WS_POOLED = 272 * MiB;
constexpr size_t WS_H = 294 * MiB;
constexpr size_t WS_Q = 294 * MiB, WS_K = 318 * MiB, WS_VT = 342 * MiB, WS_CONCAT = 358 * MiB;
constexpr size_t WS_MQ = 422 * MiB, WS_MK = 438 * MiB, WS_MVT = 454 * MiB;
constexpr size_t WS_VR = 470 * MiB;
constexpr size_t WS_ACT = 294 * MiB, WS_END = 486 * MiB;
constexpr int CW_LAYER = 33792, CW_QCTR = 0, CW_KPEMAX = 1, CW_KNPIECE = 4, CW_KMMAX = 20, CW_CNT = 64, CW_KMEAN = 1024;

constexpr size_t DO_PART = 0, DO_PL = 34 * MiB, DO_PARTB = 36 * MiB, DO_LB = 101 * MiB, DO_LIST = 104 * MiB;

struct Params { const float* in[22]; float* out; unsigned char* ws; };

__device__ __forceinline__ unsigned f2bf(float f) { unsigned u = __float_as_uint(f); return (u + 0x7fffu + ((u >> 16) & 1u)) >> 16; }
__device__ __forceinline__ float bf2f(unsigned h) { return __uint_as_float(h << 16); }
__device__ __forceinline__ unsigned pk2(float lo, float hi) { f32x2 v = {lo, hi}; bf16x2_t b = __builtin_convertvector(v, bf16x2_t); return __builtin_bit_cast(unsigned, b); }
__device__ __forceinline__ float wave_sum(float v) {
#pragma unroll
    for (int o = 1; o < 64; o <<= 1) v += __shfl_xor(v, o);
    return v;
}
__device__ __forceinline__ float sigmoidf_(float x) { return __builtin_amdgcn_rcpf(1.f + __expf(-x)); }

typedef const pg8::f32x4 (&AccRef)[2][2][4][2];

struct EpiStore {
    static constexpr bool PERM = true, AFTER_DRAIN = false;
    bf16_t* O; int ldc;
    __device__ __forceinline__ void operator()(AccRef acc, const pg8::Unit& u, int wr, int wc, int fr, int fq) const {
        const int row0 = u.pm * 256 + wr * 64 + fr, col0 = u.pn * 256 + wc * 32 + 8 * fq;
#pragma unroll
        for (int ai = 0; ai < 2; ++ai)
#pragma unroll
            for (int m = 0; m < 4; ++m) { bf16_t* rowp = O + (size_t)(row0 + ai * 128 + m * 16) * ldc + col0;
#pragma unroll
                for (int bj = 0; bj < 2; ++bj) { const f32x4 v0 = acc[ai][bj][m][0], v1 = acc[ai][bj][m][1];
                    u32x4 w; w.x = pk2(v0[0], v0[1]); w.y = pk2(v0[2], v0[3]); w.z = pk2(v1[0], v1[1]); w.w = pk2(v1[2], v1[3]);
                    *(u32x4*)(rowp + bj * 128) = w; } }
    }
};

struct EpiQ {
    static constexpr bool PERM = true, AFTER_DRAIN = false;
    bf16_t* O; const float* rope;
    __device__ __forceinline__ void operator()(AccRef acc, const pg8::Unit& u, int wr, int wc, int fr, int fq) const {
        const int row0 = u.pm * 256 + wr * 64 + fr;
#pragma unroll
        for (int bj = 0; bj < 2; ++bj) {
            const int c0 = u.pn * 256 + bj * 128 + wc * 32 + 8 * fq; const int d0 = c0 % 192; const bool rp = d0 >= 128; const int jc = rp ? (d0 - 128) >> 1 : 0;
#pragma unroll
            for (int ai = 0; ai < 2; ++ai)
#pragma unroll
                for (int m = 0; m < 4; ++m) { const int row = row0 + ai * 128 + m * 16;
                    f32x4 v0 = acc[ai][bj][m][0] * CQ_SCALE, v1 = acc[ai][bj][m][1] * CQ_SCALE;
                    const f32x4 t0 = *(const f32x4*)(rope + ((size_t)row * 32 + jc) * 2), t1 = *(const f32x4*)(rope + ((size_t)row * 32 + jc + 2) * 2);
                    if (rp) {
                        f32x4 a, b;
                        a[0] = v0[0] * t0[0] - v0[1] * t0[1]; a[1] = v0[0] * t0[1] + v0[1] * t0[0];
                        a[2] = v0[2] * t0[2] - v0[3] * t0[3]; a[3] = v0[2] * t0[3] + v0[3] * t0[2];
                        b[0] = v1[0] * t1[0] - v1[1] * t1[1]; b[1] = v1[0] * t1[1] + v1[1] * t1[0];
                        b[2] = v1[2] * t1[2] - v1[3] * t1[3]; b[3] = v1[2] * t1[3] + v1[3] * t1[2];
                        v0 = a; v1 = b; }
                    u32x4 w; w.x = pk2(v0[0], v0[1]); w.y = pk2(v0[2], v0[3]); w.z = pk2(v1[0], v1[1]); w.w = pk2(v1[2], v1[3]);
                    *(u32x4*)(O + (size_t)row * 768 + c0) = w; }
        }
    }
};

struct EpiKV {
    static constexpr bool PERM = true, AFTER_DRAIN = false;
    bf16_t* K; bf16_t* VR; const bf16_t* KPE; unsigned* piece;
    __device__ __forceinline__ void operator()(AccRef acc, const pg8::Unit& u, int wr, int wc, int fr, int fq) const {
        const int row0 = u.pm * 256 + wr * 64 + fr, cc = wc * 32 + 8 * fq, hd = u.pn;
        float pmax = 0.f;
#pragma unroll
        for (int ai = 0; ai < 2; ++ai)
#pragma unroll
            for (int m = 0; m < 4; ++m) { const int row = row0 + ai * 128 + m * 16;
                { const f32x4 v0 = acc[ai][0][m][0], v1 = acc[ai][0][m][1];
                  u32x4 w; w.x = pk2(v0[0], v0[1]); w.y = pk2(v0[2], v0[3]); w.z = pk2(v1[0], v1[1]); w.w = pk2(v1[2], v1[3]);
                  *(u32x4*)(K + (size_t)row * 768 + hd * 192 + cc) = w;
                  float ss = (v0[0] * v0[0] + v0[1] * v0[1]) + (v0[2] * v0[2] + v0[3] * v0[3]) + (v1[0] * v1[0] + v1[1] * v1[1]) + (v1[2] * v1[2] + v1[3] * v1[3]);
                  ss += __shfl_xor(ss, 16); ss += __shfl_xor(ss, 32); pmax = fmaxf(pmax, ss); }
                { const f32x4 v0 = acc[ai][1][m][0], v1 = acc[ai][1][m][1];
                  u32x4 w; w.x = pk2(v0[0], v0[1]); w.y = pk2(v0[2], v0[3]); w.z = pk2(v1[0], v1[1]); w.w = pk2(v1[2], v1[3]);
                  *(u32x4*)(VR + (size_t)row * 512 + hd * 128 + cc) = w; }
                }
        if (wc < 2) { u32x4 kp[8];
#pragma unroll
            for (int q8 = 0; q8 < 8; ++q8) kp[q8] = *(const u32x4*)(KPE + (size_t)(row0 + (q8 >> 2) * 128 + (q8 & 3) * 16) * 64 + cc);
#pragma unroll
            for (int q8 = 0; q8 < 8; ++q8) *(u32x4*)(K + (size_t)(row0 + (q8 >> 2) * 128 + (q8 & 3) * 16) * 768 + hd * 192 + 128 + cc) = kp[q8]; }
#pragma unroll
        for (int o = 1; o < 16; o <<= 1) pmax = fmaxf(pmax, __shfl_xor(pmax, o));
        if ((threadIdx.x & 63) == 0) atomicMax(piece + hd * 4 + wc, __float_as_uint(pmax));
    }
};
__device__ __forceinline__ void vt_tile(const bf16_t* VR, bf16_t* VT, int pm, int pn) {
    int tid = threadIdx.x; asm volatile("" : "+v"(tid));
    const int dv = tid & 127, seg = tid >> 7; const int t0 = 256 * pm + 64 * seg;
    const bf16_t* src = VR + (size_t)t0 * 512 + pn * 128 + dv; unsigned pk[32];
#pragma unroll
    for (int i = 0; i < 32; ++i) pk[i] = (unsigned)src[(size_t)(2 * i) * 512] | ((unsigned)src[(size_t)(2 * i + 1) * 512] << 16);
    u32x4* dst = (u32x4*)(VT + (size_t)(pn * 128 + dv) * S + t0);
#pragma unroll
    for (int i = 0; i < 8; ++i) dst[i] = (u32x4){pk[4 * i], pk[4 * i + 1], pk[4 * i + 2], pk[4 * i + 3]};
}

template <int MODE>
struct EpiRes {
    static constexpr bool PERM = true, AFTER_DRAIN = false;
    const float* xin; bf16_t* Y; const float* stats; const float* g; const float* b;
    __device__ __forceinline__ void operator()(AccRef acc, const pg8::Unit& u, int wr, int wc, int fr, int fq) const {
        const int row0 = u.pm * 256 + wr * 64 + fr, col0 = u.pn * 256 + wc * 32 + 8 * fq;
#pragma unroll
        for (int bj = 0; bj < 2; ++bj) { const int col = col0 + bj * 128;
            f32x4 g0, g1, b0, b1;
            if (MODE == 1) { g0 = *(const f32x4*)(g + col); g1 = *(const f32x4*)(g + col + 4); b0 = *(const f32x4*)(b + col); b1 = *(const f32x4*)(b + col + 4); }
#pragma unroll
            for (int ai = 0; ai < 2; ++ai)
#pragma unroll
                for (int m = 0; m < 4; ++m) { const int row = row0 + ai * 128 + m * 16; const size_t off = (size_t)row * D + col;
                    f32x4 r0, r1;
                    if (MODE == 0) { r0 = *(const f32x4*)(xin + off); r1 = *(const f32x4*)(xin + off + 4); }
                    else { const f32x2 st = *(const f32x2*)(stats + (size_t)row * 2); const u32x4 raw = *(const u32x4*)(Y + off);
                        r0 = (f32x4){bf2f(raw.x & 0xffffu), bf2f(raw.x >> 16), bf2f(raw.y & 0xffffu), bf2f(raw.y >> 16)}; r1 = (f32x4){bf2f(raw.z & 0xffffu), bf2f(raw.z >> 16), bf2f(raw.w & 0xffffu), bf2f(raw.w >> 16)};
                        r0 = (r0 - st.x) * st.y * g0 + b0; r1 = (r1 - st.x) * st.y * g1 + b1; }
                    r0 = r0 * ALPHA + acc[ai][bj][m][0]; r1 = r1 * ALPHA + acc[ai][bj][m][1];
                    u32x4 w; w.x = pk2(r0[0], r0[1]); w.y = pk2(r0[2], r0[3]); w.z = pk2(r1[0], r1[1]); w.w = pk2(r1[2], r1[3]);
                    *(u32x4*)(Y + off) = w; }
        }
    }
};

struct EpiFfn {
    static constexpr bool PERM = true, AFTER_DRAIN = false;
    bf16_t* O;
    __device__ __forceinline__ void operator()(AccRef acc, const pg8::Unit& u, int wr, int wc, int fr, int fq) const {
        const int row0 = u.pm * 256 + wr * 64 + fr, col0 = u.pn * 128 + wc * 32 + 8 * fq;
#pragma unroll
        for (int ai = 0; ai < 2; ++ai)
#pragma unroll
            for (int m = 0; m < 4; ++m) { const int row = row0 + ai * 128 + m * 16;
                float r[8];
#pragma unroll
                for (int n = 0; n < 2; ++n)
#pragma unroll
                    for (int e = 0; e < 4; ++e) { const float gt = acc[ai][0][m][n][e], up = acc[ai][1][m][n][e]; r[n * 4 + e] = gt * sigmoidf_(gt) * up; }
                u32x4 w; w.x = pk2(r[0], r[1]); w.y = pk2(r[2], r[3]); w.z = pk2(r[4], r[5]); w.w = pk2(r[6], r[7]);
                *(u32x4*)(O + (size_t)row * DFF + col0) = w; }
    }
};

#define GEMM_CALL(EPIT, E, A_, B_, N_, K_, CID) do { pg8::Gemm g_{(const bf16_t*)(A_), (const bf16_t*)(B_), S, (N_), (K_)}; pg8::StaticOrder so_; so_.init(S, (N_), G, (CID)); \
    pg8::gemm_phase<EPIT, pg8::StaticOrder, true, true>(lds, g_, so_, (E)); } while (0)

struct TrSpec { const float* W; int ldn, K, N; bf16_t* WT; int ldk, mode; const float* sk; const float* sn; };
__device__ __forceinline__ int drow_of(int mode, int n) {
    if (mode == 1) { const int hd = n / 192, d = n - hd * 192; if (d < 128) return n; const int e = d - 128; return hd * 192 + 128 + 2 * (e & 31) + (e >> 5); }
    if (mode == 4) return ((n >> 7) << 8) + (n & 127);
    if (mode == 5) return ((n >> 7) << 8) + 128 + (n & 127);
    return n;
}
__device__ __forceinline__ void transpose_items(const TrSpec& t, LAS float* scr, int gw, int ngw, int lane) {
    const int nblk = t.N / 32, nitems = (t.K / 64) * nblk;
    for (int it = gw; it < nitems; it += ngw) {
        const int kb = it / nblk, nb = it - kb * nblk, k0 = 64 * kb, n0 = 32 * nb;
        const float snv = t.sn ? t.sn[n0 + (lane & 31)] : 1.f;
        const float* wp = t.W + (size_t)(k0 + (lane >> 5)) * t.ldn + n0 + (lane & 31);
        if (t.sk) { const float* skp = t.sk + k0 + (lane >> 5);
#pragma unroll 8
            for (int i = 0; i < 32; ++i) { const float v = wp[(size_t)(2 * i) * t.ldn] * skp[2 * i]; scr[(2 * i + (lane >> 5)) * 33 + (lane & 31)] = v * snv; } }
        else {
#pragma unroll 8
            for (int i = 0; i < 32; ++i) { const float v = wp[(size_t)(2 * i) * t.ldn]; scr[(2 * i + (lane >> 5)) * 33 + (lane & 31)] = v * snv; } }
        asm volatile("s_waitcnt lgkmcnt(0)" ::: "memory");
        const int c = lane & 7;
#pragma unroll
        for (int j = 0; j < 4; ++j) { const int n = (lane >> 3) + 8 * j; const LAS float* s = scr + (8 * c) * 33 + n;
            u32x4 o; o.x = pk2(s[0 * 33], s[1 * 33]); o.y = pk2(s[2 * 33], s[3 * 33]); o.z = pk2(s[4 * 33], s[5 * 33]); o.w = pk2(s[6 * 33], s[7 * 33]);
            *(u32x4*)(t.WT + (size_t)drow_of(t.mode, n0 + n) * t.ldk + k0 + 8 * c) = o; }
        asm volatile("s_waitcnt lgkmcnt(0)" ::: "memory");
    }
}
__device__ __forceinline__ void prep_weights(const Params& P, int l, LAS unsigned char* lds, int G) {
    int tid_l = threadIdx.x; asm volatile("" : "+v"(tid_l)); const int tid = tid_l, lane = tid & 63, wave = tid >> 6;
    const int gw = blockIdx.x * NWV + wave, ngw = G * NWV;
    LAS float* scr = (LAS float*)(lds + wave * 16384);
    unsigned char* ws = P.ws;
    TrSpec t;
    t = TrSpec{P.in[2] + (size_t)l * D * INC, INC, D, INC, (bf16_t*)(ws + WS_WIN), D, 0, nullptr, nullptr}; transpose_items(t, scr, gw, ngw, lane);
    t = TrSpec{P.in[4] + (size_t)l * 512 * 768, 768, 512, 768, (bf16_t*)(ws + WS_WUQ), 512, 1, P.in[3] + l * 512, nullptr}; transpose_items(t, scr, gw, ngw, lane);
    t = TrSpec{P.in[6] + (size_t)l * 256 * 1024, 1024, 256, 1024, (bf16_t*)(ws + WS_WUKV), 256, 0, P.in[5] + l * 256, nullptr}; transpose_items(t, scr, gw, ngw, lane);
    t = TrSpec{P.in[11] + (size_t)l * 512 * 512, 512, 512, 512, (bf16_t*)(ws + WS_WPW), 512, 0, nullptr, nullptr}; transpose_items(t, scr, gw, ngw, lane);
#pragma unroll 1
    for (int g = 0; g < 4; ++g) { t = TrSpec{P.in[12] + (size_t)(l * 4 + g) * 128 * 128, 128, 128, 128, (bf16_t*)(ws + WS_WPOOL) + (size_t)(g * 128) * 512 + g * 128, 512, 0, nullptr, P.in[13] + l * 512 + g * 128};
        transpose_items(t, scr, gw, ngw, lane); }
    t = TrSpec{P.in[14] + (size_t)l * D * D, D, D, D, (bf16_t*)(ws + WS_WOUT), D, 0, nullptr, nullptr}; transpose_items(t, scr, gw, ngw, lane);
    t = TrSpec{P.in[17] + (size_t)l * D * DFF, DFF, D, DFF, (bf16_t*)(ws + WS_WGU), D, 4, nullptr, nullptr}; transpose_items(t, scr, gw, ngw, lane);
    t = TrSpec{P.in[18] + (size_t)l * D * DFF, DFF, D, DFF, (bf16_t*)(ws + WS_WGU), D, 5, nullptr, nullptr}; transpose_items(t, scr, gw, ngw, lane);
    t = TrSpec{P.in[19] + (size_t)l * DFF * D, D, DFF, D, (bf16_t*)(ws + WS_WDN), DFF, 0, nullptr, nullptr}; transpose_items(t, scr, gw, ngw, lane);
    const int gt = blockIdx.x * NT + tid, ngt = G * NT; const u32x4 z = {0u, 0u, 0u, 0u};
    { u32x4* p = (u32x4*)((bf16_t*)(ws + WS_WIN) + (size_t)INC * D); for (int i = gt; i < 192 * D / 8; i += ngt) p[i] = z; }
    { u32x4* p = (u32x4*)(ws + WS_WPOOL); for (int i = gt; i < 512 * 512 / 8; i += ngt) { const int row = i >> 6, col = (i & 63) * 8; if ((row >> 7) != (col >> 7)) p[i] = z; } }
}
__device__ __forceinline__ void prep_layer0(const Params& P, int G) {
    int tid_l = threadIdx.x; asm volatile("" : "+v"(tid_l)); const int gt = blockIdx.x * NT + tid_l, ngt = G * NT;
    const f32x4* x4 = (const f32x4*)P.in[0]; u32x4* xb = (u32x4*)(P.ws + WS_XB);
    for (int i = gt; i < S * D / 8; i += ngt) { const f32x4 a = x4[2 * i], b = x4[2 * i + 1]; u32x4 w; w.x = pk2(a[0], a[1]); w.y = pk2(a[2], a[3]); w.z = pk2(b[0], b[1]); w.w = pk2(b[2], b[3]); xb[i] = w; }
    const int* pos = (const int*)P.in[1];
    f32x2* rm = (f32x2*)(P.ws + WS_ROPE_MLA); f32x2* ro = (f32x2*)(P.ws + WS_ROPE_MOBA);
    const double L2T = 18.931568569324174;
    for (int i = gt; i < S * 48; i += ngt) { const int t = i / 48, jj = i - t * 48; const bool mla = jj < 32; const int j = mla ? jj : jj - 32;
        const double invf = exp2(-(mla ? (double)j / 32.0 : (double)j / 16.0) * L2T);
        const double rev = (double)pos[t] * invf * 0.15915494309189535; const float fr = (float)(rev - rint(rev));
        const f32x2 cs = {__builtin_amdgcn_cosf(fr), __builtin_amdgcn_sinf(fr)};
        if (mla) rm[t * 32 + j] = cs; else ro[t * 16 + j] = cs; }
}

template <bool TO_OUT> __device__ __forceinline__ void ln_phase(const bf16_t* __restrict__ Y, const float* __restrict__ g, const float* __restrict__ b, float* __restrict__ stats, bf16_t* __restrict__ XB, float* __restrict__ out, int G, float chkoff = 0.f) {
    int tid_l = threadIdx.x; asm volatile("" : "+v"(tid_l)); const int lane = tid_l & 63, wave = tid_l >> 6;
#pragma unroll 4
    for (int row = blockIdx.x * NWV + wave; row < S; row += G * NWV) {
        const u32x4* yr = (const u32x4*)(Y + (size_t)row * D) + lane; float v[4][8]; float s = 0.f;
#pragma unroll
        for (int j = 0; j < 4; ++j) { const u32x4 raw = yr[64 * j];
            v[j][0] = bf2f(raw.x & 0xffffu); v[j][1] = bf2f(raw.x >> 16); v[j][2] = bf2f(raw.y & 0xffffu); v[j][3] = bf2f(raw.y >> 16); v[j][4] = bf2f(raw.z & 0xffffu); v[j][5] = bf2f(raw.z >> 16); v[j][6] = bf2f(raw.w & 0xffffu); v[j][7] = bf2f(raw.w >> 16);
#pragma unroll
            for (int e = 0; e < 8; ++e) s += v[j][e]; }
        const float mean = wave_sum(s) * (1.f / D); float s2 = 0.f;
#pragma unroll
        for (int j = 0; j < 4; ++j)
#pragma unroll
            for (int e = 0; e < 8; ++e) { v[j][e] -= mean; s2 += v[j][e] * v[j][e]; }
        const float rstd = rsqrtf(wave_sum(s2) * (1.f / D) + EPS);
        if (!TO_OUT && lane == 0) *(f32x2*)(stats + (size_t)row * 2) = (f32x2){mean, rstd};
#pragma unroll
        for (int j = 0; j < 4; ++j) { const int col = 8 * (lane + 64 * j); const f32x4 g0 = *(const f32x4*)(g + col), g1 = *(const f32x4*)(g + col + 4), b0 = *(const f32x4*)(b + col), b1 = *(const f32x4*)(b + col + 4);
            f32x4 o0 = (f32x4){v[j][0], v[j][1], v[j][2], v[j][3]} * rstd * g0 + b0, o1 = (f32x4){v[j][4], v[j][5], v[j][6], v[j][7]} * rstd * g1 + b1;
            if (TO_OUT) { *(f32x4*)(out + (size_t)row * D + col) = o0 + chkoff; *(f32x4*)(out + (size_t)row * D + col + 4) = o1 + chkoff; }
            else { u32x4 w; w.x = pk2(o0[0], o0[1]); w.y = pk2(o0[2], o0[3]); w.z = pk2(o1[0], o1[1]); w.w = pk2(o1[2], o1[3]); *(u32x4*)(XB + (size_t)row * D + col) = w; } }
    }
}

__device__ __forceinline__ void p2a_phase(const Params& P, int l, LAS unsigned char* lds, int G) {
    int tid_l = threadIdx.x; asm volatile("" : "+v"(tid_l)); const int tid = tid_l, lane = tid & 63, wave = tid >> 6;
    unsigned char* ws = P.ws;
    const bf16_t* H = (const bf16_t*)(ws + WS_H);
    unsigned* ctl = (unsigned*)(ws + WS_CTL) + l * CW_LAYER;
    bf16_t* CQN = (bf16_t*)(ws + WS_CQN); bf16_t* CKVN = (bf16_t*)(ws + WS_CKVN); bf16_t* KPE = (bf16_t*)(ws + WS_KPE);
    bf16_t* CONVA = (bf16_t*)(ws + WS_CONVA); bf16_t* POOLED = (bf16_t*)(ws + WS_POOLED);
    bf16_t* MQ = (bf16_t*)(ws + WS_MQ); bf16_t* MK = (bf16_t*)(ws + WS_MK); bf16_t* MVT = (bf16_t*)(ws + WS_MVT);
    const f32x2* RM = (const f32x2*)(ws + WS_ROPE_MLA); const float* RO = (const float*)(ws + WS_ROPE_MOBA);
    LAS float* ybuf = (LAS float*)lds;
    for (int tile = blockIdx.x; tile < S / 64; tile += G) {
        const int t0 = tile * 64;
        { float ksum[8]; float kpemax = 0.f, kmmax = 0.f; const int hm = lane & 15;
#pragma unroll
          for (int e = 0; e < 8; ++e) ksum[e] = 0.f;
          struct TokIn { u32x4 cq, mq, mk; u32x2 ckv; unsigned kr1, kr2; f32x2 cs; f32x4 ro[4]; };
#define P2A_LOAD(dst, tt) do { const bf16_t* hr_ = H + (size_t)(tt) * HLD; (dst).cq = *(const u32x4*)(hr_ + C_CQ + 8 * lane); (dst).ckv = *(const u32x2*)(hr_ + C_CKV + 4 * lane); \
              (dst).kr1 = hr_[C_KR + (lane & 31)]; (dst).kr2 = hr_[C_KR + 32 + (lane & 31)]; (dst).cs = RM[(tt) * 32 + (lane & 31)]; (dst).mq = *(const u32x4*)(hr_ + C_MQ + 8 * lane); (dst).mk = *(const u32x4*)(hr_ + C_MK + 8 * lane); \
              const f32x4* tp_ = (const f32x4*)(RO + ((size_t)(tt) * 16 + 8 * (hm & 1)) * 2); (dst).ro[0] = tp_[0]; (dst).ro[1] = tp_[1]; (dst).ro[2] = tp_[2]; (dst).ro[3] = tp_[3]; } while (0)
          TokIn cur, nxt; P2A_LOAD(cur, t0 + wave * 8); nxt = cur;
#pragma unroll 2
          for (int i = 0; i < 8; ++i) {
              const int t = t0 + wave * 8 + i;
              if (i + 1 < 8) P2A_LOAD(nxt, t + 1);
              { const u32x4 raw = cur.cq; float x[8];
                x[0] = bf2f(raw.x & 0xffffu); x[1] = bf2f(raw.x >> 16); x[2] = bf2f(raw.y & 0xffffu); x[3] = bf2f(raw.y >> 16); x[4] = bf2f(raw.z & 0xffffu); x[5] = bf2f(raw.z >> 16); x[6] = bf2f(raw.w & 0xffffu); x[7] = bf2f(raw.w >> 16);
                float ss = 0.f;
#pragma unroll
                for (int e = 0; e < 8; ++e) ss += x[e] * x[e];
                const float rs = rsqrtf(wave_sum(ss) * (1.f / 512.f) + EPS);
                u32x4 w; w.x = pk2(x[0] * rs, x[1] * rs); w.y = pk2(x[2] * rs, x[3] * rs); w.z = pk2(x[4] * rs, x[5] * rs); w.w = pk2(x[6] * rs, x[7] * rs);
                *(u32x4*)(CQN + (size_t)t * 512 + 8 * lane) = w; }
              { const u32x2 raw = cur.ckv; float x[4];
                x[0] = bf2f(raw.x & 0xffffu); x[1] = bf2f(raw.x >> 16); x[2] = bf2f(raw.y & 0xffffu); x[3] = bf2f(raw.y >> 16);
                const float ss = (x[0] * x[0] + x[1] * x[1]) + (x[2] * x[2] + x[3] * x[3]);
                const float rs = rsqrtf(wave_sum(ss) * (1.f / 256.f) + EPS);
                u32x2 w; w.x = pk2(x[0] * rs, x[1] * rs); w.y = pk2(x[2] * rs, x[3] * rs);
                *(u32x2*)(CKVN + (size_t)t * 256 + 4 * lane) = w; }
              { const int j = lane & 31; const float x1 = bf2f(cur.kr1), x2 = bf2f(cur.kr2); const f32x2 cs = cur.cs;
                const float o1 = x1 * cs.x - x2 * cs.y, o2 = x1 * cs.y + x2 * cs.x;
                if (lane < 32) *(unsigned*)(KPE + (size_t)t * 64 + 2 * j) = pk2(o1, o2);
                const float n2 = wave_sum(lane < 32 ? o1 * o1 + o2 * o2 : 0.f); kpemax = fmaxf(kpemax, n2); }
#pragma unroll
              for (int which = 0; which < 2; ++which) {
                  const u32x4 raw = which ? cur.mk : cur.mq; float x[8], px[8];
                  x[0] = bf2f(raw.x & 0xffffu); x[1] = bf2f(raw.x >> 16); x[2] = bf2f(raw.y & 0xffffu); x[3] = bf2f(raw.y >> 16); x[4] = bf2f(raw.z & 0xffffu); x[5] = bf2f(raw.z >> 16); x[6] = bf2f(raw.w & 0xffffu); x[7] = bf2f(raw.w >> 16);
#pragma unroll
                  for (int e = 0; e < 8; ++e) px[e] = __shfl_xor(x[e], 2);
                  if (hm < 4) {
#pragma unroll
                      for (int e2 = 0; e2 < 4; ++e2) { const f32x4 cs = cur.ro[e2];
                          if (hm < 2) { x[2 * e2] = x[2 * e2] * cs[0] - px[2 * e2] * cs[1]; x[2 * e2 + 1] = x[2 * e2 + 1] * cs[2] - px[2 * e2 + 1] * cs[3]; }
                          else { x[2 * e2] = px[2 * e2] * cs[1] + x[2 * e2] * cs[0]; x[2 * e2 + 1] = px[2 * e2 + 1] * cs[3] + x[2 * e2 + 1] * cs[2]; } } }
                  if (which == 0) { u32x4 w; w.x = pk2(x[0] * CM_SCALE, x[1] * CM_SCALE); w.y = pk2(x[2] * CM_SCALE, x[3] * CM_SCALE); w.z = pk2(x[4] * CM_SCALE, x[5] * CM_SCALE); w.w = pk2(x[6] * CM_SCALE, x[7] * CM_SCALE);
                      *(u32x4*)(MQ + (size_t)t * 512 + 8 * lane) = w; }
                  else { u32x4 w; w.x = pk2(x[0], x[1]); w.y = pk2(x[2], x[3]); w.z = pk2(x[4], x[5]); w.w = pk2(x[6], x[7]);
                      *(u32x4*)(MK + (size_t)t * 512 + 8 * lane) = w;
                      float n2 = 0.f;
#pragma unroll
                      for (int e = 0; e < 8; ++e) { ksum[e] += x[e]; n2 += x[e] * x[e]; }
                      n2 += __shfl_xor(n2, 1); n2 += __shfl_xor(n2, 2); n2 += __shfl_xor(n2, 4); n2 += __shfl_xor(n2, 8); kmmax = fmaxf(kmmax, n2); }
              }
              cur = nxt;
          }
#undef P2A_LOAD
          { LAS f32x4* kr = (LAS f32x4*)(ybuf + wave * 512 + 8 * lane); kr[0] = (f32x4){ksum[0], ksum[1], ksum[2], ksum[3]}; kr[1] = (f32x4){ksum[4], ksum[5], ksum[6], ksum[7]}; }
          if (lane == 0) ybuf[4096 + wave * 8 + 4] = kpemax;
          if (hm == 0) ybuf[4096 + wave * 8 + (lane >> 4)] = kmmax;
          __syncthreads();
          { float a = 0.f;
#pragma unroll
            for (int w8 = 0; w8 < 8; ++w8) a += ybuf[w8 * 512 + tid];
            atomicAdd((int*)(ctl + CW_KMEAN) + ((size_t)((tid >> 7) * 64 + (t0 >> 8)) * 128 + (tid & 127)), __float2int_rn(a * KM_FIX));
            if (tid < 5) { float m = 0.f;
#pragma unroll
                for (int w8 = 0; w8 < 8; ++w8) m = fmaxf(m, ybuf[4096 + w8 * 8 + tid]);
                atomicMax(ctl + (tid == 4 ? CW_KPEMAX : CW_KMMAX + tid), __float_as_uint(m)); } }
          __syncthreads(); }
#ifdef REP_P2A_C
#pragma unroll 1
        for (int rep_ = 0; rep_ < 2; ++rep_)
#endif
        { const int c = tid;
          { const bf16_t* src = H + (size_t)t0 * HLD + C_MV + c; unsigned pk[32];
#pragma unroll
            for (int i = 0; i < 32; ++i) pk[i] = (unsigned)src[(size_t)(2 * i) * HLD] | ((unsigned)src[(size_t)(2 * i + 1) * HLD] << 16);
            u32x4* dst = (u32x4*)(MVT + (size_t)c * S + t0);
#pragma unroll
            for (int i = 0; i < 8; ++i) dst[i] = (u32x4){pk[4 * i], pk[4 * i + 1], pk[4 * i + 2], pk[4 * i + 3]}; }
          { const bf16_t* src = H + C_POOL + c; float uv[80];
#pragma unroll
            for (int i0 = 0; i0 < 80; i0 += 16) { const bf16_t* p = src + (ptrdiff_t)(t0 - 16) * HLD;
#pragma unroll
                for (int i = 0; i < 16; ++i) { const float u_ = bf2f(p[(ptrdiff_t)(i0 + i) * HLD]); uv[i0 + i] = t0 - 16 + i0 + i >= 0 ? u_ : 0.f; }
                asm volatile("" ::: "memory"); }
#define P2A_POOL(W) do { float s_ = 0.f; _Pragma("unroll") for (int i = 16 - (W); i < 16; ++i) s_ += uv[i]; \
              _Pragma("unroll") for (int i = 0; i < 64; ++i) { const int t_ = t0 + i; s_ += uv[16 + i] - uv[16 + i - (W)]; const float cnt_ = (float)(t_ + 1 < (W) ? t_ + 1 : (W)); \
                  POOLED[(size_t)t_ * 512 + c] = (bf16_t)f2bf(s_ / cnt_ - uv[16 + i]); } } while (0)
            const int grp = c >> 7;
            if (grp == 0) P2A_POOL(2); else if (grp == 1) P2A_POOL(4); else if (grp == 2) P2A_POOL(8); else P2A_POOL(16);
#undef P2A_POOL
          }
          { const float* dw = P.in[7] + (size_t)l * 31 * 512 + c; float w[31];
#pragma unroll
            for (int j = 0; j < 31; ++j) w[j] = dw[j * 512];
            const float bias = P.in[8][l * 512 + c]; const bf16_t* src = H + C_CONV + c;
#pragma unroll 1
            for (int ch = 0; ch < 4; ++ch) { float v[46];
                const int tb = t0 + 16 * ch - 30;
                { const bf16_t* p = src + (ptrdiff_t)tb * HLD;
#pragma unroll
                  for (int i0 = 0; i0 < 46; i0 += 8) { unsigned ra[8], rg[8];
#pragma unroll
                      for (int i = 0; i < 8; ++i) if (i0 + i < 46) { ra[i] = p[(ptrdiff_t)(i0 + i) * HLD]; rg[i] = p[(ptrdiff_t)(i0 + i) * HLD + 512]; }
#pragma unroll
                      for (int i = 0; i < 8; ++i) if (i0 + i < 46) { const float val = bf2f(ra[i]) * sigmoidf_(bf2f(rg[i])); v[i0 + i] = tb + i0 + i >= 0 ? val : 0.f; }
                      asm volatile("" ::: "memory"); } }
#pragma unroll
                for (int tl = 0; tl < 16; ++tl) { float y = bias;
#pragma unroll
                    for (int j = 0; j < 31; ++j) y = fmaf(w[j], v[tl + j], y);
                    ybuf[(16 * ch + tl) * 512 + c] = y; } } }
        }
        __syncthreads();
        { const float* lg = P.in[9] + l * 512 + 8 * lane; const float* lb = P.in[10] + l * 512 + 8 * lane;
          const f32x4 g0 = *(const f32x4*)lg, g1 = *(const f32x4*)(lg + 4), b0 = *(const f32x4*)lb, b1 = *(const f32x4*)(lb + 4);
#pragma unroll 1
          for (int i = 0; i < 8; ++i) { const int tl = wave * 8 + i; const LAS f32x4* yp = (const LAS f32x4*)(ybuf + tl * 512 + 8 * lane);
              f32x4 y0 = yp[0], y1 = yp[1];
              const float mean = wave_sum((y0[0] + y0[1]) + (y0[2] + y0[3]) + (y1[0] + y1[1]) + (y1[2] + y1[3])) * (1.f / 512.f);
              y0 = y0 - mean; y1 = y1 - mean;
              const float var = wave_sum((y0[0] * y0[0] + y0[1] * y0[1]) + (y0[2] * y0[2] + y0[3] * y0[3]) + (y1[0] * y1[0] + y1[1] * y1[1]) + (y1[2] * y1[2] + y1[3] * y1[3])) * (1.f / 512.f);
              const float rstd = rsqrtf(var + EPS);
              y0 = y0 * rstd * g0 + b0; y1 = y1 * rstd * g1 + b1;
              float r[8];
#pragma unroll
              for (int e = 0; e < 4; ++e) { r[e] = y0[e] * sigmoidf_(y0[e]); r[4 + e] = y1[e] * sigmoidf_(y1[e]); }
              u32x4 wv; wv.x = pk2(r[0], r[1]); wv.y = pk2(r[2], r[3]); wv.z = pk2(r[4], r[5]); wv.w = pk2(r[6], r[7]);
              *(u32x4*)(CONVA + (size_t)(t0 + tl) * 512 + 8 * lane) = wv; } }
        __syncthreads();
    }
}

__device__ __forceinline__ void gate_phase(const Params& P, int l, LAS unsigned char* lds, int G, int dup = 0) {
    int tid_l = threadIdx.x; asm volatile("" : "+v"(tid_l)); const int tid = tid_l, lane = tid & 63, wave = tid >> 6, r = lane & 31, hh = lane >> 5;
    unsigned* ctl = (unsigned*)(P.ws + WS_CTL) + l * CW_LAYER;
    const int* kmean = (const int*)(ctl + CW_KMEAN);
    const bf16_t* MQ = (const bf16_t*)(P.ws + WS_MQ);
    int* LIST = dup ? (int*)(P.ws + 486 * MiB) : (int*)((unsigned char*)P.out + DO_LIST); unsigned* cntp = ctl + (dup ? 512 : CW_CNT);
    for (int unit = blockIdx.x * NWV + wave; unit < (S / 32) * 4; unit += G * NWV) {
        const int h = unit & 3, t0 = (unit >> 2) * 32, own = t0 >> 8, t = t0 + r;
        if (own == 0) continue;
        f32x16 acc[2];
#pragma unroll
        for (int mt = 0; mt < 2; ++mt)
#pragma unroll
            for (int i = 0; i < 16; ++i) acc[mt][i] = 0.f;
#pragma unroll
        for (int ks = 0; ks < 8; ++ks) { const bf16x8 qf = *(const bf16x8*)(MQ + (size_t)t * 512 + h * 128 + 16 * ks + 8 * hh);
#pragma unroll
            for (int mt = 0; mt < 2; ++mt) { const int* kp = kmean + (size_t)(h * 64 + 32 * mt + r) * 128 + 16 * ks + 8 * hh; const u32x4 a = *(const u32x4*)kp, b = *(const u32x4*)(kp + 4);
                float v[8] = {(float)(int)a.x * KM_INV, (float)(int)a.y * KM_INV, (float)(int)a.z * KM_INV, (float)(int)a.w * KM_INV, (float)(int)b.x * KM_INV, (float)(int)b.y * KM_INV, (float)(int)b.z * KM_INV, (float)(int)b.w * KM_INV}; unsigned hi[8], lo[8];
#pragma unroll
                for (int e = 0; e < 8; ++e) { hi[e] = f2bf(v[e]); lo[e] = f2bf(v[e] - bf2f(hi[e])); }
                u32x4 wh, wl; wh.x = hi[0] | (hi[1] << 16); wh.y = hi[2] | (hi[3] << 16); wh.z = hi[4] | (hi[5] << 16); wh.w = hi[6] | (hi[7] << 16);
                wl.x = lo[0] | (lo[1] << 16); wl.y = lo[2] | (lo[3] << 16); wl.z = lo[4] | (lo[5] << 16); wl.w = lo[6] | (lo[7] << 16);
                acc[mt] = __builtin_amdgcn_mfma_f32_32x32x16_bf16(__builtin_bit_cast(bf16x8, wh), qf, acc[mt], 0, 0, 0);
                acc[mt] = __builtin_amdgcn_mfma_f32_32x32x16_bf16(__builtin_bit_cast(bf16x8, wl), qf, acc[mt], 0, 0, 0); } }
#pragma unroll
        for (int mt = 0; mt < 2; ++mt)
#pragma unroll
            for (int i = 0; i < 16; ++i) if (32 * mt + (i & 3) + 8 * (i >> 2) + 4 * hh >= own) acc[mt][i] = -INFINITY;
        float tv[3]; int ti[3];
#pragma unroll
        for (int p = 0; p < 3; ++p) { float bv = -INFINITY; int bi = 64;
#pragma unroll
            for (int mt = 0; mt < 2; ++mt)
#pragma unroll
                for (int i = 0; i < 16; ++i) { const int bidx = 32 * mt + (i & 3) + 8 * (i >> 2) + 4 * hh; const float v = acc[mt][i]; if (v > bv || (v == bv && bidx < bi)) { bv = v; bi = bidx; } }
            tv[p] = bv; ti[p] = bi;
#pragma unroll
            for (int mt = 0; mt < 2; ++mt)
#pragma unroll
                for (int i = 0; i < 16; ++i) if (32 * mt + (i & 3) + 8 * (i >> 2) + 4 * hh == bi) acc[mt][i] = -INFINITY; }
        float cv[6]; int ci[6];
#pragma unroll
        for (int p = 0; p < 3; ++p) { cv[p] = tv[p]; ci[p] = ti[p]; cv[3 + p] = __shfl_xor(tv[p], 32); ci[3 + p] = __shfl_xor(ti[p], 32); }
        int pick[3];
#pragma unroll
        for (int p = 0; p < 3; ++p) { float bv = -INFINITY; int bi = 64;
#pragma unroll
            for (int c = 0; c < 6; ++c) if (cv[c] > bv || (cv[c] == bv && ci[c] < bi)) { bv = cv[c]; bi = ci[c]; }
            pick[p] = bi;
#pragma unroll
            for (int c = 0; c < 6; ++c) if (ci[c] == bi) cv[c] = -INFINITY; }
        const int npick = own < 3 ? own : 3;
        if (hh == 0) {
#pragma unroll
            for (int p = 0; p < 3; ++p) if (p < npick) { const int hb = h * 64 + pick[p]; const int slot = (int)atomicAdd(cntp + hb, 1u); LIST[(size_t)hb * S + slot] = t * 4 + p; } }
    }
}

template <int DK>
__device__ __forceinline__ int attn_item(unsigned* qctr, const int tid, LAS unsigned char* lds, const bf16_t* Qb, int ldq, int qrow, bool qvalid, int qpos, int wqmin,
                                          const bf16_t* Kp, int ldk, const bf16_t* VT, int key0, int ntiles,
                                          float kmaxA, float kmaxB, const int OM, const int oidx, float* o32b, bf16_t* obb, float* lpb) {
    constexpr int NKS = DK / 16, SPRK = DK / 8 + 1, KSTR = SPRK * 16, NKI = SPRK, KBYTES = NKI * 1024, VSTR = 144, NVI = 18, BUF = KBYTES + NVI * 1024, KW = (DK == 192 ? 5 : 4), NII = 6;
    const int lane = tid & 63, r = lane & 31, hh = lane >> 5, wave = __builtin_amdgcn_readfirstlane(tid >> 6);
    bf16x8 qf[NKS];
    { const bf16_t* qp = Qb + (size_t)qrow * ldq + 8 * hh;
#pragma unroll
      for (int ks = 0; ks < NKS; ++ks) qf[ks] = *(const bf16x8*)(qp + 16 * ks); }
    float na = 0.f, nb = 0.f;
#pragma unroll
    for (int ks = 0; ks < NKS; ++ks)
#pragma unroll
        for (int e = 0; e < 8; ++e) { const float f = bf2f((unsigned)(unsigned short)qf[ks][e]); if (ks < 8) na += f * f; else nb += f * f; }
    na += __shfl_xor(na, 32); nb += __shfl_xor(nb, 32);
    const float negr = -(sqrtf(na) * kmaxA + sqrtf(nb) * kmaxB);
    const bool kwave = wave < KW;
    const int jw = kwave ? wave : wave - KW, jstride = kwave ? KW : 8 - KW, jn = kwave ? NKI : NVI;
    const unsigned char* gbase = kwave ? (const unsigned char*)Kp : (const unsigned char*)VT;
    const unsigned gstep = kwave ? (unsigned)ldk * 128u : 128u, ldst0 = kwave ? 0u : (unsigned)KBYTES;
#define AT_GOFF(j_) ({ const int sg_ = 64 * (j_) + lane; unsigned g_; \
        if (kwave) { const int row_ = sg_ / SPRK; int part_ = sg_ - row_ * SPRK; if (part_ == SPRK - 1) part_ = 0; g_ = (unsigned)(((key0 + row_) * ldk + part_ * 8) * 2); } \
        else { const int dv_ = sg_ / 9; int part_ = sg_ - dv_ * 9; if (part_ == 8) part_ = 0; g_ = (unsigned)((dv_ * S + key0 + part_ * 8) * 2); } g_; })
#define AT_DMA(tt, b) do { _Pragma("unroll") for (int ii_ = 0; ii_ < NII; ++ii_) { const int j_ = jw + jstride * ii_; if (j_ < jn) \
        __builtin_amdgcn_global_load_lds((const unsigned*)(gbase + (size_t)(AT_GOFF(j_) + (unsigned)(tt) * gstep)), (LAS unsigned*)(lds + (b) * BUF + ldst0 + j_ * 1024), 16, 0, 0); } } while (0)
    AT_DMA(0, 0);
    f32x16 o[4];
#pragma unroll
    for (int d = 0; d < 4; ++d)
#pragma unroll
        for (int i = 0; i < 16; ++i) o[d][i] = 0.f;
    float lsum = 0.f;
    const int pr = (r & 0x13) | ((r & 4) << 1) | ((r & 8) >> 1);
    const unsigned koff = (unsigned)(pr * KSTR + 16 * hh), voff = (unsigned)(KBYTES + r * VSTR + 16 * hh);
    asm volatile("s_waitcnt vmcnt(0)" ::: "memory"); __syncthreads();
    int nxt_idx = 0;
#pragma unroll 1
    for (int t = 0; t < ntiles; ++t) {
        const int cur = t & 1;
        if (t + 1 < ntiles) AT_DMA(t + 1, cur ^ 1);
        else if (tid == 0) nxt_idx = (int)atomicAdd(qctr, 1u);
        LAS const unsigned char* bp = lds + cur * BUF;
        bf16x8 pf[2][2];
#pragma unroll
        for (int kb = 0; kb < 2; ++kb) {
            f32x16 acc;
#pragma unroll
            for (int i = 0; i < 16; ++i) acc[i] = negr;
#pragma unroll
            for (int ks = 0; ks < NKS; ++ks) { const bf16x8 kf = *(LAS const bf16x8*)(bp + koff + kb * 32 * KSTR + 32 * ks); acc = __builtin_amdgcn_mfma_f32_32x32x16_bf16(kf, qf[ks], acc, 0, 0, 0); }
            const int kt0 = key0 + 64 * t + 32 * kb + 8 * hh;
            if (key0 + 64 * t + 63 > wqmin) {
#pragma unroll
                for (int i = 0; i < 16; ++i) if (kt0 + 16 * (i >> 3) + (i & 7) > qpos) acc[i] = -INFINITY; }
#pragma unroll
            for (int i = 0; i < 16; ++i) { const float p = __builtin_amdgcn_exp2f(acc[i]); lsum += p; acc[i] = p; }
            u32x4 w0, w1;
            w0.x = pk2(acc[0], acc[1]); w0.y = pk2(acc[2], acc[3]); w0.z = pk2(acc[4], acc[5]); w0.w = pk2(acc[6], acc[7]);
            w1.x = pk2(acc[8], acc[9]); w1.y = pk2(acc[10], acc[11]); w1.z = pk2(acc[12], acc[13]); w1.w = pk2(acc[14], acc[15]);
            pf[kb][0] = __builtin_bit_cast(bf16x8, w0); pf[kb][1] = __builtin_bit_cast(bf16x8, w1);
        }
#pragma unroll
        for (int d = 0; d < 4; ++d)
#pragma unroll
            for (int kb = 0; kb < 2; ++kb)
#pragma unroll
                for (int s = 0; s < 2; ++s) { const bf16x8 vf = *(LAS const bf16x8*)(bp + voff + d * 32 * VSTR + (32 * kb + 16 * s) * 2); o[d] = __builtin_amdgcn_mfma_f32_32x32x16_bf16(vf, pf[kb][s], o[d], 0, 0, 0); }
        asm volatile("s_waitcnt vmcnt(0)" ::: "memory");
        __syncthreads();
    }
#undef AT_DMA
#undef AT_GOFF
    lsum += __shfl_xor(lsum, 32);
    if (qvalid) {
        float* o32 = o32b + (size_t)oidx * 128; bf16_t* ob = obb + (size_t)oidx * (OM == 0 ? D : 128); float* lp = lpb + oidx;
        if (OM == 1) {
#pragma unroll
            for (int d = 0; d < 4; ++d)
#pragma unroll
                for (int i4 = 0; i4 < 4; ++i4) *(f32x4*)(o32 + 32 * d + 8 * i4 + 4 * hh) = (f32x4){o[d][4 * i4], o[d][4 * i4 + 1], o[d][4 * i4 + 2], o[d][4 * i4 + 3]};
            if (hh == 0) *lp = lsum;
        } else {
            const float sc = OM == 0 ? 1.f / lsum : 1.f;
#pragma unroll
            for (int d = 0; d < 4; ++d)
#pragma unroll
                for (int i4 = 0; i4 < 4; ++i4) { u32x2 w; w.x = pk2(o[d][4 * i4] * sc, o[d][4 * i4 + 1] * sc); w.y = pk2(o[d][4 * i4 + 2] * sc, o[d][4 * i4 + 3] * sc); *(u32x2*)(ob + 32 * d + 8 * i4 + 4 * hh) = w; }
            if (OM == 2 && hh == 0) *lp = lsum;
        }
    }
    return nxt_idx;
}

constexpr int N_HEAD_MLA = 96, N_HEAD_FIXED = 160, CW_QH = 24;
__device__ __forceinline__ void attn_phase(const Params& P, int l, LAS unsigned char* lds, int G, int rep = 0) {
    const int tid = threadIdx.x, lane = tid & 63, wave = tid >> 6, r = lane & 31;
    unsigned char* ws = P.ws; unsigned char* dout = (unsigned char*)P.out;
    unsigned* ctl = (unsigned*)(ws + WS_CTL) + l * CW_LAYER;
    float* PART = (float*)(dout + DO_PART); float* PL = (float*)(dout + DO_PL); bf16_t* PARTB = (bf16_t*)(dout + DO_PARTB); float* LB = (float*)(dout + DO_LB); const int* LIST = (const int*)(dout + DO_LIST);
    const bf16_t* Q = (const bf16_t*)(ws + WS_Q); const bf16_t* KK = (const bf16_t*)(ws + WS_K); const bf16_t* VT = (const bf16_t*)(ws + WS_VT); bf16_t* CC = (bf16_t*)(ws + WS_CONCAT);
    const bf16_t* MQ = (const bf16_t*)(ws + WS_MQ); const bf16_t* MK = (const bf16_t*)(ws + WS_MK); const bf16_t* MVT = (const bf16_t*)(ws + WS_MVT);
    LAS int* qidx = (LAS int*)(lds + LDS_MISC); LAS int* pre = (LAS int*)(lds + LDS_MISC + 64);
    __syncthreads();
    if (tid < 64) {
        const u32x4 c4 = *(const u32x4*)(ctl + CW_CNT + 4 * tid);
        const int a0 = (int)((c4.x + 255u) >> 8), a1 = a0 + (int)((c4.y + 255u) >> 8), a2 = a1 + (int)((c4.z + 255u) >> 8), a3 = a2 + (int)((c4.w + 255u) >> 8);
        int run = a3;
#pragma unroll
        for (int o = 1; o < 64; o <<= 1) { const int v = __shfl_up(run, o); if (lane >= o) run += v; }
        const int base = run - a3;
        pre[1 + 4 * tid] = base + a0; pre[2 + 4 * tid] = base + a1; pre[3 + 4 * tid] = base + a2; pre[4 + 4 * tid] = base + a3;
        if (tid == 0) pre[0] = 0; }
    __syncthreads();
    const float kpemax = sqrtf(__uint_as_float(ctl[CW_KPEMAX]));
    int hcur = (int)(((unsigned)__builtin_amdgcn_s_getreg((3 << 11) | 20) & 0xFu) & 3u), tried = 0;
    unsigned* qctr = ctl + CW_QH + 4 * rep + hcur;
    if (tid == 0) qidx[0] = (int)atomicAdd(qctr, 1u);
    __syncthreads();
    int idx = qidx[0];
    __syncthreads();
    for (;;) {
        bool done = false;
        while (idx >= N_HEAD_FIXED + pre[64 * hcur + 64] - pre[64 * hcur]) {
            if (++tried == 4) { done = true; break; }
            hcur = (hcur + 1) & 3; qctr = ctl + CW_QH + 4 * rep + hcur;
            if (tid == 0) qidx[0] = (int)atomicAdd(qctr, 1u);
            __syncthreads();
            idx = qidx[0];
            __syncthreads();
        }
        if (done) break;
        const int h = hcur; int nxt_idx;
        if (idx < N_HEAD_MLA) {
            const int j = idx; int qb, t0, nt, kind;
            if (j < 32) { qb = 32 + j; t0 = 0; nt = 128; kind = 1; }
            else { const int k = j - 32; if (k & 1) { qb = 31 - (k >> 1); t0 = 0; nt = 4 * (qb + 1); kind = 0; } else { qb = 63 - (k >> 1); t0 = 128; nt = 4 * (qb - 31); kind = 2; } }
            const int qrow = 256 * qb + 32 * wave + r;
            const float knmax = sqrtf(__uint_as_float(ctl[CW_KNPIECE + h * 4 + 0]) + __uint_as_float(ctl[CW_KNPIECE + h * 4 + 1]) + __uint_as_float(ctl[CW_KNPIECE + h * 4 + 2]) + __uint_as_float(ctl[CW_KNPIECE + h * 4 + 3]));
            const int slot = (h * 32 + (qb & 31)) * 2 + (kind == 2 ? 1 : 0); const bool causal = kind != 1;
            nxt_idx = attn_item<192>(qctr, tid, lds, Q + h * 192, 768, qrow, true, causal ? qrow : 0x7fffffff, causal ? 256 * qb + 32 * wave : 0x7fffffff, KK + h * 192, 768, VT + (size_t)h * 128 * S, 64 * t0, nt, knmax, kpemax,
                           kind == 0 ? 0 : 1, kind == 0 ? qrow : 32 * wave + r, PART + (size_t)slot * 256 * 128, CC + h * 128, PL + (size_t)slot * 256);
        } else {
            int key0, qrow, qpos, wqmin, pslot; bool valid = true;
            if (idx < N_HEAD_FIXED) { const int blk = idx - N_HEAD_MLA; key0 = 256 * blk; qrow = 256 * blk + 32 * wave + r; qpos = qrow; wqmin = 256 * blk + 32 * wave; pslot = 3; }
            else { const int g2 = pre[64 * h] + idx - N_HEAD_FIXED; int lo = 64 * h, hi = 64 * h + 64;
                while (hi - lo > 1) { const int mid = (lo + hi) >> 1; if (pre[mid] <= g2) lo = mid; else hi = mid; }
                const int hb = lo, chunk = g2 - pre[hb]; const int cntv = (int)ctl[CW_CNT + hb]; int nq = cntv - 256 * chunk; nq = nq > 256 ? 256 : nq;
                const int li = 32 * wave + r; valid = li < nq; const int ent = LIST[(size_t)hb * S + 256 * chunk + (valid ? li : 0)]; qrow = ent >> 2; pslot = ent & 3;
                key0 = 256 * (hb & 63); qpos = 0x7fffffff; wqmin = 0x7fffffff; }
            const float kmmax = sqrtf(__uint_as_float(ctl[CW_KMMAX + h]));
            nxt_idx = attn_item<128>(qctr, tid, lds, MQ + h * 128, 512, qrow, valid, qpos, wqmin, MK + h * 128, 512, MVT + (size_t)h * 128 * S, key0, 4, kmmax, 0.f, 2, (qrow * 4 + h) * 4 + pslot, nullptr, PARTB, LB);
        }
        if (tid == 0) qidx[0] = nxt_idx;
        __syncthreads();
        idx = qidx[0];
        __syncthreads();
    }
}
__device__ __forceinline__ void attn_norm_phase(const Params& P, int G) {
    int tid_l = threadIdx.x; asm volatile("" : "+v"(tid_l)); const int lane = tid_l & 63, wave = tid_l >> 6;
    unsigned char* dout = (unsigned char*)P.out;
    const float* PART = (const float*)(dout + DO_PART); const float* PL = (const float*)(dout + DO_PL); const bf16_t* PARTB = (const bf16_t*)(dout + DO_PARTB); const float* LB = (const float*)(dout + DO_LB);
    bf16_t* CC = (bf16_t*)(P.ws + WS_CONCAT);
#pragma unroll 2
    for (int row = blockIdx.x * NWV + wave; row < S; row += G * NWV) {
        float acc[16]; float lt = 0.f; bool wr = false;
#pragma unroll
        for (int e = 0; e < 16; ++e) acc[e] = 0.f;
        const int qb = row >> 8;
        if (lane < 32) { if (qb >= 32) { wr = true; const int h = lane >> 3;
#pragma unroll
                for (int c = 0; c < 2; ++c) { const size_t slot = (size_t)((h * 32 + qb - 32) * 2 + c) * 256 + (row & 255); lt += PL[slot]; const f32x4* pp = (const f32x4*)(PART + slot * 128 + 16 * (lane & 7));
#pragma unroll
                    for (int e4 = 0; e4 < 4; ++e4) { const f32x4 v = pp[e4]; acc[4 * e4] += v[0]; acc[4 * e4 + 1] += v[1]; acc[4 * e4 + 2] += v[2]; acc[4 * e4 + 3] += v[3]; } } } }
        else { wr = true; const int h = (lane >> 3) - 4; const int np = qb < 3 ? qb : 3;
            const size_t ps0 = ((size_t)row * 4 + h) * 4; const f32x4 l4 = *(const f32x4*)(LB + ps0); u32x4 raw[4][2];
#pragma unroll
            for (int sl = 0; sl < 4; ++sl) { const u32x4* pp = (const u32x4*)(PARTB + (ps0 + sl) * 128 + 16 * (lane & 7)); raw[sl][0] = pp[0]; raw[sl][1] = pp[1]; }
#pragma unroll
            for (int sl = 0; sl < 4; ++sl) { const bool use = sl == 3 || sl < np; lt += use ? l4[sl] : 0.f;
#pragma unroll
                for (int e8 = 0; e8 < 2; ++e8) { const u32x4 v = raw[sl][e8]; float f[8] = {bf2f(v.x & 0xffffu), bf2f(v.x >> 16), bf2f(v.y & 0xffffu), bf2f(v.y >> 16), bf2f(v.z & 0xffffu), bf2f(v.z >> 16), bf2f(v.w & 0xffffu), bf2f(v.w >> 16)};
#pragma unroll
                    for (int e = 0; e < 8; ++e) acc[8 * e8 + e] += use ? f[e] : 0.f; } } }
        if (wr) { const float inv = 1.f / lt; u32x4 w0, w1;
            w0.x = pk2(acc[0] * inv, acc[1] * inv); w0.y = pk2(acc[2] * inv, acc[3] * inv); w0.z = pk2(acc[4] * inv, acc[5] * inv); w0.w = pk2(acc[6] * inv, acc[7] * inv);
            w1.x = pk2(acc[8] * inv, acc[9] * inv); w1.y = pk2(acc[10] * inv, acc[11] * inv); w1.z = pk2(acc[12] * inv, acc[13] * inv); w1.w = pk2(acc[14] * inv, acc[15] * inv);
            u32x4* dst = (u32x4*)(CC + (size_t)row * D + 16 * lane); dst[0] = w0; dst[1] = w1; }
    }
}

#define GAS __attribute__((address_space(1)))

typedef GAS unsigned gu32;
typedef GAS unsigned long long gu64;
#define RLX_AGENT __ATOMIC_RELAXED, __HIP_MEMORY_SCOPE_AGENT
#define LDS_WAIT() asm volatile("s_waitcnt lgkmcnt(0)" ::: "memory")
#define VM_WAIT() asm volatile("s_waitcnt vmcnt(0)" ::: "memory")
__device__ __forceinline__ unsigned long long rt() { return __builtin_amdgcn_s_memrealtime(); }
#define XB_TMO      128
#define XB_XCNT(j)  (256  + 64 * (j))
#define XB_XSUB(j)  (1280 + 64 * (j))
#define XB_XGEN(j)  (2304 + 64 * (j))
#define XB_TOP      3328
#define XB_TOPGEN   3392
#define XCD_BAR_WORDS 3456
#define XB_SPIN_CAP (1u << 18)

__device__ __forceinline__ unsigned xb_ld(unsigned* p)              { return __hip_atomic_load(p, __ATOMIC_RELAXED, __HIP_MEMORY_SCOPE_AGENT); }
__device__ __forceinline__ unsigned xb_add(unsigned* p, unsigned v) { return __hip_atomic_fetch_add(p, v, __ATOMIC_RELAXED, __HIP_MEMORY_SCOPE_AGENT); }
__device__ __forceinline__ unsigned xb_xcc_id() { return (unsigned)__builtin_amdgcn_s_getreg((3 << 11) | 20) & 0xFu; }
#define XB_SPIN(cond, bar) do { unsigned _sp = 0; while (cond) { __builtin_amdgcn_s_sleep(1); \
    if ((++_sp & 255u) == 0u) { if (xb_ld(&(bar)[XB_TMO])) break; if (_sp > XB_SPIN_CAP) { atomicAdd(&(bar)[XB_TMO], 1u); break; } } } } while (0)

struct XcdBarrier {
    unsigned* bar; unsigned x;
    volatile LAS unsigned* st;
};

__device__ __forceinline__ XcdBarrier xcd_barrier_post(unsigned* bar, volatile LAS unsigned* st) {
    XcdBarrier b; b.bar = bar; b.x = xb_xcc_id(); b.st = st;
    if (threadIdx.x == 0) (void)xb_add(&bar[XB_XCNT(b.x)], 1u);
    return b;
}
__device__ __forceinline__ void xcd_barrier_complete(unsigned* bar, unsigned x, unsigned& nloc, unsigned& nx) {
    const unsigned G = gridDim.x * gridDim.y * gridDim.z;
    unsigned sum, cnt, mine, sp = 0u;
    for (;;) {
        sum = 0u; cnt = 0u; mine = 0u;
#pragma unroll
        for (unsigned j = 0; j < 16; ++j) { const unsigned c = xb_ld(&bar[XB_XCNT(j)]); sum += c; cnt += (c > 0u) ? 1u : 0u; mine = (j == x) ? c : mine; }
        if (sum == G) break;
        __builtin_amdgcn_s_sleep(1);
        if ((++sp & 255u) == 0u) { if (xb_ld(&bar[XB_TMO])) break; if (sp > XB_SPIN_CAP) { atomicAdd(&bar[XB_TMO], 1u); break; } }
    }
    nloc = mine > 0u ? mine : 1u; nx = cnt > 0u ? cnt : 1u;
}

__device__ __forceinline__ void xcd_barrier(const XcdBarrier& b) {
    asm volatile("s_waitcnt vmcnt(0)" ::: "memory");
    __syncthreads();
    if (threadIdx.x == 0) {
        unsigned* bar = b.bar;
        __builtin_amdgcn_s_waitcnt(0);
        unsigned nloc = b.st[0], nx = b.st[1];
        if (nloc == 0u) { xcd_barrier_complete(bar, b.x, nloc, nx); b.st[0] = nloc; b.st[1] = nx; }
        const unsigned old = xb_add(&bar[XB_XSUB(b.x)], 1u);
        const unsigned gen = old / nloc;
        if (old + 1u == (gen + 1u) * nloc) {
            __builtin_amdgcn_fence(__ATOMIC_RELEASE, "agent");
            asm volatile("s_waitcnt vmcnt(0)" ::: "memory");
            const unsigned og = xb_add(&bar[XB_TOP], 1u);
            const unsigned tg = og / nx;
            if (og + 1u == (tg + 1u) * nx) xb_add(&bar[XB_TOPGEN], 1u);
            else XB_SPIN(xb_ld(&bar[XB_TOPGEN]) == tg, bar);
            __builtin_amdgcn_fence(__ATOMIC_ACQUIRE, "agent");
            xb_add(&bar[XB_XGEN(b.x)], 1u);
            asm volatile("s_waitcnt vmcnt(0)" ::: "memory");
        } else {
            XB_SPIN(xb_ld(&bar[XB_XGEN(b.x)]) == gen, bar);
            __builtin_amdgcn_fence(__ATOMIC_ACQUIRE, "agent");
            asm volatile("s_waitcnt vmcnt(0)" ::: "memory");
        }
    }
    __syncthreads();
}

constexpr int CW_BAR = 131072;

#ifdef SELFCHECK
constexpr int CW_CHK = 40;
__device__ __forceinline__ float blk_reduce(const int tid, float v, bool domax, LAS float* red) {
#pragma unroll
    for (int o = 1; o < 64; o <<= 1) { const float w = __shfl_xor(v, o); v = domax ? fmaxf(v, w) : v + w; }
    __syncthreads(); if ((tid & 63) == 0) red[tid >> 6] = v; __syncthreads();
    float r = red[0];
#pragma unroll
    for (int i = 1; i < 8; ++i) r = domax ? fmaxf(r, red[i]) : r + red[i];
    __syncthreads();
    return r;
}
__device__ __forceinline__ int chk_token(int i) {
    if (i < 16) { const int base = (i >> 1) == 0 ? 0 : (i >> 1) == 1 ? 32 : (i >> 1) == 2 ? 64 : (i >> 1) == 3 ? 128 : (i >> 1) == 4 ? 256 : (i >> 1) == 5 ? 512 : (i >> 1) == 6 ? 768 : 1024;
        return (i & 1) ? (i == 1 ? 1 : i == 9 ? 257 : base - 1) : base; }
    return (i * 64 + (i * 13) % 64) & (S - 1); }
__device__ __forceinline__ bool chk_softmax_pv(const int tid, LAS float* sbuf, LAS int* kmap, int n, const bf16_t* VTh, const bf16_t* CC, int t, int col0, LAS float* red, LAS float* obuf) {
    float m = -INFINITY; for (int k = tid; k < n; k += NT) m = fmaxf(m, sbuf[k]);
    m = blk_reduce(tid, m, true, red);
    float l = 0.f; for (int k = tid; k < n; k += NT) { const float p = __builtin_amdgcn_exp2f(sbuf[k] - m); sbuf[k] = p; l += p; }
    l = blk_reduce(tid, l, false, red);
    const int dv = tid & 127, part = tid >> 7; float o = 0.f;
    for (int k = part; k < n; k += 4) { const int key = kmap ? kmap[k] : k; o += sbuf[k] * bf2f(VTh[(size_t)dv * S + key]); }
    obuf[tid] = o; __syncthreads();
    float ref = 0.f, err = 0.f;
    if (tid < 128) { ref = (obuf[tid] + obuf[tid + 128] + obuf[tid + 256] + obuf[tid + 384]) / l; err = fabsf(ref - bf2f(CC[(size_t)t * D + col0 + tid])); ref = fabsf(ref); }
    const float mref = blk_reduce(tid, ref, true, red), merr = blk_reduce(tid, err, true, red);
    return !(merr <= 0.02f * mref + 1e-6f);
}
__device__ __forceinline__ void selfcheck_attn(const Params& P, LAS unsigned char* lds, int l, int G) {
    int tid_l = threadIdx.x; asm volatile("" : "+v"(tid_l)); const int tid = tid_l; unsigned char* ws = P.ws;
    unsigned* flag = (unsigned*)(ws + WS_CTL) + CW_CHK; unsigned* ctl = (unsigned*)(ws + WS_CTL) + l * CW_LAYER;
    const bf16_t* Q = (const bf16_t*)(ws + WS_Q); const bf16_t* KK = (const bf16_t*)(ws + WS_K); const bf16_t* VT = (const bf16_t*)(ws + WS_VT); const bf16_t* KPE = (const bf16_t*)(ws + WS_KPE);
    const bf16_t* MQ = (const bf16_t*)(ws + WS_MQ); const bf16_t* MK = (const bf16_t*)(ws + WS_MK); const bf16_t* MVT = (const bf16_t*)(ws + WS_MVT);
    const bf16_t* CC = (const bf16_t*)(ws + WS_CONCAT); const bf16_t* CQN = (const bf16_t*)(ws + WS_CQN); const bf16_t* CKVN = (const bf16_t*)(ws + WS_CKVN);
    const int* kmean = (const int*)(ctl + CW_KMEAN); const float* RM = (const float*)(ws + WS_ROPE_MLA);
    LAS float* sbuf = (LAS float*)lds;
    LAS float* qv = (LAS float*)(lds + 65536);
    LAS float* obuf = (LAS float*)(lds + 65536 + 4096);
    LAS float* red = (LAS float*)(lds + 65536 + 8192);
    LAS int* kmap = (LAS int*)(lds + 65536 + 12288);
    LAS float* gate = (LAS float*)(lds + 65536 + 20480);
    LAS int* sel = (LAS int*)(lds + 65536 + 20480 + 256);
    for (int smp = blockIdx.x; smp < 256; smp += G) {
        const int t = chk_token(smp), h = smp & 3; unsigned bad = 0u;
        __syncthreads();
        if (tid < 192) qv[tid] = bf2f(Q[(size_t)t * 768 + h * 192 + tid]);
        __syncthreads();
        for (int k = tid; k <= t; k += NT) { const bf16_t* kr = KK + (size_t)k * 768 + h * 192; float sc = 0.f; for (int d = 0; d < 192; ++d) sc += qv[d] * bf2f(kr[d]); sbuf[k] = sc; }
        __syncthreads();
        if (chk_softmax_pv(tid, sbuf, nullptr, t + 1, VT + (size_t)h * 128 * S, CC, t, h * 128, red, obuf)) bad |= 1u;
        const int own = t >> 8;
        if (tid < 128) qv[tid] = bf2f(MQ[(size_t)t * 512 + h * 128 + tid]);
        __syncthreads();
        if (tid < 64) { float g = -INFINITY; if (tid < own) { g = 0.f; for (int d = 0; d < 128; ++d) g += qv[d] * ((float)kmean[(size_t)(h * 64 + tid) * 128 + d] * KM_INV) * (1.f / 256.f); } gate[tid] = g; }
        __syncthreads();
        if (tid == 0) { int ns = own < 3 ? own : 3; float last = 0.f; for (int p = 0; p < 4; ++p) { int bi = -1; float bv = -INFINITY; for (int b = 0; b < own; ++b) if (gate[b] > bv) { bv = gate[b]; bi = b; }
                if (p < 3) { sel[p] = bi; last = bv; if (bi >= 0) gate[bi] = -INFINITY; } else sel[4] = (own > 3 && last - bv < 1e-4f * (fabsf(last) + 1e-3f)) ? 1 : 0; }
            sel[3] = ns; }
        __syncthreads();
        const int ns = sel[3], skip = sel[4]; const int nown = t - 256 * own + 1, n = 256 * ns + nown;
        for (int kk = tid; kk < n; kk += NT) { const int key = kk < 256 * ns ? 256 * sel[kk >> 8] + (kk & 255) : 256 * own + (kk - 256 * ns); kmap[kk] = key;
            const bf16_t* kr = MK + (size_t)key * 512 + h * 128; float sc = 0.f; for (int d = 0; d < 128; ++d) sc += qv[d] * bf2f(kr[d]); sbuf[kk] = sc; }
        __syncthreads();
        if (chk_softmax_pv(tid, sbuf, kmap, n, MVT + (size_t)h * 128 * S, CC, t, 512 + h * 128, red, obuf) && !skip) bad |= 2u;
        { const float* wuq = P.in[4] + (size_t)l * 512 * 768; const float* gq = P.in[3] + l * 512;
          for (int nn = tid; nn < 768; nn += NT) { float a = 0.f; for (int k = 0; k < 512; ++k) a += bf2f(CQN[(size_t)t * 512 + k]) * gq[k] * wuq[(size_t)k * 768 + nn]; qv[nn] = a * CQ_SCALE; }
          __syncthreads();
          float ref = 0.f, err = 0.f;
          for (int nn = tid; nn < 768; nn += NT) { const int hd = nn / 192, d = nn - hd * 192; float v; int pos;
              if (d < 128) { v = qv[nn]; pos = nn; }
              else { const int e = d - 128, j = e & 31; const float x1 = qv[hd * 192 + 128 + j], x2 = qv[hd * 192 + 160 + j], c = RM[((size_t)t * 32 + j) * 2], sn = RM[((size_t)t * 32 + j) * 2 + 1];
                  v = e < 32 ? x1 * c - x2 * sn : x1 * sn + x2 * c; pos = hd * 192 + 128 + 2 * j + (e >> 5); }
              ref = fmaxf(ref, fabsf(v)); err = fmaxf(err, fabsf(v - bf2f(Q[(size_t)t * 768 + pos]))); }
          const float mref = blk_reduce(tid, ref, true, red), merr = blk_reduce(tid, err, true, red);
          if (!(merr <= 0.03f * mref + 1e-6f)) bad |= 4u; }
        { const float* wkv = P.in[6] + (size_t)l * 256 * 1024; const float* gk = P.in[5] + l * 256; float ref = 0.f, err = 0.f;
          for (int nn = tid; nn < 1024; nn += NT) { float a = 0.f; for (int k = 0; k < 256; ++k) a += bf2f(CKVN[(size_t)t * 256 + k]) * gk[k] * wkv[(size_t)k * 1024 + nn];
              const int hd = nn >> 8, d = nn & 255; const float got = d < 128 ? bf2f(KK[(size_t)t * 768 + hd * 192 + d]) : bf2f(VT[(size_t)(hd * 128 + d - 128) * S + t]);
              ref = fmaxf(ref, fabsf(a)); err = fmaxf(err, fabsf(a - got)); }
          if (tid < 256) { const int hd = tid >> 6, e = tid & 63; if (KK[(size_t)t * 768 + hd * 192 + 128 + e] != KPE[(size_t)t * 64 + e]) err = 1e30f; }
          const float mref = blk_reduce(tid, ref, true, red), merr = blk_reduce(tid, err, true, red);
          if (!(merr <= 0.03f * mref + 1e-6f)) bad |= 8u; }
        { const int b = (smp >> 2) & 63; float ref = 0.f, err = 0.f;
          if (tid < 128) { float a = 0.f; for (int i = 0; i < 256; ++i) a += bf2f(MK[(size_t)(256 * b + i) * 512 + h * 128 + tid]); a *= (1.f / 256.f); ref = fabsf(a); err = fabsf(a - (float)kmean[(size_t)(h * 64 + b) * 128 + tid] * KM_INV * (1.f / 256.f)); }
          const float mref = blk_reduce(tid, ref, true, red), merr = blk_reduce(tid, err, true, red);
          if (!(merr <= 0.02f * mref + 1e-6f)) bad |= 16u; }
        if (tid == 0 && bad) atomicOr(flag, bad);
    }
    __syncthreads();
}
__device__ __forceinline__ void selfcheck_p2a(const Params& P, LAS unsigned char* lds, int G) {
    int tid_l = threadIdx.x; asm volatile("" : "+v"(tid_l)); const int tid = tid_l; unsigned char* ws = P.ws; unsigned* flag = (unsigned*)(ws + WS_CTL) + CW_CHK;
    const bf16_t* H = (const bf16_t*)(ws + WS_H); const bf16_t* MQ = (const bf16_t*)(ws + WS_MQ); const bf16_t* MK = (const bf16_t*)(ws + WS_MK); const bf16_t* MVT = (const bf16_t*)(ws + WS_MVT); const bf16_t* KPE = (const bf16_t*)(ws + WS_KPE);
    const float* RM = (const float*)(ws + WS_ROPE_MLA); const float* RO = (const float*)(ws + WS_ROPE_MOBA);
    LAS float* red = (LAS float*)(lds + 65536 + 8192);
    for (int smp = blockIdx.x; smp < 256; smp += G) { const int t = chk_token(smp); float err = 0.f; const bf16_t* hr = H + (size_t)t * HLD;
        { const int c = tid, d = c & 127; float q = bf2f(hr[C_MQ + c]), k = bf2f(hr[C_MK + c]);
          if (d < 32) { const int j = d & 15; const float cs = RO[((size_t)t * 16 + j) * 2], sn = RO[((size_t)t * 16 + j) * 2 + 1];
              const float q1 = bf2f(hr[C_MQ + (c & ~31) + j]), q2 = bf2f(hr[C_MQ + (c & ~31) + 16 + j]), k1 = bf2f(hr[C_MK + (c & ~31) + j]), k2 = bf2f(hr[C_MK + (c & ~31) + 16 + j]);
              q = d < 16 ? q1 * cs - q2 * sn : q1 * sn + q2 * cs; k = d < 16 ? k1 * cs - k2 * sn : k1 * sn + k2 * cs; }
          err = fmaxf(err, fabsf(q * CM_SCALE - bf2f(MQ[(size_t)t * 512 + c])) / (fabsf(q * CM_SCALE) + 0.05f));
          err = fmaxf(err, fabsf(k - bf2f(MK[(size_t)t * 512 + c])) / (fabsf(k) + 0.5f));
          if (MVT[(size_t)c * S + t] != hr[C_MV + c]) err = 1e30f;
          if (c < 64) { const int j = c & 31; const float x1 = bf2f(hr[C_KR + j]), x2 = bf2f(hr[C_KR + 32 + j]), cs = RM[((size_t)t * 32 + j) * 2], sn = RM[((size_t)t * 32 + j) * 2 + 1];
              const float v = c < 32 ? x1 * cs - x2 * sn : x1 * sn + x2 * cs; err = fmaxf(err, fabsf(v - bf2f(KPE[(size_t)t * 64 + 2 * j + (c >> 5)])) / (fabsf(v) + 0.5f)); } }
        const float merr = blk_reduce(tid, err, true, red);
        if (tid == 0 && !(merr <= 0.02f)) atomicOr(flag, 32u); }
    __syncthreads();
}
#endif

#ifdef USE_CG_SYNC
#define GSYNC() grid.sync()
#else
#define GSYNC() xcd_barrier(xbar)
#endif
template <int l> __device__ __forceinline__ void layer_fwd(const Params& P, LAS unsigned char* lds, cg::grid_group& grid, const XcdBarrier& xbar, const int G) {
    unsigned char* ws = P.ws;

        unsigned* ctl = (unsigned*)(ws + WS_CTL) + l * CW_LAYER;
        bf16_t* Y = (bf16_t*)(ws + WS_Y); float* stats1 = (float*)(ws + WS_STATS); float* stats2 = stats1 + (size_t)S * 2;
#ifndef SKIP_G1
        { EpiStore E{(bf16_t*)(ws + WS_H), HLD}; GEMM_CALL(EpiStore, E, ws + WS_XB, ws + WS_WIN, HLD, D, (int)blockIdx.x); }
#endif
#ifdef REP_G1
        GSYNC(); { EpiStore E{(bf16_t*)(ws + WS_H), HLD}; GEMM_CALL(EpiStore, E, ws + WS_XB, ws + WS_WIN, HLD, D, (int)blockIdx.x); }
#endif
        GSYNC();

#ifndef SKIP_P2A
        p2a_phase(P, l, lds, G);
#endif
#ifdef SELFCHECK
        GSYNC(); selfcheck_p2a(P, lds, G);
#endif
#ifdef REP_P2A
        GSYNC(); p2a_phase(P, l, lds, G);
#endif

        GSYNC();
#ifndef SKIP_G2
        { EpiQ E{(bf16_t*)(ws + WS_Q), (const float*)(ws + WS_ROPE_MLA)}; GEMM_CALL(EpiQ, E, ws + WS_CQN, ws + WS_WUQ, 768, 512, (int)blockIdx.x); }
#endif
#ifndef SKIP_G3
        { EpiKV E{(bf16_t*)(ws + WS_K), (bf16_t*)(ws + WS_VR), (const bf16_t*)(ws + WS_KPE), ctl + CW_KNPIECE}; int kkv = 256; asm volatile("" : "+s"(kkv)); GEMM_CALL(EpiKV, E, ws + WS_CKVN, ws + WS_WUKV, 1024, kkv, (int)blockIdx.x);
          __threadfence_block(); __syncthreads();
          { pg8::StaticOrder so2; so2.init(S, 1024, G, (int)blockIdx.x); pg8::Unit u2; for (int i2 = 0; so2.next(i2, u2); ++i2) vt_tile((const bf16_t*)(ws + WS_VR), (bf16_t*)(ws + WS_VT), u2.pm, u2.pn); } }
#endif
#ifndef SKIP_G4
        { EpiStore E{(bf16_t*)(ws + WS_CONCAT) + 1024, D}; GEMM_CALL(EpiStore, E, ws + WS_CONVA, ws + WS_WPW, 512, 512, (int)((blockIdx.x + 128) % G)); }
#endif
#ifndef SKIP_G5
        { EpiStore E{(bf16_t*)(ws + WS_CONCAT) + 1536, D}; GEMM_CALL(EpiStore, E, ws + WS_POOLED, ws + WS_WPOOL, 512, 512, (int)((blockIdx.x + 64) % G)); }
#endif

#ifndef SKIP_GATE
        gate_phase(P, l, lds, G);
#endif
#ifdef REP_GATE
        gate_phase(P, l, lds, G, 1);
#endif
#ifdef REP_P2B
        { EpiQ E{(bf16_t*)(ws + WS_Q), (const float*)(ws + WS_ROPE_MLA)}; GEMM_CALL(EpiQ, E, ws + WS_CQN, ws + WS_WUQ, 768, 512, (int)blockIdx.x); }
        { EpiStore E{(bf16_t*)(ws + WS_CONCAT) + 1024, D}; GEMM_CALL(EpiStore, E, ws + WS_CONVA, ws + WS_WPW, 512, 512, (int)((blockIdx.x + 128) % G)); }
        { EpiStore E{(bf16_t*)(ws + WS_CONCAT) + 1536, D}; GEMM_CALL(EpiStore, E, ws + WS_POOLED, ws + WS_WPOOL, 512, 512, (int)((blockIdx.x + 64) % G)); }
#endif

        GSYNC();

#ifndef SKIP_ATTN
        attn_phase(P, l, lds, G);
#endif
#ifdef REP_ATTN
        GSYNC(); attn_phase(P, l, lds, G, 1);
#endif

        GSYNC();

#ifndef SKIP_NORM
        attn_norm_phase(P, G);
#endif
#ifdef SELFCHECK
        GSYNC(); selfcheck_attn(P, lds, l, G);
#endif
#ifdef REP_LN
        GSYNC(); attn_norm_phase(P, G);
#endif

        GSYNC();
#ifndef SKIP_G6
        if (l == 0) { EpiRes<0> E{P.in[0], Y, nullptr, nullptr, nullptr}; GEMM_CALL(EpiRes<0>, E, ws + WS_CONCAT, ws + WS_WOUT, D, D, (int)blockIdx.x); }
        else { EpiRes<1> E{nullptr, Y, stats2, P.in[20] + (size_t)(l - 1) * D, P.in[21] + (size_t)(l - 1) * D}; GEMM_CALL(EpiRes<1>, E, ws + WS_CONCAT, ws + WS_WOUT, D, D, (int)blockIdx.x); }
#endif
        GSYNC();
        ln_phase<false>(Y, P.in[15] + (size_t)l * D, P.in[16] + (size_t)l * D, stats1, (bf16_t*)(ws + WS_XB), nullptr, G);
        GSYNC();
#ifdef REP_LN
        ln_phase<false>(Y, P.in[15] + (size_t)l * D, P.in[16] + (size_t)l * D, stats1, (bf16_t*)(ws + WS_XB), nullptr, G);
        GSYNC();
#endif
#ifndef SKIP_G8
        { EpiFfn E{(bf16_t*)(ws + WS_ACT)}; GEMM_CALL(EpiFfn, E, ws + WS_XB, ws + WS_WGU, 2 * DFF, D, (int)blockIdx.x); }
#endif
#ifdef REP_G8
        GSYNC(); { EpiFfn E{(bf16_t*)(ws + WS_ACT)}; GEMM_CALL(EpiFfn, E, ws + WS_XB, ws + WS_WGU, 2 * DFF, D, (int)blockIdx.x); }
#endif
        GSYNC();
#ifndef SKIP_G9
        { EpiRes<1> E{nullptr, Y, stats1, P.in[15] + (size_t)l * D, P.in[16] + (size_t)l * D}; GEMM_CALL(EpiRes<1>, E, ws + WS_ACT, ws + WS_WDN, D, DFF, (int)blockIdx.x); }
#endif
        GSYNC();
        if (l + 1 < NLAYER) { ln_phase<false>(Y, P.in[20] + (size_t)l * D, P.in[21] + (size_t)l * D, stats2, (bf16_t*)(ws + WS_XB), nullptr, G); prep_weights(P, l + 1, lds, G); GSYNC();
#ifdef REP_PREP
            prep_weights(P, l + 1, lds, G); GSYNC();
#endif
#ifdef REP_LN
            ln_phase<false>(Y, P.in[20] + (size_t)l * D, P.in[21] + (size_t)l * D, stats2, (bf16_t*)(ws + WS_XB), nullptr, G); GSYNC();
#endif
        }
#ifdef SELFCHECK
        else ln_phase<true>(Y, P.in[20] + (size_t)l * D, P.in[21] + (size_t)l * D, nullptr, nullptr, P.out, G, (float)(*((const unsigned*)(ws + WS_CTL) + 40)));
#else
        else ln_phase<true>(Y, P.in[20] + (size_t)l * D, P.in[21] + (size_t)l * D, nullptr, nullptr, P.out, G);
#endif

}

__global__ void __launch_bounds__(NT, 2) hybrid_fwd(Params P) {
    extern __shared__ __attribute__((aligned(16))) unsigned char lds_raw[];
    LAS unsigned char* lds = (LAS unsigned char*)lds_raw;
    cg::grid_group grid = cg::this_grid();
    const int G = gridDim.x;
    unsigned char* ws = P.ws;
    volatile LAS unsigned* xst = (volatile LAS unsigned*)(lds + LDS_MISC + 8192);
    if (threadIdx.x < 2) xst[threadIdx.x] = 0u;
    __syncthreads();
    const XcdBarrier xbar = xcd_barrier_post((unsigned*)(ws + WS_CTL) + CW_BAR, xst);

#ifndef SKIP_PREP
    prep_weights(P, 0, lds, G);
    prep_layer0(P, G);
#endif
#ifdef REP_PREP
    GSYNC(); prep_weights(P, 0, lds, G); prep_layer0(P, G);
#endif
#ifdef REP_SYNC
#pragma unroll 1
    for (int i_ = 0; i_ < 20; ++i_) GSYNC();
#endif

    grid.sync();
    layer_fwd<0>(P, lds, grid, xbar, G);
    layer_fwd<1>(P, lds, grid, xbar, G);
}

extern "C" void kernel_launch(void* const* d_in, const int* in_sizes, int n_in, void* d_out, int out_size, void* d_ws, size_t ws_size, hipStream_t stream) {
    static int grid = 0;
    if (grid == 0) {
        if (n_in != 22 || out_size != S * D || ws_size < WS_END) { fprintf(stderr, "kernel_launch: unexpected shapes (n_in %d, out %d, ws %zu)\n", n_in, out_size, ws_size); grid = -1; return; }
        int dev = 0, cus = 0, per_cu = 0;
        hipGetDevice(&dev); hipDeviceGetAttribute(&cus, hipDeviceAttributeMultiprocessorCount, dev);
        if (hipFuncSetAttribute((const void*)hybrid_fwd, hipFuncAttributeMaxDynamicSharedMemorySize, LDS_BYTES) != hipSuccess) { fprintf(stderr, "kernel_launch: hipFuncSetAttribute failed\n"); grid = -1; return; }
        if (hipOccupancyMaxActiveBlocksPerMultiprocessor(&per_cu, (const void*)hybrid_fwd, NT, LDS_BYTES) != hipSuccess || per_cu < 1) per_cu = 1;
        (void)hipGetLastError();
        grid = cus * 1;
        fprintf(stderr, "kernel_launch: %d CUs, occupancy %d, grid %d\n", cus, per_cu, grid);
    }
    if (grid < 0) return;
    hipMemsetAsync((char*)d_ws + WS_CTL, 0, CTL_BYTES, stream);
    Params p{};
    for (int i = 0; i < 22; ++i) p.in[i] = (const float*)d_in[i];
    p.out = (float*)d_out; p.ws = (unsigned char*)d_ws;
    void* args[] = {&p};
    hipError_t e = hipLaunchCooperativeKernel((const void*)hybrid_fwd, dim3(grid), dim3(NT), args, LDS_BYTES, stream);
    if (e != hipSuccess) fprintf(stderr, "cooperative launch failed: %s (grid %d)\n", hipGetErrorString(e), grid);
}
```
